# Optimizing an MI355X kernel written in HIP

```python
import math
import jax, jax.numpy as jnp
from jax import lax
import numpy as np

D_MODEL = 1024
BATCH = 8
SEQ = 2048
DEPTH = 2

HEAD_DIM = 64
N_DIFF_HEADS = 4
DIFF_V_DIM = 2 * HEAD_DIM
DIFF_QK = N_DIFF_HEADS * 2 * HEAD_DIM
DIFF_WIDTH = N_DIFF_HEADS * DIFF_V_DIM
N_FOX_HEADS = 8
FOX_WIDTH = N_FOX_HEADS * HEAD_DIM
N_BUCKETS = 32
MAX_DISTANCE = 128
Q_BLOCK = 128
N_KEYS = 128
N_EXPERTS = N_KEYS * N_KEYS
PEER_HEADS = 8
PEER_TOPK = 16
PEER_QDIM = 256
PEER_HALF = PEER_QDIM // 2
TOKEN_BLOCK = 128
EPS = 1e-6
IN_SIZES = (DIFF_QK, DIFF_QK, DIFF_WIDTH, FOX_WIDTH, FOX_WIDTH, FOX_WIDTH, N_FOX_HEADS, D_MODEL, D_MODEL)
IN_WIDTH = sum(IN_SIZES)

kernel_name = "hybrid_diffattn_fox_peer"


def rms_norm(x, g):
    xf = x.astype(jnp.float32)
    y = xf * lax.rsqrt(jnp.mean(xf * xf, axis=-1, keepdims=True) + EPS)
    return (y * g.astype(jnp.float32)).astype(x.dtype)


def t5_bucket(dist):
    n = jnp.maximum(dist, 0)
    max_exact = N_BUCKETS // 2
    nf = jnp.maximum(n, 1).astype(jnp.float32)
    large = max_exact + (jnp.log(nf / max_exact) / math.log(MAX_DISTANCE / max_exact)
                         * (N_BUCKETS - max_exact)).astype(jnp.int32)
    large = jnp.minimum(large, N_BUCKETS - 1)
    return jnp.where(n < max_exact, n, large)


def diff_attention(q, k, v, rel_bias, lam, lam_init, subln_g):
    B, S = q.shape[0], q.shape[1]
    scale = HEAD_DIM ** -0.5
    lf = lam.astype(jnp.float32)
    lam_full = jnp.exp(jnp.sum(lf[0] * lf[1])) - jnp.exp(jnp.sum(lf[2] * lf[3])) + lam_init
    outs = []
    for blk in range(S // Q_BLOCK):
        q0 = blk * Q_BLOCK
        end = q0 + Q_BLOCK
        logits = jnp.einsum('bqhmd,bkhmd->bhmqk', q[:, q0:end], k[:, :end]).astype(jnp.float32) * scale
        dist = (q0 + jnp.arange(Q_BLOCK))[:, None] - jnp.arange(end)[None, :]
        bias = jnp.transpose(rel_bias[t5_bucket(dist)], (2, 0, 1))[:, None]
        logits = jnp.where(dist >= 0, logits + bias.astype(jnp.float32), -jnp.inf)
        probs = jax.nn.softmax(logits, axis=-1)
        weights = probs[:, :, 0] - lam_full * probs[:, :, 1]
        outs.append(jnp.einsum('bhqk,bkhd->bqhd', weights.astype(v.dtype), v[:, :end]))
    o = jnp.concatenate(outs, axis=1)
    o = rms_norm(o, subln_g) * (1.0 - lam_init)
    return o.reshape(B, S, DIFF_WIDTH)


def forgetting_attention(q, k, v, f_logit):
    B, S = q.shape[0], q.shape[1]
    scale = HEAD_DIM ** -0.5
    c = jnp.swapaxes(jnp.cumsum(jax.nn.log_sigmoid(f_logit.astype(jnp.float32)), axis=1), 1, 2)
    outs = []
    for blk in range(S // Q_BLOCK):
        q0 = blk * Q_BLOCK
        end = q0 + Q_BLOCK
        logits = jnp.einsum('bqhd,bkhd->bhqk', q[:, q0:end], k[:, :end]).astype(jnp.float32) * scale
        decay = c[:, :, q0:end, None] - c[:, :, None, :end]
        dist = (q0 + jnp.arange(Q_BLOCK))[:, None] - jnp.arange(end)[None, :]
        logits = jnp.where(dist >= 0, logits + decay, -jnp.inf)
        probs = jax.nn.softmax(logits, axis=-1)
        outs.append(jnp.einsum('bhqk,bkhd->bqhd', probs.astype(v.dtype), v[:, :end]))
    return jnp.concatenate(outs, axis=1).reshape(B, S, FOX_WIDTH)


def peer_ffn(h, w_query, sub_keys, expert_u, expert_v):
    B, S, D = h.shape
    T = B * S
    t = h.reshape(T, D)
    q = (t @ w_query).reshape(T, PEER_HEADS, 2, PEER_HALF)
    s = jnp.einsum('thpd,pnd->thpn', q, sub_keys).astype(jnp.float32)
    top_s, top_i = lax.top_k(s, PEER_TOPK)
    cand_s = (top_s[:, :, 0, :, None] + top_s[:, :, 1, None, :]).reshape(T, PEER_HEADS, PEER_TOPK * PEER_TOPK)
    cand_i = (top_i[:, :, 0, :, None] * N_KEYS + top_i[:, :, 1, None, :]).reshape(T, PEER_HEADS, PEER_TOPK * PEER_TOPK)
    best_s, best_pos = lax.top_k(cand_s, PEER_TOPK)
    experts = jnp.take_along_axis(cand_i, best_pos, axis=-1).reshape(T, PEER_HEADS * PEER_TOPK)
    gates = jax.nn.softmax(best_s, axis=-1).reshape(T, PEER_HEADS * PEER_TOPK)
    nblk = T // TOKEN_BLOCK

    def expert_block(args):
        tb, eb, gb = args
        act = jax.nn.gelu(jnp.einsum('td,ted->te', tb, expert_u[eb]).astype(jnp.float32), approximate=False)
        return jnp.einsum('te,ted->td', (gb * act).astype(tb.dtype), expert_v[eb])

    out = lax.map(expert_block, (t.reshape(nblk, TOKEN_BLOCK, D),
                                 experts.reshape(nblk, TOKEN_BLOCK, -1),
                                 gates.reshape(nblk, TOKEN_BLOCK, -1)))
    return out.reshape(B, S, D)


def setup_inputs(seed: int = 0) -> dict:
    key = jax.random.key(seed)
    ks = jax.random.split(key, 17)
    nrm = lambda k, shape, scale: jax.random.normal(k, shape, jnp.float32) * scale
    return {
        "x": nrm(ks[0], (BATCH, SEQ, D_MODEL), 1.0),
        "norm1_g": 1.0 + nrm(ks[1], (DEPTH, D_MODEL), 0.02),
        "w_in": nrm(ks[2], (DEPTH, D_MODEL, IN_WIDTH), D_MODEL ** -0.5),
        "b_forget": 2.0 + nrm(ks[3], (DEPTH, N_FOX_HEADS), 0.1),
        "diff_lambda": nrm(ks[4], (DEPTH, 4, HEAD_DIM), 0.1),
        "diff_subln_g": 1.0 + nrm(ks[5], (DEPTH, DIFF_V_DIM), 0.02),
        "w_diff_o": nrm(ks[6], (DEPTH, DIFF_WIDTH, D_MODEL), DIFF_WIDTH ** -0.5),
        "w_fox_o": nrm(ks[7], (DEPTH, FOX_WIDTH, D_MODEL), FOX_WIDTH ** -0.5),
        "w_out": nrm(ks[8], (DEPTH, D_MODEL, D_MODEL), D_MODEL ** -0.5),
        "norm2_g": 1.0 + nrm(ks[9], (DEPTH, D_MODEL), 0.02),
        "w_query": nrm(ks[10], (DEPTH, D_MODEL, PEER_HEADS * PEER_QDIM), D_MODEL ** -0.5),
        "sub_keys": nrm(ks[11], (DEPTH, 2, N_KEYS, PEER_HALF), PEER_HALF ** -0.5),
        "expert_u": nrm(ks[12], (DEPTH, N_EXPERTS, D_MODEL), D_MODEL ** -0.5),
        "expert_v": nrm(ks[13], (DEPTH, N_EXPERTS, D_MODEL), (PEER_HEADS * PEER_TOPK) ** -0.5),
        "rel_bias": nrm(ks[14], (N_BUCKETS, N_DIFF_HEADS), 0.5),
        "final_norm_g": 1.0 + nrm(ks[15], (D_MODEL,), 0.02),
    }


def reference(x, norm1_g, w_in, b_forget, diff_lambda, diff_subln_g, w_diff_o, w_fox_o, w_out,
              norm2_g, w_query, sub_keys, expert_u, expert_v, rel_bias, final_norm_g):
    B, S, D = x.shape
    split_points = np.cumsum(IN_SIZES)[:-1].tolist()
    for layer in range(DEPTH):
        lam_init = 0.8 - 0.6 * math.exp(-0.3 * layer)
        h = rms_norm(x, norm1_g[layer])
        proj = h @ w_in[layer]
        dq, dk, dv, fq, fk, fv, ff, ga, gb = jnp.split(proj, split_points, axis=-1)
        y_diff = diff_attention(dq.reshape(B, S, N_DIFF_HEADS, 2, HEAD_DIM),
                                dk.reshape(B, S, N_DIFF_HEADS, 2, HEAD_DIM),
                                dv.reshape(B, S, N_DIFF_HEADS, DIFF_V_DIM),
                                rel_bias, diff_lambda[layer], lam_init, diff_subln_g[layer])
        y_fox = forgetting_attention(fq.reshape(B, S, N_FOX_HEADS, HEAD_DIM),
                                     fk.reshape(B, S, N_FOX_HEADS, HEAD_DIM),
                                     fv.reshape(B, S, N_FOX_HEADS, HEAD_DIM),
                                     ff + b_forget[layer])
        merged = jax.nn.sigmoid(ga) * (y_diff @ w_diff_o[layer]) + jax.nn.sigmoid(gb) * (y_fox @ w_fox_o[layer])
        x = x + merged @ w_out[layer]
        x = x + peer_ffn(rms_norm(x, norm2_g[layer]), w_query[layer], sub_keys[layer],
                         expert_u[layer], expert_v[layer])
    return rms_norm(x, final_norm_g)
```

```cpp
#include <hip/hip_runtime.h>
#include <stdint.h>
#include <math.h>

typedef uint16_t bf16_t;
constexpr int D = 1024, NB = 8, S = 2048, T = NB * S, DEPTH = 2;
constexpr int INW = 5128;
constexpr int NEXP = 16384;
constexpr float EPS = 1e-6f;

__device__ __forceinline__ float bf2f(bf16_t v) { return __uint_as_float((uint32_t)v << 16); }
__device__ __forceinline__ bf16_t f2bf(float f) { uint32_t u = __float_as_uint(f); u += 0x7fffu + ((u >> 16) & 1u); return (bf16_t)(u >> 16); }
__device__ __forceinline__ float wave_sum(float v) {
#pragma unroll
    for (int o = 32; o > 0; o >>= 1) v += __shfl_xor(v, o);
    return v;
}
__device__ __forceinline__ float wave_max(float v) {
#pragma unroll
    for (int o = 32; o > 0; o >>= 1) v = fmaxf(v, __shfl_xor(v, o));
    return v;
}

__global__ void __launch_bounds__(256) k_rmsnorm(const float* __restrict__ x, const float* __restrict__ g, bf16_t* __restrict__ out,
                                                 const float* __restrict__ wff, const float* __restrict__ bfg, float* __restrict__ logf) {
    const int wave = threadIdx.x >> 6, lane = threadIdx.x & 63;
    const int row = blockIdx.x * 4 + wave;
    const float4* xr = (const float4*)(x + (size_t)row * D);
    const float4* gr = (const float4*)g;
    float4 v[4]; float ss = 0.f;
#pragma unroll
    for (int j = 0; j < 4; ++j) { v[j] = xr[j * 64 + lane]; ss += v[j].x * v[j].x + v[j].y * v[j].y + v[j].z * v[j].z + v[j].w * v[j].w; }
    ss = wave_sum(ss);
    const float rs = rsqrtf(ss * (1.0f / D) + EPS);
#pragma unroll
    for (int j = 0; j < 4; ++j) { const float4 gg = gr[j * 64 + lane]; v[j].x *= rs * gg.x; v[j].y *= rs * gg.y; v[j].z *= rs * gg.z; v[j].w *= rs * gg.w; }
#pragma unroll
    for (int j = 0; j < 4; ++j) {
        uint2 o; o.x = (uint32_t)f2bf(v[j].x) | ((uint32_t)f2bf(v[j].y) << 16); o.y = (uint32_t)f2bf(v[j].z) | ((uint32_t)f2bf(v[j].w) << 16);
        *(uint2*)(out + (size_t)row * D + (j * 64 + lane) * 4) = o;
    }
    if (wff) {
        float a0 = 0, a1 = 0, a2 = 0, a3 = 0, a4 = 0, a5 = 0, a6 = 0, a7 = 0;
#pragma unroll
        for (int j = 0; j < 4; ++j) {
#pragma unroll
            for (int c = 0; c < 4; ++c) {
                const int k = (j * 64 + lane) * 4 + c;
                const float hv = c == 0 ? v[j].x : c == 1 ? v[j].y : c == 2 ? v[j].z : v[j].w;
                const float4 w0 = *(const float4*)(wff + (size_t)k * INW + 3072), w1 = *(const float4*)(wff + (size_t)k * INW + 3076);
                a0 += hv * w0.x; a1 += hv * w0.y; a2 += hv * w0.z; a3 += hv * w0.w; a4 += hv * w1.x; a5 += hv * w1.y; a6 += hv * w1.z; a7 += hv * w1.w;
            }
        }
        a0 = wave_sum(a0); a1 = wave_sum(a1); a2 = wave_sum(a2); a3 = wave_sum(a3); a4 = wave_sum(a4); a5 = wave_sum(a5); a6 = wave_sum(a6); a7 = wave_sum(a7);
        if (lane < 8) {
            float f = lane == 0 ? a0 : lane == 1 ? a1 : lane == 2 ? a2 : lane == 3 ? a3 : lane == 4 ? a4 : lane == 5 ? a5 : lane == 6 ? a6 : a7;
            f += bfg[lane];
            logf[(size_t)row * 8 + lane] = fminf(f, 0.f) - log1pf(expf(-fabsf(f)));
        }
    }
}

__global__ void __launch_bounds__(256) k_final_norm(const float* __restrict__ x, const float* __restrict__ g, float* __restrict__ out) {
    const int wave = threadIdx.x >> 6, lane = threadIdx.x & 63;
    const int row = blockIdx.x * 4 + wave;
    const float4* xr = (const float4*)(x + (size_t)row * D);
    const float4* gr = (const float4*)g;
    float4 v[4]; float ss = 0.f;
#pragma unroll
    for (int j = 0; j < 4; ++j) { v[j] = xr[j * 64 + lane]; ss += v[j].x * v[j].x + v[j].y * v[j].y + v[j].z * v[j].z + v[j].w * v[j].w; }
    ss = wave_sum(ss);
    const float rs = rsqrtf(ss * (1.0f / D) + EPS);
#pragma unroll
    for (int j = 0; j < 4; ++j) { const float4 gg = gr[j * 64 + lane]; float4 o; o.x = v[j].x * rs * gg.x; o.y = v[j].y * rs * gg.y; o.z = v[j].z * rs * gg.z; o.w = v[j].w * rs * gg.w;
        *(float4*)(out + (size_t)row * D + (j * 64 + lane) * 4) = o; }
}

__global__ void __launch_bounds__(64) k_cumsum(const float* __restrict__ logf, float* __restrict__ cum) {
    const int lane = threadIdx.x, b = blockIdx.x >> 3, hh = blockIdx.x & 7;
    float carry = 0.f;
    for (int c = 0; c < S / 64; ++c) {
        const int s = c * 64 + lane;
        float v = logf[((size_t)(b * S + s)) * 8 + hh];
#pragma unroll
        for (int o = 1; o < 64; o <<= 1) { const float n = __shfl_up(v, o); if (lane >= o) v += n; }
        v += carry;
        cum[(size_t)(b * 8 + hh) * S + s] = v;
        carry = __shfl(v, 63);
    }
}

__global__ void k_bias_table(const float* __restrict__ rel_bias, float* __restrict__ tab) {
    const int i = threadIdx.x + blockIdx.x * blockDim.x;
    if (i >= 4 * 129) return;
    const int h = i / 129, d = i % 129;
    int bucket;
    if (d < 16) bucket = d;
    else { const float nf = (float)d; int large = 16 + (int)(logf(nf / 16.0f) / 2.0794415416798357f * 16.0f); bucket = large < 31 ? large : 31; }
    tab[i] = rel_bias[bucket * 4 + h];
}

template <class Epi, bool DUAL>
__global__ void __launch_bounds__(256) k_gemm(const bf16_t* __restrict__ A, int lda, const float* __restrict__ W, int ldw,
                                              const bf16_t* __restrict__ A2, const float* __restrict__ W2, int K, Epi epi) {
    __shared__ float As[16][65], Ws[16][64], As2[DUAL ? 16 : 1][65], Ws2[DUAL ? 16 : 1][64];
    const int t = threadIdx.x, tx = t & 15, ty = t >> 4;
    const int row0 = blockIdx.y * 64, col0 = blockIdx.x * 64;
    float acc[4][4], acc2[4][4];
#pragma unroll
    for (int i = 0; i < 4; ++i)
#pragma unroll
        for (int j = 0; j < 4; ++j) { acc[i][j] = 0.f; acc2[i][j] = 0.f; }
    for (int k0 = 0; k0 < K; k0 += 16) {
        {
            const int r = t >> 2, kk = (t & 3) * 4;
            const uint2 a = *(const uint2*)(A + (size_t)(row0 + r) * lda + k0 + kk);
            As[kk + 0][r] = bf2f((bf16_t)(a.x & 0xffff)); As[kk + 1][r] = bf2f((bf16_t)(a.x >> 16));
            As[kk + 2][r] = bf2f((bf16_t)(a.y & 0xffff)); As[kk + 3][r] = bf2f((bf16_t)(a.y >> 16));
            const int wk = t >> 4, wc = (t & 15) * 4;
            const float4 w = *(const float4*)(W + (size_t)(k0 + wk) * ldw + col0 + wc);
            Ws[wk][wc + 0] = w.x; Ws[wk][wc + 1] = w.y; Ws[wk][wc + 2] = w.z; Ws[wk][wc + 3] = w.w;
            if (DUAL) {
                const uint2 a2 = *(const uint2*)(A2 + (size_t)(row0 + r) * lda + k0 + kk);
                As2[kk + 0][r] = bf2f((bf16_t)(a2.x & 0xffff)); As2[kk + 1][r] = bf2f((bf16_t)(a2.x >> 16));
                As2[kk + 2][r] = bf2f((bf16_t)(a2.y & 0xffff)); As2[kk + 3][r] = bf2f((bf16_t)(a2.y >> 16));
                const float4 w2 = *(const float4*)(W2 + (size_t)(k0 + wk) * ldw + col0 + wc);
                Ws2[wk][wc + 0] = w2.x; Ws2[wk][wc + 1] = w2.y; Ws2[wk][wc + 2] = w2.z; Ws2[wk][wc + 3] = w2.w;
            }
        }
        __syncthreads();
#pragma unroll
        for (int kk = 0; kk < 16; ++kk) {
            float a[4], w[4];
#pragma unroll
            for (int i = 0; i < 4; ++i) { a[i] = As[kk][ty * 4 + i]; w[i] = Ws[kk][tx * 4 + i]; }
#pragma unroll
            for (int i = 0; i < 4; ++i)
#pragma unroll
                for (int j = 0; j < 4; ++j) acc[i][j] += a[i] * w[j];
            if (DUAL) {
#pragma unroll
                for (int i = 0; i < 4; ++i) { a[i] = As2[kk][ty * 4 + i]; w[i] = Ws2[kk][tx * 4 + i]; }
#pragma unroll
                for (int i = 0; i < 4; ++i)
#pragma unroll
                    for (int j = 0; j < 4; ++j) acc2[i][j] += a[i] * w[j];
            }
        }
        __syncthreads();
    }
#pragma unroll
    for (int i = 0; i < 4; ++i)
#pragma unroll
        for (int j = 0; j < 4; ++j) epi(row0 + ty * 4 + i, col0 + tx * 4 + j, acc[i][j], acc2[i][j]);
}

struct EpiQKV {
    bf16_t* qkv;
    __device__ void operator()(int r, int c, float v, float) const { qkv[(size_t)(c >> 9) * T * 512 + (size_t)r * 512 + (c & 511)] = f2bf(v); }
};
struct EpiGate {
    bf16_t* sg;
    __device__ void operator()(int r, int c, float v, float) const { sg[(size_t)(c >> 10) * T * 1024 + (size_t)r * 1024 + (c & 1023)] = f2bf(1.0f / (1.0f + expf(-v))); }
};
struct EpiMerge {
    const bf16_t* sg; bf16_t* mg;
    __device__ void operator()(int r, int c, float v, float v2) const {
        const float a = bf2f(sg[(size_t)r * 1024 + c]), b = bf2f(sg[(size_t)T * 1024 + (size_t)r * 1024 + c]);
        mg[(size_t)r * 1024 + c] = f2bf(a * v + b * v2);
    }
};
struct EpiResid {
    const float* xin; float* xout;
    __device__ void operator()(int r, int c, float v, float) const { xout[(size_t)r * D + c] = xin[(size_t)r * D + c] + v; }
};
struct EpiBf16 {
    bf16_t* o; int ldo;
    __device__ void operator()(int r, int c, float v, float) const { o[(size_t)r * ldo + c] = f2bf(v); }
};

__global__ void __launch_bounds__(256) k_diff_attn(const bf16_t* __restrict__ DQ, const bf16_t* __restrict__ DK, const bf16_t* __restrict__ DV,
                                                   const float* __restrict__ biasTab, const float* __restrict__ lamv, const float* __restrict__ subg,
                                                   float lam_init, bf16_t* __restrict__ YD) {
    __shared__ float qs[4][2][64];
    const int wave = threadIdx.x >> 6, lane = threadIdx.x & 63;
    const int gw = blockIdx.x * 4 + wave;
    const int q = gw % S, h = (gw / S) & 3, b = gw / (4 * S);
    const size_t qrow = (size_t)(b * S + q) * 512 + h * 128;
    qs[wave][0][lane] = bf2f(DQ[qrow + lane]);
    qs[wave][1][lane] = bf2f(DQ[qrow + 64 + lane]);
    __syncthreads();
    const float l01 = wave_sum(lamv[lane] * lamv[64 + lane]), l23 = wave_sum(lamv[128 + lane] * lamv[192 + lane]);
    const float lam = expf(l01) - expf(l23) + lam_init;
    float m0 = -INFINITY, m1 = -INFINITY, l0 = 0.f, l1 = 0.f, o0a = 0.f, o0b = 0.f, o1a = 0.f, o1b = 0.f;
    const int nch = q / 64 + 1;
    for (int c = 0; c < nch; ++c) {
        const int kp = c * 64 + lane;
        const bf16_t* kr = DK + (size_t)(b * S + kp) * 512 + h * 128;
        float s0 = 0.f, s1 = 0.f;
#pragma unroll
        for (int d8 = 0; d8 < 8; ++d8) {
            const uint4 k0 = *(const uint4*)(kr + d8 * 8), k1 = *(const uint4*)(kr + 64 + d8 * 8);
            const float* q0 = &qs[wave][0][d8 * 8]; const float* q1 = &qs[wave][1][d8 * 8];
            s0 += q0[0] * bf2f((bf16_t)(k0.x & 0xffff)) + q0[1] * bf2f((bf16_t)(k0.x >> 16)) + q0[2] * bf2f((bf16_t)(k0.y & 0xffff)) + q0[3] * bf2f((bf16_t)(k0.y >> 16))
                + q0[4] * bf2f((bf16_t)(k0.z & 0xffff)) + q0[5] * bf2f((bf16_t)(k0.z >> 16)) + q0[6] * bf2f((bf16_t)(k0.w & 0xffff)) + q0[7] * bf2f((bf16_t)(k0.w >> 16));
            s1 += q1[0] * bf2f((bf16_t)(k1.x & 0xffff)) + q1[1] * bf2f((bf16_t)(k1.x >> 16)) + q1[2] * bf2f((bf16_t)(k1.y & 0xffff)) + q1[3] * bf2f((bf16_t)(k1.y >> 16))
                + q1[4] * bf2f((bf16_t)(k1.z & 0xffff)) + q1[5] * bf2f((bf16_t)(k1.z >> 16)) + q1[6] * bf2f((bf16_t)(k1.w & 0xffff)) + q1[7] * bf2f((bf16_t)(k1.w >> 16));
        }
        const int dist = q - kp;
        const int dc = dist < 0 ? 0 : (dist > 128 ? 128 : dist);
        const float bias = biasTab[h * 129 + dc];
        s0 = dist >= 0 ? s0 * 0.125f + bias : -INFINITY;
        s1 = dist >= 0 ? s1 * 0.125f + bias : -INFINITY;
        float p0, p1;
        { const float cm = wave_max(s0), mn = fmaxf(m0, cm), al = expf(m0 - mn); p0 = expf(s0 - mn); l0 = l0 * al + wave_sum(p0); o0a *= al; o0b *= al; m0 = mn; }
        { const float cm = wave_max(s1), mn = fmaxf(m1, cm), al = expf(m1 - mn); p1 = expf(s1 - mn); l1 = l1 * al + wave_sum(p1); o1a *= al; o1b *= al; m1 = mn; }
        const bf16_t* vb = DV + (size_t)(b * S + c * 64) * 512 + h * 128;
        for (int j = 0; j < 64; ++j) {
            const float pj0 = __shfl(p0, j), pj1 = __shfl(p1, j);
            const float va = bf2f(vb[(size_t)j * 512 + lane]), vbb = bf2f(vb[(size_t)j * 512 + 64 + lane]);
            o0a += pj0 * va; o0b += pj0 * vbb; o1a += pj1 * va; o1b += pj1 * vbb;
        }
    }
    const float r0 = 1.0f / l0, r1 = lam / l1;
    const float oa = o0a * r0 - o1a * r1, ob = o0b * r0 - o1b * r1;
    const float ms = wave_sum(oa * oa + ob * ob) * (1.0f / 128.0f);
    const float rs = rsqrtf(ms + EPS) * (1.0f - lam_init);
    YD[qrow + lane] = f2bf(oa * rs * subg[lane]);
    YD[qrow + 64 + lane] = f2bf(ob * rs * subg[64 + lane]);
}

__global__ void __launch_bounds__(256) k_fox_attn(const bf16_t* __restrict__ FQ, const bf16_t* __restrict__ FK, const bf16_t* __restrict__ FV,
                                                  const float* __restrict__ cum, bf16_t* __restrict__ YF) {
    __shared__ float qs[4][64];
    const int wave = threadIdx.x >> 6, lane = threadIdx.x & 63;
    const int gw = blockIdx.x * 4 + wave;
    const int q = gw % S, h = (gw / S) & 7, b = gw / (8 * S);
    const size_t qrow = (size_t)(b * S + q) * 512 + h * 64;
    qs[wave][lane] = bf2f(FQ[qrow + lane]);
    __syncthreads();
    const float* cr = cum + (size_t)(b * 8 + h) * S;
    const float cq = cr[q];
    float m0 = -INFINITY, l0 = 0.f, o0 = 0.f;
    const int nch = q / 64 + 1;
    for (int c = 0; c < nch; ++c) {
        const int kp = c * 64 + lane;
        const bf16_t* kr = FK + (size_t)(b * S + kp) * 512 + h * 64;
        float s0 = 0.f;
#pragma unroll
        for (int d8 = 0; d8 < 8; ++d8) {
            const uint4 k0 = *(const uint4*)(kr + d8 * 8);
            const float* q0 = &qs[wave][d8 * 8];
            s0 += q0[0] * bf2f((bf16_t)(k0.x & 0xffff)) + q0[1] * bf2f((bf16_t)(k0.x >> 16)) + q0[2] * bf2f((bf16_t)(k0.y & 0xffff)) + q0[3] * bf2f((bf16_t)(k0.y >> 16))
                + q0[4] * bf2f((bf16_t)(k0.z & 0xffff)) + q0[5] * bf2f((bf16_t)(k0.z >> 16)) + q0[6] * bf2f((bf16_t)(k0.w & 0xffff)) + q0[7] * bf2f((bf16_t)(k0.w >> 16));
        }
        s0 = (kp <= q) ? s0 * 0.125f + (cq - cr[kp]) : -INFINITY;
        float p0;
        { const float cm = wave_max(s0), mn = fmaxf(m0, cm), al = expf(m0 - mn); p0 = expf(s0 - mn); l0 = l0 * al + wave_sum(p0); o0 *= al; m0 = mn; }
        const bf16_t* vb = FV + (size_t)(b * S + c * 64) * 512 + h * 64;
        for (int j = 0; j < 64; ++j) { const float pj = __shfl(p0, j); o0 += pj * bf2f(vb[(size_t)j * 512 + lane]); }
    }
    YF[qrow + lane] = f2bf(o0 / l0);
}

__global__ void __launch_bounds__(256) k_scores(const bf16_t* __restrict__ QP, const float* __restrict__ SK, float* __restrict__ SC) {
    const size_t i = (size_t)blockIdx.x * 256 + threadIdx.x;
    const int t = (int)(i >> 11), col = (int)(i & 2047), p = (col >> 7) & 1, n = col & 127;
    const bf16_t* q = QP + (size_t)t * 2048 + (col & ~127);
    const float* k = SK + (size_t)(p * 128 + n) * 128;
    float s = 0.f;
#pragma unroll 8
    for (int d = 0; d < 128; ++d) s += bf2f(q[d]) * k[d];
    SC[i] = s;
}
__global__ void __launch_bounds__(256) k_topk1(const float* __restrict__ SC, float* __restrict__ TOPS, int* __restrict__ TOPI) {
    const size_t i = (size_t)blockIdx.x * 256 + threadIdx.x;
    const float* base = SC + i * 128;
    float pv = INFINITY; int pi = -1;
    for (int r = 0; r < 16; ++r) {
        float bv = -INFINITY; int bi = 0x7fffffff;
        for (int n = 0; n < 128; ++n) {
            const float v = base[n];
            const bool elig = (v < pv) || (v == pv && n > pi);
            if (elig && (v > bv || (v == bv && n < bi))) { bv = v; bi = n; }
        }
        TOPS[i * 16 + r] = bv; TOPI[i * 16 + r] = bi; pv = bv; pi = bi;
    }
}
__global__ void __launch_bounds__(256) k_topk2(const float* __restrict__ TOPS, const int* __restrict__ TOPI, int* __restrict__ EXPI, float* __restrict__ GATE) {
    const size_t i = (size_t)blockIdx.x * 256 + threadIdx.x;
    const float* s0 = TOPS + i * 32; const float* s1 = s0 + 16;
    const int* i0 = TOPI + i * 32; const int* i1 = i0 + 16;
    float pv = INFINITY; int pi = -1; float mx = 0.f;
    for (int r = 0; r < 16; ++r) {
        float bv = -INFINITY; int bi = 0x7fffffff;
        for (int c = 0; c < 256; ++c) {
            const float v = s0[c >> 4] + s1[c & 15];
            const bool elig = (v < pv) || (v == pv && c > pi);
            if (elig && (v > bv || (v == bv && c < bi))) { bv = v; bi = c; }
        }
        EXPI[i * 16 + r] = i0[bi >> 4] * 128 + i1[bi & 15]; GATE[i * 16 + r] = bv; pv = bv; pi = bi;
        if (r == 0) mx = bv;
    }
    float sum = 0.f;
    for (int r = 0; r < 16; ++r) sum += expf(GATE[i * 16 + r] - mx);
    const float inv = 1.0f / sum;
    for (int r = 0; r < 16; ++r) GATE[i * 16 + r] = expf(GATE[i * 16 + r] - mx) * inv;
}
__global__ void __launch_bounds__(256) k_peer(const bf16_t* __restrict__ HN, const int* __restrict__ EXPI, const float* __restrict__ GATE,
                                              const float* __restrict__ EU, const float* __restrict__ EV, float* __restrict__ XR) {
    const int wave = threadIdx.x >> 6, lane = threadIdx.x & 63;
    const int t = blockIdx.x * 4 + wave;
    float4 tv[4], acc[4];
#pragma unroll
    for (int j = 0; j < 4; ++j) {
        const uint2 a = *(const uint2*)(HN + (size_t)t * D + (j * 64 + lane) * 4);
        tv[j].x = bf2f((bf16_t)(a.x & 0xffff)); tv[j].y = bf2f((bf16_t)(a.x >> 16)); tv[j].z = bf2f((bf16_t)(a.y & 0xffff)); tv[j].w = bf2f((bf16_t)(a.y >> 16));
        acc[j] = make_float4(0.f, 0.f, 0.f, 0.f);
    }
    for (int e = 0; e < 128; ++e) {
        const int idx = EXPI[(size_t)t * 128 + e]; const float gate = GATE[(size_t)t * 128 + e];
        const float4* ur = (const float4*)(EU + (size_t)idx * D);
        float dot = 0.f;
#pragma unroll
        for (int j = 0; j < 4; ++j) { const float4 u = ur[j * 64 + lane]; dot += tv[j].x * u.x + tv[j].y * u.y + tv[j].z * u.z + tv[j].w * u.w; }
        dot = wave_sum(dot);
        const float act = 0.5f * dot * (1.0f + erff(dot * 0.70710678118654752f));
        const float cf = gate * act;
        const float4* vr = (const float4*)(EV + (size_t)idx * D);
#pragma unroll
        for (int j = 0; j < 4; ++j) { const float4 v = vr[j * 64 + lane]; acc[j].x += cf * v.x; acc[j].y += cf * v.y; acc[j].z += cf * v.z; acc[j].w += cf * v.w; }
    }
#pragma unroll
    for (int j = 0; j < 4; ++j) {
        float4* xp = (float4*)(XR + (size_t)t * D + (j * 64 + lane) * 4);
        float4 xv = *xp; xv.x += acc[j].x; xv.y += acc[j].y; xv.z += acc[j].z; xv.w += acc[j].w; *xp = xv;
    }
}

extern "C" void kernel_launch(void* const* d_in, const int* in_sizes, int n_in, void* d_out, int out_size, void* d_ws, size_t ws_size, hipStream_t stream) {
    const float* x = (const float*)d_in[0];
    const float* norm1_g = (const float*)d_in[1];
    const float* w_in = (const float*)d_in[2];
    const float* b_forget = (const float*)d_in[3];
    const float* diff_lambda = (const float*)d_in[4];
    const float* diff_subln_g = (const float*)d_in[5];
    const float* w_diff_o = (const float*)d_in[6];
    const float* w_fox_o = (const float*)d_in[7];
    const float* w_out = (const float*)d_in[8];
    const float* norm2_g = (const float*)d_in[9];
    const float* w_query = (const float*)d_in[10];
    const float* sub_keys = (const float*)d_in[11];
    const float* expert_u = (const float*)d_in[12];
    const float* expert_v = (const float*)d_in[13];
    const float* rel_bias = (const float*)d_in[14];
    const float* final_norm_g = (const float*)d_in[15];
    float* out = (float*)d_out;

    constexpr size_t MiB = 1u << 20;
    unsigned char* ws = (unsigned char*)d_ws;
    bf16_t* QKV = (bf16_t*)(ws + 0);
    bf16_t* SG = (bf16_t*)(ws + 96 * MiB);
    float* SC = (float*)(ws + 0);
    bf16_t* HN = (bf16_t*)(ws + 160 * MiB);
    bf16_t* YD = (bf16_t*)(ws + 192 * MiB);
    bf16_t* YF = (bf16_t*)(ws + 208 * MiB);
    bf16_t* MG = (bf16_t*)(ws + 224 * MiB);
    float* XR = (float*)(ws + 256 * MiB);
    bf16_t* QP = (bf16_t*)(ws + 320 * MiB);
    float* TOPS = (float*)(ws + 384 * MiB);
    int* TOPI = (int*)(ws + 400 * MiB);
    int* EXPI = (int*)(ws + 416 * MiB);
    float* GATE = (float*)(ws + 424 * MiB);
    float* LOGF = (float*)(ws + 432 * MiB);
    float* CUM = (float*)(ws + 433 * MiB);
    float* BT = (float*)(ws + 434 * MiB);
    if (ws_size < 435 * MiB) return;

    k_bias_table<<<3, 256, 0, stream>>>(rel_bias, BT);
    for (int l = 0; l < DEPTH; ++l) {
        const float lam_init = 0.8f - 0.6f * expf(-0.3f * (float)l);
        const float* xin = (l == 0) ? x : XR;
        const float* win = w_in + (size_t)l * D * INW;
        k_rmsnorm<<<T / 4, 256, 0, stream>>>(xin, norm1_g + l * D, HN, win, b_forget + l * 8, LOGF);
        k_cumsum<<<64, 64, 0, stream>>>(LOGF, CUM);
        k_gemm<EpiQKV, false><<<dim3(3072 / 64, T / 64), 256, 0, stream>>>(HN, D, win, INW, nullptr, nullptr, D, EpiQKV{QKV});
        k_gemm<EpiGate, false><<<dim3(2048 / 64, T / 64), 256, 0, stream>>>(HN, D, win + 3080, INW, nullptr, nullptr, D, EpiGate{SG});
        k_diff_attn<<<NB * 4 * S / 4, 256, 0, stream>>>(QKV, QKV + (size_t)T * 512, QKV + (size_t)2 * T * 512, BT, diff_lambda + l * 256, diff_subln_g + l * 128, lam_init, YD);
        k_fox_attn<<<NB * 8 * S / 4, 256, 0, stream>>>(QKV + (size_t)3 * T * 512, QKV + (size_t)4 * T * 512, QKV + (size_t)5 * T * 512, CUM, YF);
        k_gemm<EpiMerge, true><<<dim3(1024 / 64, T / 64), 256, 0, stream>>>(YD, 512, w_diff_o + (size_t)l * 512 * D, D, YF, w_fox_o + (size_t)l * 512 * D, 512, EpiMerge{SG, MG});
        k_gemm<EpiResid, false><<<dim3(1024 / 64, T / 64), 256, 0, stream>>>(MG, D, w_out + (size_t)l * D * D, D, nullptr, nullptr, D, EpiResid{xin, XR});
        k_rmsnorm<<<T / 4, 256, 0, stream>>>(XR, norm2_g + l * D, HN, nullptr, nullptr, nullptr);
        k_gemm<EpiBf16, false><<<dim3(2048 / 64, T / 64), 256, 0, stream>>>(HN, D, w_query + (size_t)l * D * 2048, 2048, nullptr, nullptr, D, EpiBf16{QP, 2048});
        k_scores<<<(unsigned)((size_t)T * 2048 / 256), 256, 0, stream>>>(QP, sub_keys + (size_t)l * 2 * 128 * 128, SC);
        k_topk1<<<T * 16 / 256, 256, 0, stream>>>(SC, TOPS, TOPI);
        k_topk2<<<T * 8 / 256, 256, 0, stream>>>(TOPS, TOPI, EXPI, GATE);
        k_peer<<<T / 4, 256, 0, stream>>>(HN, EXPI, GATE, expert_u + (size_t)l * NEXP * D, expert_v + (size_t)l * NEXP * D, XR);
    }
    k_final_norm<<<T / 4, 256, 0, stream>>>(XR, final_norm_g, out);
}
```

```cpp
#include <hip/hip_runtime.h>
#include <hip/hip_cooperative_groups.h>
#include <cstdio>
#include <cstdint>
#include <math.h>
namespace cg = cooperative_groups;
namespace pg8 {
#define PG8_LAS __attribute__((address_space(3)))
typedef unsigned short bf16_t;
typedef short bf16x8 __attribute__((ext_vector_type(8)));
typedef float f32x4 __attribute__((ext_vector_type(4)));
typedef unsigned u32x4 __attribute__((ext_vector_type(4)));
constexpr int BM = 256, BK = 64, HALF = 128, HTB = HALF * BK * 2  , STAGE_BYTES = 8 * HTB, NXCD = 8, WGM = 8;

__host__ __device__ __forceinline__ int lds_byte(int r, int c) { const int st = (r >> 4) * 2 + (c >> 5), rr = r & 15, cc = c & 31, ob = rr * 64 + cc * 2; return st * 1024 + (ob ^ (((ob >> 9) & 1) << 5)); }
__host__ __device__ __forceinline__ void stage_rc(int b, int& R, int& C) { const int st = b / 1024, sb = b % 1024, swz = sb ^ (((sb >> 9) & 1) << 5); R = (st >> 1) * 16 + swz / 64; C = (st & 1) * 32 + (swz % 64) / 2; }
__host__ __device__ __forceinline__ int perm32(int rho) { const int n = rho >> 4, i = rho & 15; return 8 * (i >> 2) + 4 * n + (i & 3); }

struct Unit { int pm, pn; };
struct Gemm { const bf16_t* A; const bf16_t* Bt; int M, N, K; };

struct StaticOrder {
    int nM, nN, nwg, G, c;
    __host__ __device__ void init(int M, int N, int G_, int c_) { nM = M / BM; nN = N / BM; nwg = nM * nN; G = G_; c = c_; }
    __host__ __device__ bool next(int i, Unit& u) const {
        const long L = (long)i * G + c; if (L >= nwg) return false;
        int wgid = (int)L; { const int q = nwg / NXCD, r = nwg % NXCD, xcd = wgid % NXCD, off = wgid / NXCD; wgid = (xcd < r ? xcd * (q + 1) : r * (q + 1) + (xcd - r) * q) + off; }
        const int nig = WGM * nN, gid = wgid / nig, fm = gid * WGM, gsz = (nM - fm) < WGM ? (nM - fm) : WGM;
        u.pm = fm + ((wgid % nig) % gsz); u.pn = (wgid % nig) / gsz; return true;
    }
    __device__ __forceinline__ void a_ready(const Unit&) const {}
    __device__ __forceinline__ void done(const Unit&) const {}
};

__device__ __forceinline__ unsigned cvt_pk_bf16(float lo, float hi) { unsigned r; asm volatile("v_cvt_pk_bf16_f32 %0, %1, %2" : "=v"(r) : "v"(lo), "v"(hi)); return r; }
typedef float f32x2 __attribute__((ext_vector_type(2)));
__device__ __forceinline__ f32x2 gelu_pk(f32x2 v) {
    const f32x2 av = __builtin_elementwise_abs(v), d = av * 0.2316418882f + 1.0f;
    f32x2 t; t.x = __builtin_amdgcn_rcpf(d.x); t.y = __builtin_amdgcn_rcpf(d.y);
    f32x2 q = t * 0.5307027145f + (-0.7265760135f); q = q * t + 0.7107068705f; q = q * t + (-0.142248368f); q = q * t + 0.127414796f; q = q * t;
    const f32x2 s = (v * v) * (-0.72134752044f);
    f32x2 e; e.x = __builtin_amdgcn_exp2f(s.x); e.y = __builtin_amdgcn_exp2f(s.y);
    const f32x2 m = v * (q * e), r = v - m;
    f32x2 o; o.x = v.x < 0.f ? m.x : r.x; o.y = v.y < 0.f ? m.y : r.y; return o;
}

template <int ACT  > struct EpiBf16 {
    static constexpr bool PERM = true, AFTER_DRAIN = false; static_assert(ACT == 0 || ACT == 1, "EpiBf16: ACT is 0 (none) or 1 (gelu_pk)");
    bf16_t* O; int ldc; const float* bias; int split_cols; size_t split_stride; float scale0;
    __device__ __forceinline__ void operator()(const f32x4 (&acc)[2][2][4][2], const Unit& u, int wr, int wc, int fr, int fq) const {
        const int row0 = u.pm * BM + wr * 64 + fr; int colt = u.pn * BM; bf16_t* base = O;
        float sc = 1.f; if (split_cols) { const int t = colt / split_cols; base += (size_t)t * split_stride; colt -= t * split_cols; if (t == 0) sc = scale0; }
        const int col0 = colt + wc * 32 + 8 * fq, bcol0 = u.pn * BM + wc * 32 + 8 * fq;
        f32x4 bv[2][2];
#pragma unroll
        for (int bj = 0; bj < 2; ++bj)
#pragma unroll
            for (int n = 0; n < 2; ++n) bv[bj][n] = bias ? *(const f32x4*)(bias + bcol0 + bj * HALF + 4 * n) : (f32x4){0.f, 0.f, 0.f, 0.f};
#pragma unroll
        for (int ai = 0; ai < 2; ++ai)
#pragma unroll
            for (int m = 0; m < 4; ++m) { bf16_t* rowp = base + (size_t)(row0 + ai * HALF + m * 16) * ldc + col0;
#pragma unroll
                for (int bj = 0; bj < 2; ++bj) { f32x4 v0 = acc[ai][bj][m][0] + bv[bj][0], v1 = acc[ai][bj][m][1] + bv[bj][1];
                    if (ACT == 1) { f32x2 a = gelu_pk((f32x2){v0[0], v0[1]}), b = gelu_pk((f32x2){v0[2], v0[3]}), c = gelu_pk((f32x2){v1[0], v1[1]}), d = gelu_pk((f32x2){v1[2], v1[3]});
                        v0 = (f32x4){a.x, a.y, b.x, b.y}; v1 = (f32x4){c.x, c.y, d.x, d.y}; }
                    v0 = v0 * sc; v1 = v1 * sc; u32x4 w; w.x = cvt_pk_bf16(v0[0], v0[1]); w.y = cvt_pk_bf16(v0[2], v0[3]); w.z = cvt_pk_bf16(v1[0], v1[1]); w.w = cvt_pk_bf16(v1[2], v1[3]);
                    *(u32x4*)(rowp + bj * HALF) = w; } }
    }
};
template <class Epi, class Sched, bool ALIGN_EPI = false, bool SP2 = false>
__device__ __forceinline__ void gemm_phase(PG8_LAS unsigned char* lds, const Gemm g, const Sched& S, const Epi& E, const int tid_in) {
    int tid_ = tid_in; asm volatile("" : "+v"(tid_));
    const int tid = tid_, wid = __builtin_amdgcn_readfirstlane(tid >> 6), lane = tid & 63, wr = wid >> 2, wc = wid & 3, fr = lane & 15, fq = lane >> 4;
    const int K = g.K, nt = K / BK;
    unsigned voffA[2], voffB[2];
#pragma unroll
    for (int i = 0; i < 2; ++i) { int R, C; stage_rc(tid * 16 + i * 8192, R, C); const int Rb = Epi::PERM ? ((R & ~31) + perm32(R & 31)) : R;
        voffA[i] = (unsigned)(R * K + C) * 2u; voffB[i] = (unsigned)(Rb * K + C) * 2u; }
    const size_t kstep = (size_t)(BK * 2);
    const size_t hstep = (size_t)HALF * K * 2;
    const size_t tstep = 2 * hstep;
    const unsigned ldsw = (unsigned)wid * 1024u;
    const int aoff = lds_byte(wr * 64 + fr, fq * 8), boff = lds_byte(wc * 32 + fr, fq * 8);
#define PG8_SA(b, h) (((b) * 2 + (h)) * HTB)
#define PG8_SB(b, h) ((4 + (b) * 2 + (h)) * HTB)
#define PG8_STAGE(bufoff, gbase, voff) do { _Pragma("unroll") for (int _i = 0; _i < 2; ++_i) \
        __builtin_amdgcn_global_load_lds((const unsigned*)((const char*)(gbase) + (voff)[_i]), (PG8_LAS unsigned*)(lds + (bufoff) + ldsw + _i * 8192), 16, 0, 0); } while (0)
#define PG8_LDA(dst, b, h) do { _Pragma("unroll") for (int m = 0; m < 4; ++m) _Pragma("unroll") for (int k = 0; k < 2; ++k) dst[m][k] = *(const PG8_LAS bf16x8*)(lds + PG8_SA(b, h) + aoff + m * 2048 + k * 1024); } while (0)
#define PG8_LDB(dst, b, h) do { _Pragma("unroll") for (int n = 0; n < 2; ++n) _Pragma("unroll") for (int k = 0; k < 2; ++k) dst[n][k] = *(const PG8_LAS bf16x8*)(lds + PG8_SB(b, h) + boff + n * 2048 + k * 1024); } while (0)
#define PG8_MMA(ai, bj, At, Bt) do { __builtin_amdgcn_s_setprio(1); _Pragma("unroll") for (int m = 0; m < 4; ++m) _Pragma("unroll") for (int n = 0; n < 2; ++n) _Pragma("unroll") for (int k = 0; k < 2; ++k) \
        acc[ai][bj][m][n] = __builtin_amdgcn_mfma_f32_16x16x32_bf16(Bt[n][k], At[m][k], acc[ai][bj][m][n], 0, 0, 0); __builtin_amdgcn_s_setprio(0); } while (0)
#define PG8_WAIT_V(n) asm volatile("s_waitcnt vmcnt(" #n ")" ::: "memory")
#define PG8_WAIT_L(n) asm volatile("s_waitcnt lgkmcnt(" #n ")" ::: "memory")
#define PG8_BAR __builtin_amdgcn_s_barrier()
#define PG8_SCHED __builtin_amdgcn_sched_barrier(0)
    Unit cur, nxt; int ui = 0;
    if (!S.next(0, cur)) return;
    f32x4 acc[2][2][4][2];
#pragma unroll
    for (int a = 0; a < 2; ++a)
#pragma unroll
        for (int b = 0; b < 2; ++b)
#pragma unroll
            for (int m = 0; m < 4; ++m)
#pragma unroll
                for (int n = 0; n < 2; ++n) acc[a][b][m][n] = (f32x4){0.f, 0.f, 0.f, 0.f};
    bf16x8 At[4][2], B0[2][2], B1[2][2];
    const char* cA = (const char*)g.A + (size_t)cur.pm * tstep; const char* cB = (const char*)g.Bt + (size_t)cur.pn * tstep;
    S.a_ready(cur);
    if constexpr (SP2) {
        PG8_STAGE(PG8_SB(0, 0), cB, voffB); PG8_STAGE(PG8_SB(0, 1), cB + hstep, voffB); PG8_STAGE(PG8_SA(0, 0), cA, voffA); PG8_STAGE(PG8_SA(0, 1), cA + hstep, voffA);
        if (wr == 1) PG8_BAR;
        PG8_WAIT_V(2); PG8_BAR;
        PG8_STAGE(PG8_SB(1, 0), cB + kstep, voffB); PG8_STAGE(PG8_SA(1, 0), cA + kstep, voffA); PG8_STAGE(PG8_SB(1, 1), cB + hstep + kstep, voffB);
        PG8_WAIT_V(6); PG8_BAR;
    } else {
        PG8_STAGE(PG8_SB(0, 0), cB, voffB); PG8_STAGE(PG8_SA(0, 0), cA, voffA); PG8_STAGE(PG8_SB(0, 1), cB + hstep, voffB); PG8_STAGE(PG8_SA(0, 1), cA + hstep, voffA);
        if (wr == 1) PG8_BAR;
        PG8_WAIT_V(4); PG8_BAR;
        PG8_STAGE(PG8_SB(1, 0), cB + kstep, voffB); PG8_STAGE(PG8_SA(1, 0), cA + kstep, voffA); PG8_STAGE(PG8_SB(1, 1), cB + hstep + kstep, voffB);
        PG8_WAIT_V(6); PG8_BAR;
    }
    for (;;) {
        const bool has_next = S.next(ui + 1, nxt);
        const char* nA = has_next ? (const char*)g.A + (size_t)nxt.pm * tstep : cA; const char* nB = has_next ? (const char*)g.Bt + (size_t)nxt.pn * tstep : cB;
        for (int t = 0; t < nt; t += 2) {
            const bool last = (t == nt - 2);
            const char* a1 = cA + (size_t)(t + 1) * kstep;
            const char* a2 = last ? nA : cA + (size_t)(t + 2) * kstep; const char* b2 = last ? nB : cB + (size_t)(t + 2) * kstep;
            const char* a3 = a2 + kstep; const char* b3 = b2 + kstep;
            if (last && has_next) S.a_ready(nxt);
            if constexpr (SP2) {
            PG8_LDB(B0, 0, 0); PG8_LDB(B1, 0, 1); PG8_SCHED; PG8_LDA(At, 0, 0); PG8_STAGE(PG8_SA(1, 1), a1 + hstep, voffA);
            PG8_WAIT_V(8); PG8_WAIT_L(0); PG8_BAR; PG8_MMA(0, 0, At, B0); PG8_MMA(0, 1, At, B1); PG8_BAR; PG8_SCHED;
            PG8_LDA(At, 0, 1); PG8_STAGE(PG8_SB(0, 0), b2, voffB); PG8_STAGE(PG8_SB(0, 1), b2 + hstep, voffB); PG8_STAGE(PG8_SA(0, 0), a2, voffA);
            PG8_WAIT_V(8); PG8_WAIT_L(0); PG8_BAR; PG8_MMA(1, 0, At, B0); PG8_MMA(1, 1, At, B1); PG8_BAR; PG8_SCHED;
            PG8_LDB(B0, 1, 0); PG8_LDB(B1, 1, 1); PG8_SCHED; PG8_LDA(At, 1, 0); PG8_STAGE(PG8_SA(0, 1), a2 + hstep, voffA);
            PG8_WAIT_V(8); PG8_WAIT_L(0); PG8_BAR; PG8_MMA(0, 0, At, B0); PG8_MMA(0, 1, At, B1); PG8_BAR; PG8_SCHED;
            PG8_LDA(At, 1, 1); PG8_STAGE(PG8_SB(1, 0), b3, voffB); PG8_STAGE(PG8_SB(1, 1), b3 + hstep, voffB); PG8_STAGE(PG8_SA(1, 0), a3, voffA);
            PG8_WAIT_V(8); PG8_WAIT_L(0); PG8_BAR; PG8_MMA(1, 0, At, B0); PG8_MMA(1, 1, At, B1); PG8_BAR; PG8_SCHED;
            } else {
            PG8_LDB(B0, 0, 0); PG8_SCHED; PG8_LDA(At, 0, 0); PG8_STAGE(PG8_SA(1, 1), a1 + hstep, voffA);
            PG8_WAIT_L(8); PG8_BAR; PG8_WAIT_L(0); PG8_MMA(0, 0, At, B0); PG8_BAR; PG8_SCHED;
            PG8_LDB(B1, 0, 1); PG8_STAGE(PG8_SB(0, 0), b2, voffB);
            PG8_BAR; PG8_WAIT_L(0); PG8_MMA(0, 1, At, B1); PG8_BAR;
            PG8_LDA(At, 0, 1); PG8_STAGE(PG8_SA(0, 0), a2, voffA);
            PG8_BAR; PG8_WAIT_L(0); PG8_MMA(1, 0, At, B0); PG8_BAR; PG8_SCHED;
            PG8_STAGE(PG8_SB(0, 1), b2 + hstep, voffB);
            PG8_WAIT_V(6); PG8_BAR; PG8_MMA(1, 1, At, B1); PG8_BAR;
            PG8_LDB(B0, 1, 0); PG8_SCHED; PG8_LDA(At, 1, 0); PG8_STAGE(PG8_SA(0, 1), a2 + hstep, voffA);
            PG8_WAIT_L(8); PG8_BAR; PG8_WAIT_L(0); PG8_MMA(0, 0, At, B0); PG8_BAR; PG8_SCHED;
            PG8_LDB(B1, 1, 1); PG8_STAGE(PG8_SB(1, 0), b3, voffB);
            PG8_BAR; PG8_WAIT_L(0); PG8_MMA(0, 1, At, B1); PG8_BAR;
            PG8_LDA(At, 1, 1); PG8_STAGE(PG8_SA(1, 0), a3, voffA);
            PG8_BAR; PG8_WAIT_L(0); PG8_MMA(1, 0, At, B0); PG8_BAR; PG8_SCHED;
            PG8_STAGE(PG8_SB(1, 1), b3 + hstep, voffB);
            PG8_WAIT_V(6); PG8_BAR; PG8_MMA(1, 1, At, B1); PG8_BAR;
            }
        }
        if constexpr (ALIGN_EPI) { if (wr == 0) PG8_BAR; }
        if constexpr (!Epi::AFTER_DRAIN) { E(acc, cur, wr, wc, fr, fq); S.done(cur); }
        if (!has_next) break;
#pragma unroll
        for (int a = 0; a < 2; ++a)
#pragma unroll
            for (int b = 0; b < 2; ++b)
#pragma unroll
                for (int m = 0; m < 4; ++m)
#pragma unroll
                    for (int n = 0; n < 2; ++n) acc[a][b][m][n] = (f32x4){0.f, 0.f, 0.f, 0.f};
        cur = nxt; cA = nA; cB = nB; ++ui;
        if constexpr (ALIGN_EPI) { if (wr == 1) PG8_BAR; }
    }
    PG8_WAIT_V(0);
    if constexpr (!ALIGN_EPI) { if (wr == 0) PG8_BAR; }
    PG8_BAR;
    if constexpr (Epi::AFTER_DRAIN) { E.fused(acc, cur, wr, wc, fr, fq, lds, wid, lane); S.done(cur); }
#undef PG8_SA
#undef PG8_SB
#undef PG8_STAGE
#undef PG8_LDA
#undef PG8_LDB
#undef PG8_MMA
#undef PG8_WAIT_V
#undef PG8_WAIT_L
#undef PG8_BAR
#undef PG8_SCHED
}
}
#define GAS __attribute__((address_space(1)))
#define LAS __attribute__((address_space(3)))
typedef unsigned short bf16_t;
typedef unsigned v4u __attribute__((ext_vector_type(4)));
typedef float f32x4 __attribute__((ext_vector_type(4)));
typedef short bf16x8 __attribute__((ext_vector_type(8)));
#define LDS_WAIT() asm volatile("s_waitcnt lgkmcnt(0)" ::: "memory")
#define VM_WAIT() asm volatile("s_waitcnt vmcnt(0)" ::: "memory")
__device__ __forceinline__ float bf2f(bf16_t v) { return __uint_as_float((uint32_t)v << 16); }
__device__ __forceinline__ unsigned f2bf(float f) { unsigned u = __builtin_bit_cast(unsigned, f); return (u + 0x7fffu + ((u >> 16) & 1u)) >> 16; }
__device__ __forceinline__ unsigned pk2(float lo, float hi) { return f2bf(lo) | (f2bf(hi) << 16); }
#define DPP_F(s, ctrl) __builtin_bit_cast(float, __builtin_amdgcn_update_dpp(0, __builtin_bit_cast(int, s), ctrl, 0xF, 0xF, false))
__device__ __forceinline__ float sum32(float v) {
    v += DPP_F(v, 0xB1); v += DPP_F(v, 0x4E); v += DPP_F(v, 0x141); v += DPP_F(v, 0x140);
    v += __builtin_bit_cast(float, __builtin_amdgcn_ds_swizzle(__builtin_bit_cast(int, v), 0x401F));
    return v;
}
__device__ __forceinline__ float max32(float v) {
    v = fmaxf(v, DPP_F(v, 0xB1)); v = fmaxf(v, DPP_F(v, 0x4E)); v = fmaxf(v, DPP_F(v, 0x141)); v = fmaxf(v, DPP_F(v, 0x140));
    v = fmaxf(v, __builtin_bit_cast(float, __builtin_amdgcn_ds_swizzle(__builtin_bit_cast(int, v), 0x401F)));
    return v;
}
__device__ __forceinline__ float wave_sum(float v) {
    v = sum32(v);
    return __builtin_bit_cast(float, __builtin_amdgcn_readlane(__builtin_bit_cast(int, v), 0)) + __builtin_bit_cast(float, __builtin_amdgcn_readlane(__builtin_bit_cast(int, v), 32));
}
__device__ __forceinline__ float wave_max(float v) {
    v = max32(v);
    return fmaxf(__builtin_bit_cast(float, __builtin_amdgcn_readlane(__builtin_bit_cast(int, v), 0)), __builtin_bit_cast(float, __builtin_amdgcn_readlane(__builtin_bit_cast(int, v), 32)));
}
__device__ __forceinline__ float bperm_f(int srclane, float v) { return __builtin_bit_cast(float, __builtin_amdgcn_ds_bpermute(srclane << 2, __builtin_bit_cast(int, v))); }
__device__ __forceinline__ int bperm_i(int srclane, int v) { return __builtin_amdgcn_ds_bpermute(srclane << 2, v); }
#define XB_TMO      128
#define XB_XCNT(j)  (256  + 64 * (j))
#define XB_XSUB(j)  (1280 + 64 * (j))
#define XB_XGEN(j)  (2304 + 64 * (j))
#define XB_TOP      3328
#define XB_TOPGEN   3392
#define XCD_BAR_WORDS 3456
#define XB_SPIN_CAP (1u << 24)

__device__ __forceinline__ unsigned xb_ld(unsigned* p)              { return __hip_atomic_load(p, __ATOMIC_RELAXED, __HIP_MEMORY_SCOPE_AGENT); }
__device__ __forceinline__ unsigned xb_add(unsigned* p, unsigned v) { return __hip_atomic_fetch_add(p, v, __ATOMIC_RELAXED, __HIP_MEMORY_SCOPE_AGENT); }
__device__ __forceinline__ unsigned xb_xcc_id() { return (unsigned)__builtin_amdgcn_s_getreg((3 << 11) | 20) & 0xFu; }
#define XB_SPIN(cond, bar) do { unsigned _sp = 0; while (cond) { __builtin_amdgcn_s_sleep(1); \
    if ((++_sp & 255u) == 0u) { if (xb_ld(&(bar)[XB_TMO])) break; if (_sp > XB_SPIN_CAP) { atomicAdd(&(bar)[XB_TMO], 1u); break; } } } } while (0)

struct XcdBarrier {
    unsigned* bar; unsigned x;
    volatile LAS unsigned* st;
};

__device__ __forceinline__ XcdBarrier xcd_barrier_post(unsigned* bar, volatile LAS unsigned* st, const int tid) {
    XcdBarrier b; b.bar = bar; b.x = xb_xcc_id(); b.st = st;
    if (tid == 0) (void)xb_add(&bar[XB_XCNT(b.x)], 1u);
    return b;
}
__device__ __forceinline__ void xcd_barrier_complete(unsigned* bar, unsigned x, unsigned& nloc, unsigned& nx) {
    const unsigned G = gridDim.x * gridDim.y * gridDim.z;
    unsigned sum, cnt, mine, sp = 0u;
    for (;;) {
        sum = 0u; cnt = 0u; mine = 0u;
#pragma unroll
        for (unsigned j = 0; j < 16; ++j) { const unsigned c = xb_ld(&bar[XB_XCNT(j)]); sum += c; cnt += (c > 0u) ? 1u : 0u; mine = (j == x) ? c : mine; }
        if (sum == G) break;
        __builtin_amdgcn_s_sleep(1);
        if ((++sp & 255u) == 0u) { if (xb_ld(&bar[XB_TMO])) break; if (sp > XB_SPIN_CAP) { atomicAdd(&bar[XB_TMO], 1u); break; } }
    }
    nloc = mine > 0u ? mine : 1u; nx = cnt > 0u ? cnt : 1u;
}

__device__ __forceinline__ void xcd_barrier(const XcdBarrier& b, const int tid) {
    asm volatile("s_waitcnt vmcnt(0)" ::: "memory");
    __syncthreads();
    if (tid == 0) {
        unsigned* bar = b.bar;
        __builtin_amdgcn_s_waitcnt(0);
        unsigned nloc = b.st[0], nx = b.st[1];
        if (nloc == 0u) { xcd_barrier_complete(bar, b.x, nloc, nx); b.st[0] = nloc; b.st[1] = nx; }
        const unsigned old = xb_add(&bar[XB_XSUB(b.x)], 1u);
        const unsigned gen = old / nloc;
        if (old + 1u == (gen + 1u) * nloc) {
            __builtin_amdgcn_fence(__ATOMIC_RELEASE, "agent");
            asm volatile("s_waitcnt vmcnt(0)" ::: "memory");
            const unsigned og = xb_add(&bar[XB_TOP], 1u);
            const unsigned tg = og / nx;
            if (og + 1u == (tg + 1u) * nx) xb_add(&bar[XB_TOPGEN], 1u);
            else XB_SPIN(xb_ld(&bar[XB_TOPGEN]) == tg, bar);
            __builtin_amdgcn_fence(__ATOMIC_ACQUIRE, "agent");
            xb_add(&bar[XB_XGEN(b.x)], 1u);
            asm volatile("s_waitcnt vmcnt(0)" ::: "memory");
        } else {
            XB_SPIN(xb_ld(&bar[XB_XGEN(b.x)]) == gen, bar);
            __builtin_amdgcn_fence(__ATOMIC_ACQUIRE, "agent");
            asm volatile("s_waitcnt vmcnt(0)" ::: "memory");
        }
    }
    __syncthreads();
}
constexpr int D = 1024, NB = 8, S = 2048, T = NB * S, DEPTH = 2, INW = 5128, NEXP = 16384;
constexpr int NPROJ = 5120;
constexpr float EPS = 1e-6f;
constexpr float LOG2E = 1.4426950408889634f;
constexpr float C2 = 0.125f * LOG2E;
constexpr int NWAVES = 8, NTHREADS = 512;
constexpr int LDS_BYTES = 147456;

constexpr size_t MiB = 1u << 20;
constexpr size_t WS_CTL = 0, CTL_ZERO_BYTES = 32 * 1024;
constexpr size_t WS_WIN = 1 * MiB;
constexpr size_t WS_WDO = 21 * MiB;
constexpr size_t WS_WFO = 23 * MiB;
constexpr size_t WS_WOUT = 25 * MiB;
constexpr size_t WS_WQ = 29 * MiB;
constexpr size_t WS_BT = 38 * MiB;
constexpr size_t WS_LOGF = 39 * MiB;
constexpr size_t WS_CUM = 39 * MiB + 512 * 1024;
constexpr size_t WS_EXP = 41 * MiB;
constexpr size_t WS_HN = 169 * MiB;
constexpr size_t WS_A = 201 * MiB;
constexpr size_t WS_MGT = WS_A, WS_MG = WS_A + 64 * MiB, WS_QP = WS_A;
constexpr size_t WS_SG = 297 * MiB;
constexpr size_t WS_SSP = 106 * MiB;
constexpr size_t WS_YD = 361 * MiB, WS_YF = 377 * MiB;
constexpr size_t WS_XR = 393 * MiB;
constexpr size_t WS_EXPI = 457 * MiB, WS_GATE = 465 * MiB;
constexpr size_t WS_END = 473 * MiB;
constexpr int CW_BAR = 4096;

struct Args {
    const float* in[16]; float* out; unsigned char* ws; int ph_lo, ph_hi;
};
struct Frame {
    LAS unsigned char* lds;
    int tid, lane, wave, gw, ngw, G, bid;
};
typedef __attribute__((address_space(4))) const unsigned char* kargp_t;
__device__ __forceinline__ kargp_t kargp() { kargp_t p = (kargp_t)__builtin_amdgcn_kernarg_segment_ptr(); asm volatile("" : "+s"(p)); return p; }
#define ARG_IN(i) (*(const float* const __attribute__((address_space(4)))*)(kargp() + 8 * (i)))
#define ARG_OUT   (*(float* const __attribute__((address_space(4)))*)(kargp() + 128))
#define ARG_WS    (*(unsigned char* const __attribute__((address_space(4)))*)(kargp() + 136))
#define ARG_PHLO  (*(const int __attribute__((address_space(4)))*)(kargp() + 144))
#define ARG_PHHI  (*(const int __attribute__((address_space(4)))*)(kargp() + 148))
static_assert(sizeof(Args) == 152, "kernarg layout: in[16] | out | ws | ph_lo | ph_hi");
template <class P> __device__ __forceinline__ P* opq(P* p) { asm volatile("" : "+s"(p)); return p; }

namespace pg8 {
struct EpiProj {
    static constexpr bool PERM = true, AFTER_DRAIN = false;
    bf16_t* qkv; bf16_t* sg;
    __device__ __forceinline__ void operator()(const f32x4 (&acc)[2][2][4][2], const Unit& u, int wr, int wc, int fr, int fq) const {
        const int row0 = u.pm * BM + wr * 64 + fr; const int ct = u.pn * BM;
        bf16_t* base; int ld, colt; bool sig; float sc = 1.f;
        if (ct < 3072) { const int t = ct >> 9; base = qkv + (size_t)t * T * 512; ld = 512; colt = ct & 511; sig = false; if (t == 0 || t == 3) sc = C2; }
        else { const int c2 = ct - 3072, t = c2 >> 10; base = sg + (size_t)t * T * 1024; ld = 1024; colt = c2 & 1023; sig = true; }
        const int col0 = colt + wc * 32 + 8 * fq;
#pragma unroll
        for (int ai = 0; ai < 2; ++ai)
#pragma unroll
            for (int m = 0; m < 4; ++m) { bf16_t* rowp = base + (size_t)(row0 + ai * HALF + m * 16) * ld + col0;
#pragma unroll
                for (int bj = 0; bj < 2; ++bj) { f32x4 v0 = acc[ai][bj][m][0], v1 = acc[ai][bj][m][1];
                    if (sig) {
#pragma unroll
                        for (int e = 0; e < 4; ++e) { v0[e] = __builtin_amdgcn_rcpf(1.0f + __builtin_amdgcn_exp2f(-LOG2E * v0[e])); v1[e] = __builtin_amdgcn_rcpf(1.0f + __builtin_amdgcn_exp2f(-LOG2E * v1[e])); }
                    } else { v0 = v0 * sc; v1 = v1 * sc; }
                    u32x4 w; w.x = cvt_pk_bf16(v0[0], v0[1]); w.y = cvt_pk_bf16(v0[2], v0[3]); w.z = cvt_pk_bf16(v1[0], v1[1]); w.w = cvt_pk_bf16(v1[2], v1[3]);
                    *(GAS u32x4*)(rowp + bj * HALF) = w; } }
    }
};
__device__ __forceinline__ void unpack8(const u32x4 w, float (&f)[8]) {
    f[0] = __uint_as_float(w.x << 16); f[1] = __uint_as_float(w.x & 0xffff0000u); f[2] = __uint_as_float(w.y << 16); f[3] = __uint_as_float(w.y & 0xffff0000u);
    f[4] = __uint_as_float(w.z << 16); f[5] = __uint_as_float(w.z & 0xffff0000u); f[6] = __uint_as_float(w.w << 16); f[7] = __uint_as_float(w.w & 0xffff0000u);
}
struct EpiMerge1 {
    static constexpr bool PERM = true, AFTER_DRAIN = false;
    const bf16_t* sga; bf16_t* tmp;
    __device__ __forceinline__ void operator()(const f32x4 (&acc)[2][2][4][2], const Unit& u, int wr, int wc, int fr, int fq) const {
        const int row0 = u.pm * BM + wr * 64 + fr, col0 = u.pn * BM + wc * 32 + 8 * fq;
#pragma unroll
        for (int ai = 0; ai < 2; ++ai)
#pragma unroll
            for (int m = 0; m < 4; ++m) { const size_t off = (size_t)(row0 + ai * HALF + m * 16) * 1024 + col0;
#pragma unroll
                for (int bj = 0; bj < 2; ++bj) { float g[8]; unpack8(*(const GAS u32x4*)(sga + off + bj * HALF), g);
                    const f32x4 v0 = acc[ai][bj][m][0], v1 = acc[ai][bj][m][1];
                    u32x4 w; w.x = cvt_pk_bf16(v0[0] * g[0], v0[1] * g[1]); w.y = cvt_pk_bf16(v0[2] * g[2], v0[3] * g[3]); w.z = cvt_pk_bf16(v1[0] * g[4], v1[1] * g[5]); w.w = cvt_pk_bf16(v1[2] * g[6], v1[3] * g[7]);
                    *(GAS u32x4*)(tmp + off + bj * HALF) = w; } }
    }
};
struct EpiMerge2 {
    static constexpr bool PERM = true, AFTER_DRAIN = false;
    const bf16_t* sgb; const bf16_t* tmp; bf16_t* mg;
    __device__ __forceinline__ void operator()(const f32x4 (&acc)[2][2][4][2], const Unit& u, int wr, int wc, int fr, int fq) const {
        const int row0 = u.pm * BM + wr * 64 + fr, col0 = u.pn * BM + wc * 32 + 8 * fq;
#pragma unroll
        for (int ai = 0; ai < 2; ++ai)
#pragma unroll
            for (int m = 0; m < 4; ++m) { const size_t off = (size_t)(row0 + ai * HALF + m * 16) * 1024 + col0;
#pragma unroll
                for (int bj = 0; bj < 2; ++bj) { float g[8], t[8]; unpack8(*(const GAS u32x4*)(sgb + off + bj * HALF), g); unpack8(*(const GAS u32x4*)(tmp + off + bj * HALF), t);
                    const f32x4 a0 = acc[ai][bj][m][0], a1 = acc[ai][bj][m][1];
                    u32x4 w; w.x = cvt_pk_bf16(t[0] + g[0] * a0[0], t[1] + g[1] * a0[1]); w.y = cvt_pk_bf16(t[2] + g[2] * a0[2], t[3] + g[3] * a0[3]);
                    w.z = cvt_pk_bf16(t[4] + g[4] * a1[0], t[5] + g[5] * a1[1]); w.w = cvt_pk_bf16(t[6] + g[6] * a1[2], t[7] + g[7] * a1[3]);
                    *(GAS u32x4*)(mg + off + bj * HALF) = w; } }
    }
};
struct EpiResidSS {
    static constexpr bool PERM = true, AFTER_DRAIN = false;
    const float* xin; float* xout; bf16_t* xb; float* ssp;
    __device__ __forceinline__ void operator()(const f32x4 (&acc)[2][2][4][2], const Unit& u, int wr, int wc, int fr, int fq) const {
        const int row0 = u.pm * BM + wr * 64 + fr, col0 = u.pn * BM + wc * 32 + 8 * fq;
#pragma unroll
        for (int ai = 0; ai < 2; ++ai)
#pragma unroll
            for (int m = 0; m < 4; ++m) { const int row = row0 + ai * HALF + m * 16; const size_t off = (size_t)row * 1024 + col0; float s = 0.f;
#pragma unroll
                for (int bj = 0; bj < 2; ++bj) {
                    const f32x4 v0 = *(const GAS f32x4*)(xin + off + bj * HALF) + acc[ai][bj][m][0], v1 = *(const GAS f32x4*)(xin + off + bj * HALF + 4) + acc[ai][bj][m][1];
                    *(GAS f32x4*)(xout + off + bj * HALF) = v0; *(GAS f32x4*)(xout + off + bj * HALF + 4) = v1;
                    u32x4 w; w.x = cvt_pk_bf16(v0[0], v0[1]); w.y = cvt_pk_bf16(v0[2], v0[3]); w.z = cvt_pk_bf16(v1[0], v1[1]); w.w = cvt_pk_bf16(v1[2], v1[3]);
                    *(GAS u32x4*)(xb + off + bj * HALF) = w;
                    s += ((v0[0] * v0[0] + v0[1] * v0[1]) + (v0[2] * v0[2] + v0[3] * v0[3])) + ((v1[0] * v1[0] + v1[1] * v1[1]) + (v1[2] * v1[2] + v1[3] * v1[3])); }
                s += __builtin_bit_cast(float, __builtin_amdgcn_ds_swizzle(__builtin_bit_cast(int, s), 0x401F));
                { auto rr = __builtin_amdgcn_permlane32_swap(__builtin_bit_cast(unsigned, s), __builtin_bit_cast(unsigned, s), false, false); s = __builtin_bit_cast(float, rr[0]) + __builtin_bit_cast(float, rr[1]); }
                if (fq == 0) ((GAS float*)ssp)[(size_t)row * 16 + u.pn * 4 + wc] = s; }
    }
};
struct EpiQP {
    static constexpr bool PERM = true, AFTER_DRAIN = false;
    bf16_t* qp; const PG8_LAS float* rsl; int pm0;
    __device__ __forceinline__ void operator()(const f32x4 (&acc)[2][2][4][2], const Unit& u, int wr, int wc, int fr, int fq) const {
        const int rl0 = wr * 64 + fr, col0 = u.pn * BM + wc * 32 + 8 * fq;
        const PG8_LAS float* rs_ = rsl + (u.pm == pm0 ? 0 : 256);
#pragma unroll
        for (int ai = 0; ai < 2; ++ai)
#pragma unroll
            for (int m = 0; m < 4; ++m) { const int rl = rl0 + ai * HALF + m * 16;
                const float rs = rs_[rl];
                bf16_t* rowp = qp + (size_t)(u.pm * BM + rl) * 2048 + col0;
#pragma unroll
                for (int bj = 0; bj < 2; ++bj) { const f32x4 v0 = acc[ai][bj][m][0] * rs, v1 = acc[ai][bj][m][1] * rs;
                    u32x4 w; w.x = cvt_pk_bf16(v0[0], v0[1]); w.y = cvt_pk_bf16(v0[2], v0[3]); w.z = cvt_pk_bf16(v1[0], v1[1]); w.w = cvt_pk_bf16(v1[2], v1[3]);
                    *(GAS u32x4*)(rowp + bj * HALF) = w; } }
    }
};
}

__device__ __forceinline__ void p0_transpose_item(const float* W, int ldw, int K, int Nd, int skip_from, int skip, bf16_t* WT, LAS float* scr, int item, int lane, const float* kscale = nullptr) {
    const int nblk = Nd / 32, kb = item / nblk, nb = item % nblk, k0 = 64 * kb, n0 = 32 * nb;
    const int s0 = n0 + (n0 >= skip_from ? skip : 0);
    float wv_[32];
    const GAS float* Wg = (const GAS float*)W + (size_t)(k0 + (lane >> 5)) * ldw + s0 + (lane & 31);
#pragma unroll
    for (int i = 0; i < 32; ++i) wv_[i] = Wg[(size_t)(2 * i) * ldw];
    if (kscale) {
        const GAS float* ks = (const GAS float*)kscale + k0 + (lane >> 5);
#pragma unroll
        for (int i = 0; i < 32; ++i) wv_[i] *= ks[2 * i];
    }
#pragma unroll
    for (int i = 0; i < 32; ++i) scr[(2 * i + (lane >> 5)) * 33 + (lane & 31)] = wv_[i];
    LDS_WAIT(); asm volatile("" ::: "memory");
    const int c = lane & 7;
#pragma unroll
    for (int j = 0; j < 4; ++j) { const int n = (lane >> 3) + 8 * j; const LAS float* s = scr + (8 * c) * 33 + n;
        v4u o; o.x = pk2(s[0 * 33], s[1 * 33]); o.y = pk2(s[2 * 33], s[3 * 33]); o.z = pk2(s[4 * 33], s[5 * 33]); o.w = pk2(s[6 * 33], s[7 * 33]);
        *(GAS v4u*)(WT + (size_t)(n0 + n) * K + k0 + 8 * c) = o; }
    LDS_WAIT(); asm volatile("" ::: "memory");
}
__device__ __forceinline__ void ph_prologue(Frame& F) {
    unsigned char* ws = ARG_WS;
    LAS float* scr = (LAS float*)(F.lds + F.wave * 16384);
    constexpr int I_IN = (D / 64) * (NPROJ / 32), I_DO = (512 / 64) * (D / 32), I_OUT = (D / 64) * (D / 32), I_Q = (D / 64) * (2048 / 32);
    constexpr int PER_L = I_IN + 2 * I_DO + I_OUT + I_Q;
    for (int it = F.gw; it < DEPTH * PER_L; it += F.ngw) {
        const int l = it / PER_L; int r = it % PER_L;
        if (r < I_IN) { p0_transpose_item(ARG_IN(2) + (size_t)l * D * INW, INW, D, NPROJ, 3072, 8, (bf16_t*)(ws + WS_WIN + (size_t)l * 10 * MiB), scr, r, F.lane); continue; } r -= I_IN;
        if (r < I_DO) { p0_transpose_item(ARG_IN(6) + (size_t)l * 512 * D, D, 512, D, 1 << 30, 0, (bf16_t*)(ws + WS_WDO + (size_t)l * MiB), scr, r, F.lane); continue; } r -= I_DO;
        if (r < I_DO) { p0_transpose_item(ARG_IN(7) + (size_t)l * 512 * D, D, 512, D, 1 << 30, 0, (bf16_t*)(ws + WS_WFO + (size_t)l * MiB), scr, r, F.lane); continue; } r -= I_DO;
        if (r < I_OUT) { p0_transpose_item(ARG_IN(8) + (size_t)l * D * D, D, D, D, 1 << 30, 0, (bf16_t*)(ws + WS_WOUT + (size_t)l * 2 * MiB), scr, r, F.lane); continue; } r -= I_OUT;
        p0_transpose_item(ARG_IN(10) + (size_t)l * D * 2048, 2048, D, 2048, 1 << 30, 0, (bf16_t*)(ws + WS_WQ + (size_t)l * 4 * MiB), scr, r, F.lane, ARG_IN(9) + l * D);
    }
    if (F.bid == 0) {
        float* tab = (float*)(ws + WS_BT); const float* rel_bias = ARG_IN(14);
        for (int i = F.tid; i < 4 * 129; i += NTHREADS) {
            const int h = i / 129, d = i % 129; int bucket;
            if (d < 16) bucket = d;
            else { const int large = 16 + (int)(logf((float)d / 16.0f) / 2.0794415416798357f * 16.0f); bucket = large < 31 ? large : 31; }
            tab[i] = rel_bias[bucket * 4 + h] * LOG2E;
        }
    }
}

__device__ __forceinline__ void ph_rmsnorm(Frame& F, const float* xp_, const float* gp_, bf16_t* outp_, const float* wffp_, const float* bfgp_, float* logfp_) {
    const int lane = F.lane;
    const GAS float* x = (const GAS float*)xp_; const GAS f32x4* gr = (const GAS f32x4*)gp_; GAS bf16_t* out = (GAS bf16_t*)outp_;
    const GAS float* wff = (const GAS float*)wffp_; const GAS float* bfg = (const GAS float*)bfgp_; GAS float* logf = (GAS float*)logfp_;
    LAS float* wl = (LAS float*)F.lds;
    for (int k = F.tid; k < D; k += NTHREADS) {
        const f32x4 w0 = *(const GAS f32x4*)(wff + (size_t)k * INW + 3072), w1 = *(const GAS f32x4*)(wff + (size_t)k * INW + 3076);
        wl[0 * D + k] = w0[0]; wl[1 * D + k] = w0[1]; wl[2 * D + k] = w0[2]; wl[3 * D + k] = w0[3]; wl[4 * D + k] = w1[0]; wl[5 * D + k] = w1[1]; wl[6 * D + k] = w1[2]; wl[7 * D + k] = w1[3];
    }
    __syncthreads();
    f32x4 nx[4];
    if (F.gw < T) {
#pragma unroll
        for (int j = 0; j < 4; ++j) nx[j] = ((const GAS f32x4*)(x + (size_t)F.gw * D))[j * 64 + lane];
    }
    for (int row = F.gw; row < T; row += F.ngw) {
        f32x4 v[4]; float ss = 0.f;
#pragma unroll
        for (int j = 0; j < 4; ++j) { v[j] = nx[j]; ss += (v[j][0] * v[j][0] + v[j][1] * v[j][1]) + (v[j][2] * v[j][2] + v[j][3] * v[j][3]); }
        if (row + F.ngw < T) {
#pragma unroll
            for (int j = 0; j < 4; ++j) nx[j] = ((const GAS f32x4*)(x + (size_t)(row + F.ngw) * D))[j * 64 + lane];
        }
        ss = wave_sum(ss);
        const float rs = rsqrtf(ss * (1.0f / D) + EPS);
#pragma unroll
        for (int j = 0; j < 4; ++j) v[j] = v[j] * gr[j * 64 + lane] * rs;
#pragma unroll
        for (int j = 0; j < 4; ++j) { typedef unsigned u32x2_ __attribute__((ext_vector_type(2))); u32x2_ o; o[0] = pk2(v[j][0], v[j][1]); o[1] = pk2(v[j][2], v[j][3]); *(GAS u32x2_*)(out + (size_t)row * D + (j * 64 + lane) * 4) = o; }
        float a[8];
#pragma unroll
        for (int hh = 0; hh < 8; ++hh) { float s = 0.f;
#pragma unroll
            for (int j = 0; j < 4; ++j) { const f32x4 w = *(const LAS f32x4*)(wl + hh * D + (j * 64 + lane) * 4); s += (v[j][0] * w[0] + v[j][1] * w[1]) + (v[j][2] * w[2] + v[j][3] * w[3]); }
            a[hh] = wave_sum(s); }
        if (lane < 8) {
            float f = lane == 0 ? a[0] : lane == 1 ? a[1] : lane == 2 ? a[2] : lane == 3 ? a[3] : lane == 4 ? a[4] : lane == 5 ? a[5] : lane == 6 ? a[6] : a[7];
            f += bfg[lane];
            logf[(size_t)row * 8 + lane] = fminf(f, 0.f) - log1pf(expf(-fabsf(f)));
        }
    }
    __syncthreads();
}
__device__ __forceinline__ void ph_cumsum(Frame& F, const float* logfp_, float* cump_) {
    const int lane = F.lane;
    const GAS float* logf = (const GAS float*)logfp_; GAS float* cum = (GAS float*)cump_;
    for (int task = F.gw; task < 64; task += F.ngw) {
        const int b = task >> 3, hh = task & 7;
        float v[32];
#pragma unroll
        for (int i = 0; i < 32; ++i) v[i] = logf[((size_t)(b * S + lane * 32 + i)) * 8 + hh];
#pragma unroll
        for (int i = 1; i < 32; ++i) v[i] += v[i - 1];
        float tot = v[31];
#pragma unroll
        for (int o = 1; o < 64; o <<= 1) { const float n = bperm_f(lane - o, tot); if (lane >= o) tot += n; }
        const float base = tot - v[31];
        GAS float* cp = cum + (size_t)task * S + lane * 32;
#pragma unroll
        for (int i = 0; i < 32; i += 4) { f32x4 o4 = {(v[i] + base) * LOG2E, (v[i + 1] + base) * LOG2E, (v[i + 2] + base) * LOG2E, (v[i + 3] + base) * LOG2E}; *(GAS f32x4*)(cp + i) = o4; }
    }
}
namespace att {
typedef float f32x16 __attribute__((ext_vector_type(16)));
typedef short s16x4 __attribute__((ext_vector_type(4)));
typedef short v4i16_t __attribute__((ext_vector_type(4)));
typedef unsigned u32x4 __attribute__((ext_vector_type(4)));
typedef float f32x2_t __attribute__((ext_vector_type(2))); typedef __bf16 bf16x2_t __attribute__((ext_vector_type(2)));
__device__ __forceinline__ int crow(int r, int hi) { return (r & 3) + 8 * (r >> 2) + 4 * hi; }
__device__ __forceinline__ unsigned cvtpk(float lo, float hi) { f32x2_t v = {lo, hi}; bf16x2_t b = __builtin_convertvector(v, bf16x2_t); return __builtin_bit_cast(unsigned, b); }
__device__ __forceinline__ void glds16(const void* gsrc, unsigned lds_dst) { unsigned keep;
    asm volatile("s_mov_b32 %0, m0\n\ts_mov_b32 m0, %2\n\ts_nop 0\n\tglobal_load_lds_dwordx4 %1, off\n\ts_mov_b32 m0, %0" : "=&s"(keep) : "v"(gsrc), "s"(lds_dst) : "memory"); }
__device__ __forceinline__ void glds16s(const void* gbase  , unsigned voff, unsigned lds_dst) { unsigned keep;
    asm volatile("s_mov_b32 %0, m0\n\ts_mov_b32 m0, %3\n\ts_nop 0\n\tglobal_load_lds_dwordx4 %1, %2\n\ts_mov_b32 m0, %0" : "=&s"(keep) : "v"(voff), "s"(gbase), "s"(lds_dst) : "memory"); }
#define ATT_WAIT_BAR() asm volatile("s_waitcnt vmcnt(0) lgkmcnt(0)\n\ts_barrier" ::: "memory")
#define ATT_MFMA(a, b, c) __builtin_amdgcn_mfma_f32_32x32x16_bf16(a, b, c, 0, 0, 0)
__device__ __forceinline__ s16x4 vtr(const LAS unsigned char* p) { return __builtin_bit_cast(s16x4, __builtin_amdgcn_ds_read_tr16_b64_v4i16((LAS v4i16_t*)p)); }
#define FX_SBAR() __builtin_amdgcn_sched_barrier(0)
#define FX_PIN(x) asm volatile("" : "+v"(x))
#define FX_WAIT_BAR(N) asm volatile("s_waitcnt vmcnt(" #N ") lgkmcnt(0)\n\ts_barrier" ::: "memory")
#define FX_MX3(a, b, c) __builtin_fmaxf(__builtin_fmaxf((a), (b)), (c))
__device__ __forceinline__ unsigned fx_cvtpk(float lo, float hi) { unsigned r; asm("v_cvt_pk_bf16_f32 %0, %1, %2" : "=v"(r) : "v"(lo), "v"(hi)); return r; }
__device__ __forceinline__ float fx_rowmax(const f32x16& p0, const f32x16& p1) {
    float a = FX_MX3(p0[0], p0[1], p1[0]), b = FX_MX3(p0[2], p0[3], p1[1]); a = FX_MX3(a, p1[2], p1[3]);
#pragma unroll
    for (int r = 4; r < 16; r += 4) { a = FX_MX3(a, p0[r], p0[r + 1]); b = FX_MX3(b, p0[r + 2], p0[r + 3]); a = FX_MX3(a, p1[r], p1[r + 1]); b = FX_MX3(b, p1[r + 2], p1[r + 3]); }
    float m = __builtin_fmaxf(a, b); auto rr = __builtin_amdgcn_permlane32_swap(__float_as_uint(m), __float_as_uint(m), false, false);
    return __builtin_fmaxf(__uint_as_float(rr[0]), __uint_as_float(rr[1])); }
__device__ __forceinline__ void fx_cmask(f32x16& p0, f32x16& p1, int jb, int qrel, int hi) {
    const int kb = 64 * jb + 4 * hi;
#pragma unroll
    for (int r = 0; r < 16; ++r) { const int kv = kb + (r & 3) + 8 * (r >> 2); if (kv > qrel) p0[r] = -INFINITY; if (kv + 32 > qrel) p1[r] = -INFINITY; } }

__device__ __forceinline__ void fox_unit(LAS unsigned char* lds, int tid, int b, int h, int qb, const bf16_t* Q, const bf16_t* K, const bf16_t* V, bf16_t* Y, const float* cum) {
    constexpr int QB = 256, SLOTB = 8192, LDS_K = 0, LDS_V = 3 * SLOTB, LDS_WS = 6 * SLOTB, LDS_TAB = LDS_WS + 2048, LDS_OST = LDS_TAB + 8192;
    constexpr float FTHR = 40.0f;
    int tid_ = tid; asm volatile("" : "+v"(tid_));
    const int lane = tid_ & 63, r32 = lane & 31, hi = lane >> 5, wid = __builtin_amdgcn_readfirstlane(tid_ >> 6);
    const int q0 = qb * QB, NT = (q0 + QB) / 64;
    const size_t rowbase = (size_t)b * S;
    const int hcol = h * 64;
    const bf16_t* Qw = Q + (rowbase + q0 + wid * 32) * 512 + hcol;
    const bf16_t* Kh = K + rowbase * 512 + hcol;
    const bf16_t* Vh = V + rowbase * 512 + hcol;
    const unsigned lds0 = (unsigned)(uintptr_t)lds;
    LAS float* wsf = (LAS float*)(lds + LDS_WS) + wid * 64;
    LAS float* tab = (LAS float*)(lds + LDS_TAB);
    const int qrel = wid * 32 + r32, qpos = q0 + qrel;
    const GAS float* cumg = (const GAS float*)cum;
    const bf16_t* ksrc = Kh + (size_t)(8 * wid + (lane & 7)) * 512 + (lane >> 3) * 8;
    const int vrow = lane >> 3, vslot = lane & 7;
    const int vchunk = (((vslot >> 2) ^ ((vrow >> 1) & 1)) << 2) | (vslot & 3);
    const bf16_t* vsrc = Vh + (size_t)(8 * wid + vrow) * 512 + vchunk * 8;
    const unsigned kdst = lds0 + LDS_K + wid * 1024, vdst = lds0 + LDS_V + wid * 1024;
#define FX_DMA_K(t, slot) glds16(ksrc + (size_t)(t) * 64 * 512, (unsigned)__builtin_amdgcn_readfirstlane(kdst + (slot)))
#define FX_DMA_V(t, slot) glds16(vsrc + (size_t)(t) * 64 * 512, (unsigned)__builtin_amdgcn_readfirstlane(vdst + (slot)))
    const int vq = (lane & 15) >> 2;
    const LAS unsigned char* vp0 = lds + LDS_V + ((lane >> 4) & 1) * 32 + (lane & 3) * 8 + (4 * hi + vq) * 128;
    const int vsw0 = ((vq >> 1) & 1) * 64, vsw1 = vsw0 ^ 64;
    const LAS unsigned char* kp0 = lds + LDS_K + (r32 >> 3) * 1024 + (r32 & 7) * 16 + hi * 128;
    const LAS float* cp0 = tab + 4 * hi;
    FX_DMA_K(0, 0); FX_DMA_V(0, 0); FX_DMA_K(1, SLOTB); FX_DMA_K(2, 2 * SLOTB);
    if (tid_ * 4 < q0 + QB) { const f32x4 c4 = ((const GAS f32x4*)cumg)[tid_]; ((LAS f32x4*)tab)[tid_] = (f32x4){-c4[0], -c4[1], -c4[2], -c4[3]}; }
    bf16x8 qr[4];
#pragma unroll
    for (int d0 = 0; d0 < 4; ++d0) qr[d0] = *(const GAS bf16x8*)(Qw + (size_t)r32 * 512 + d0 * 16 + hi * 8);
    float cq = cumg[qpos];
    asm volatile("" : "+v"(qr[0]), "+v"(qr[1]), "+v"(qr[2]), "+v"(qr[3]), "+v"(cq));
    float mhat = 0.f, l_reg = 0.f; f32x16 o[2]; o[0] = f32x16{}; o[1] = f32x16{};
    bool resc = false;
    f32x16 pA0, pA1, pB0, pB1; bf16x8 kf[8]; s16x4 vlo[8], vhi[8]; u32x4 pw0, pw1, pw2, pw3;
    int sl_prev = 0, sl_cur = 0, sl_next = SLOTB;
#define FX_ROT() do { sl_prev = sl_cur; sl_cur = sl_next; sl_next = (sl_next == 2 * SLOTB) ? 0 : sl_next + SLOTB; } while (0)
#define FX_EX(v) __builtin_amdgcn_exp2f((v) + nmh)
#define FX_RESC() do { if (resc) { _Pragma("unroll") for (int g_ = 0; g_ < 4; ++g_) { const f32x4 a4 = *(const LAS f32x4*)(wsf + 8 * g_ + 4 * hi); \
        _Pragma("unroll") for (int d_ = 0; d_ < 2; ++d_) { o[d_][4 * g_] *= a4[0]; o[d_][4 * g_ + 1] *= a4[1]; o[d_][4 * g_ + 2] *= a4[2]; o[d_][4 * g_ + 3] *= a4[3]; } } } } while (0)
#define FX_KLOAD2(kp, d0) do { kf[2 * (d0)] = *(const LAS bf16x8*)((kp) + (d0) * 256); kf[2 * (d0) + 1] = *(const LAS bf16x8*)((kp) + (d0) * 256 + 4096); } while (0)
#define FX_CLOAD(X0, X1, cp, g) do { const f32x4 c0_ = *(const LAS f32x4*)((cp) + 8 * (g)), c1_ = *(const LAS f32x4*)((cp) + 32 + 8 * (g)); \
        X0[4 * (g)] = c0_[0]; X0[4 * (g) + 1] = c0_[1]; X0[4 * (g) + 2] = c0_[2]; X0[4 * (g) + 3] = c0_[3]; X1[4 * (g)] = c1_[0]; X1[4 * (g) + 1] = c1_[1]; X1[4 * (g) + 2] = c1_[2]; X1[4 * (g) + 3] = c1_[3]; } while (0)
    FX_WAIT_BAR(3);
#pragma unroll
    for (int d0 = 0; d0 < 4; ++d0) FX_KLOAD2(kp0, d0);
#pragma unroll
    for (int g = 0; g < 4; ++g) FX_CLOAD(pA0, pA1, cp0, g);
    pA0 = ATT_MFMA(kf[0], qr[0], pA0); pA1 = ATT_MFMA(kf[1], qr[0], pA1); pA0 = ATT_MFMA(kf[2], qr[1], pA0); pA1 = ATT_MFMA(kf[3], qr[1], pA1);
    pA0 = ATT_MFMA(kf[4], qr[2], pA0); pA1 = ATT_MFMA(kf[5], qr[2], pA1); pA0 = ATT_MFMA(kf[6], qr[3], pA0); pA1 = ATT_MFMA(kf[7], qr[3], pA1);
    if (NT == 4) fx_cmask(pA0, pA1, 0, qrel, hi);
    { const float rm = fx_rowmax(pA0, pA1); mhat = rm + cq; const float nmh = cq - mhat;
#pragma unroll
      for (int r = 0; r < 16; ++r) { pA0[r] = FX_EX(pA0[r]); pA1[r] = FX_EX(pA1[r]); } }
    FX_WAIT_BAR(0);
    FX_DMA_K(3, 0); FX_DMA_V(1, SLOTB); FX_ROT();
#pragma unroll
    for (int d0 = 0; d0 < 4; ++d0) FX_KLOAD2(kp0 + sl_cur, d0);
#pragma unroll
    for (int g = 0; g < 4; ++g) FX_CLOAD(pB0, pB1, cp0 + 64, g);
    FX_WAIT_BAR(2);
#define FX_PKW(P, i) fx_cvtpk(P[i], P[i + 1])
#define FX_PAF(k) __builtin_bit_cast(bf16x8, pw##k)
#define FX_VFR(i) (bf16x8){vlo[i][0], vlo[i][1], vlo[i][2], vlo[i][3], vhi[i][0], vhi[i][1], vhi[i][2], vhi[i][3]}
#define FX_VRD(i) do { vlo[i] = vtr(vp_ + ((((i) >> 2) ? vsw1 : vsw0) + ((i) & 3) * 2048)); vhi[i] = vtr(vp_ + ((((i) >> 2) ? vsw1 : vsw0) + ((i) & 3) * 2048 + 1024)); } while (0)
#define FX_KRD(G, d0) do { if (G) { FX_KLOAD2(kp0 + sl_next, d0); FX_SBAR(); } } while (0)
#define FX_CRD(G, X0, X1, t, g) do { if (G) { FX_CLOAD(X0, X1, cp0 + 64 * ((t) + 1), g); FX_SBAR(); } } while (0)
#define FX_GAPA(MF, a0, a1, a2, a3, W0, W1, PW) do { MF; sacc += a0; sacc += a1; sacc += a2; sacc += a3; W0; W1; FX_PIN(PW); FX_PIN(sacc); FX_SBAR(); } while (0)
#define FX_GAPB(MF, X, i) do { MF; X[i] = FX_EX(X[i]); X[i + 1] = FX_EX(X[i + 1]); X[i + 2] = FX_EX(X[i + 2]); X[i + 3] = FX_EX(X[i + 3]); FX_PIN(X); FX_SBAR(); } while (0)
#define FX_STEP(C0, C1, P0, P1, t, MASK, GK, GV, GL) do { FX_SBAR(); \
    const LAS unsigned char* vp_ = vp0 + sl_prev; \
    FX_VRD(0); FX_SBAR(); float sacc = P0[0] + P0[1]; \
                       FX_GAPA(C0 = ATT_MFMA(kf[0], qr[0], C0), P0[2], P0[3], P0[4], P0[5],     pw0[0] = FX_PKW(P0, 0),  pw0[1] = FX_PKW(P0, 2),  pw0); \
    FX_VRD(4); FX_SBAR(); FX_GAPA(C1 = ATT_MFMA(kf[1], qr[0], C1), P0[6], P0[7], P0[8], P0[9],     pw0[2] = FX_PKW(P0, 4),  pw0[3] = FX_PKW(P0, 6),  pw0); \
    if (GK) { FX_DMA_K((t) + 3, sl_cur); FX_SBAR(); }                                                                \
    FX_VRD(1); FX_SBAR(); FX_GAPA(C0 = ATT_MFMA(kf[2], qr[1], C0),    P0[10], P0[11], P0[12], P0[13], pw1[0] = FX_PKW(P0, 8),  pw1[1] = FX_PKW(P0, 10), pw1); \
    FX_VRD(5); FX_SBAR(); FX_GAPA(C1 = ATT_MFMA(kf[3], qr[1], C1),    P0[14], P0[15], P1[0], P1[1],   pw1[2] = FX_PKW(P0, 12), pw1[3] = FX_PKW(P0, 14), pw1); \
    if (GV) { FX_DMA_V((t) + 1, sl_next); FX_SBAR(); } \
    FX_VRD(2); FX_SBAR(); FX_GAPA(C0 = ATT_MFMA(kf[4], qr[2], C0),    P1[2], P1[3], P1[4], P1[5],     pw2[0] = FX_PKW(P1, 0),  pw2[1] = FX_PKW(P1, 2),  pw2); \
    FX_VRD(6); FX_SBAR(); FX_GAPA(C1 = ATT_MFMA(kf[5], qr[2], C1),    P1[6], P1[7], P1[8], P1[9],     pw2[2] = FX_PKW(P1, 4),  pw2[3] = FX_PKW(P1, 6),  pw2); \
    FX_VRD(3); FX_SBAR(); FX_GAPA(C0 = ATT_MFMA(kf[6], qr[3], C0),    P1[10], P1[11], P1[12], P1[13], pw3[0] = FX_PKW(P1, 8),  pw3[1] = FX_PKW(P1, 10), pw3); \
    FX_VRD(7); FX_SBAR(); FX_GAPA(C1 = ATT_MFMA(kf[7], qr[3], C1),    P1[14], P1[15], 0.f, 0.f,       pw3[2] = FX_PKW(P1, 12), pw3[3] = FX_PKW(P1, 14), pw3); \
    l_reg += sacc; \
    if (MASK) fx_cmask(C0, C1, (t) - (NT - 4), qrel, hi); \
    { const float rm = fx_rowmax(C0, C1) + (cq - mhat); resc = false;                                      \
      if (__builtin_expect(__any(rm > FTHR), 0)) { const float dl = __builtin_fmaxf(rm, 0.f); mhat += dl;     \
          const float f = __builtin_amdgcn_exp2f(-dl); l_reg *= f; if (hi == 0) wsf[r32] = f; resc = true; } } \
    const float nmh = cq - mhat; FX_SBAR(); \
    FX_CRD(GL, P0, P1, t, 0); FX_GAPB(o[0] = ATT_MFMA(FX_PAF(0), FX_VFR(0), o[0]), C0, 0);  FX_CRD(GL, P0, P1, t, 1); FX_GAPB(o[1] = ATT_MFMA(FX_PAF(0), FX_VFR(4), o[1]), C0, 4); \
    FX_KRD(GL, 0); FX_GAPB(o[0] = ATT_MFMA(FX_PAF(1), FX_VFR(1), o[0]), C0, 8);  FX_KRD(GL, 1); FX_GAPB(o[1] = ATT_MFMA(FX_PAF(1), FX_VFR(5), o[1]), C0, 12); \
    FX_KRD(GL, 2); FX_GAPB(o[0] = ATT_MFMA(FX_PAF(2), FX_VFR(2), o[0]), C1, 0);  FX_KRD(GL, 3); FX_GAPB(o[1] = ATT_MFMA(FX_PAF(2), FX_VFR(6), o[1]), C1, 4); \
    FX_CRD(GL, P0, P1, t, 2); FX_GAPB(o[0] = ATT_MFMA(FX_PAF(3), FX_VFR(3), o[0]), C1, 8);  FX_CRD(GL, P0, P1, t, 3); FX_GAPB(o[1] = ATT_MFMA(FX_PAF(3), FX_VFR(7), o[1]), C1, 12); \
    } while (0)
    int t = 1;
    for (; t + 5 < NT; t += 2) {
        FX_STEP(pB0, pB1, pA0, pA1, t, false, true, true, true);     FX_WAIT_BAR(2); FX_RESC(); FX_ROT();
        FX_STEP(pA0, pA1, pB0, pB1, t + 1, false, true, true, true); FX_WAIT_BAR(2); FX_RESC(); FX_ROT();
    }
#define FX_ENDW(tt) do { if ((tt) + 3 < NT) { FX_WAIT_BAR(2); } else if ((tt) + 2 < NT) { FX_WAIT_BAR(1); } else { FX_WAIT_BAR(0); } } while (0)
    for (; t + 1 < NT; t += 2) {
        FX_STEP(pB0, pB1, pA0, pA1, t, true, (t + 3 < NT), (t + 1 < NT), (t + 1 < NT));         FX_ENDW(t);     FX_RESC(); FX_ROT();
        FX_STEP(pA0, pA1, pB0, pB1, t + 1, true, (t + 4 < NT), (t + 2 < NT), (t + 2 < NT));     FX_ENDW(t + 1); FX_RESC(); FX_ROT();
    }
    FX_STEP(pB0, pB1, pA0, pA1, NT - 1, true, false, false, false); FX_RESC();
    { float sacc = pB0[0] + pB0[1];
#pragma unroll
      for (int r = 2; r < 16; ++r) sacc += pB0[r];
#pragma unroll
      for (int r = 0; r < 16; ++r) sacc += pB1[r];
      l_reg += sacc;
      pw0 = (u32x4){FX_PKW(pB0, 0), FX_PKW(pB0, 2), FX_PKW(pB0, 4), FX_PKW(pB0, 6)}; pw1 = (u32x4){FX_PKW(pB0, 8), FX_PKW(pB0, 10), FX_PKW(pB0, 12), FX_PKW(pB0, 14)};
      pw2 = (u32x4){FX_PKW(pB1, 0), FX_PKW(pB1, 2), FX_PKW(pB1, 4), FX_PKW(pB1, 6)}; pw3 = (u32x4){FX_PKW(pB1, 8), FX_PKW(pB1, 10), FX_PKW(pB1, 12), FX_PKW(pB1, 14)};
      const LAS unsigned char* vp_ = vp0 + sl_cur;
#pragma unroll
      for (int i = 0; i < 8; ++i) FX_VRD(i);
      o[0] = ATT_MFMA(FX_PAF(0), FX_VFR(0), o[0]); o[1] = ATT_MFMA(FX_PAF(0), FX_VFR(4), o[1]); o[0] = ATT_MFMA(FX_PAF(1), FX_VFR(1), o[0]); o[1] = ATT_MFMA(FX_PAF(1), FX_VFR(5), o[1]);
      o[0] = ATT_MFMA(FX_PAF(2), FX_VFR(2), o[0]); o[1] = ATT_MFMA(FX_PAF(2), FX_VFR(6), o[1]); o[0] = ATT_MFMA(FX_PAF(3), FX_VFR(3), o[0]); o[1] = ATT_MFMA(FX_PAF(3), FX_VFR(7), o[1]); }
    { auto rr = __builtin_amdgcn_permlane32_swap(__float_as_uint(l_reg), __float_as_uint(l_reg), false, false); l_reg = __uint_as_float(rr[0]) + __uint_as_float(rr[1]); }
    if (hi == 0) wsf[32 + r32] = 1.0f / l_reg;
    asm volatile("s_waitcnt lgkmcnt(0)" ::: "memory");
    float rli[16];
#pragma unroll
    for (int g = 0; g < 4; ++g) { const f32x4 a4 = *(const LAS f32x4*)(wsf + 32 + 8 * g + 4 * hi); rli[4 * g] = a4[0]; rli[4 * g + 1] = a4[1]; rli[4 * g + 2] = a4[2]; rli[4 * g + 3] = a4[3]; }
    LAS bf16_t* stg = (LAS bf16_t*)(lds + LDS_OST) + wid * 2048;
#pragma unroll
    for (int db = 0; db < 2; ++db)
#pragma unroll
        for (int r = 0; r < 16; ++r) stg[crow(r, hi) * 64 + db * 32 + r32] = (bf16_t)f2bf(o[db][r] * rli[r]);
    asm volatile("s_waitcnt lgkmcnt(0)" ::: "memory");
    bf16_t* Yw = Y + (rowbase + q0 + wid * 32) * 512 + hcol;
#pragma unroll
    for (int i = 0; i < 4; ++i) { const int row = i * 8 + (lane >> 3), ch = lane & 7; const u32x4 v = *(const LAS u32x4*)(stg + row * 64 + ch * 8); *(GAS u32x4*)(Yw + (size_t)row * 512 + ch * 8) = v; }
    ATT_WAIT_BAR();
#undef FX_DMA_K
#undef FX_DMA_V
#undef FX_ROT
#undef FX_EX
#undef FX_RESC
#undef FX_KLOAD2
#undef FX_CLOAD
#undef FX_PKW
#undef FX_PAF
#undef FX_VFR
#undef FX_VRD
#undef FX_KRD
#undef FX_CRD
#undef FX_ENDW
#undef FX_GAPA
#undef FX_GAPB
#undef FX_STEP
}
__device__ __forceinline__ float fx_max3(float a, float b, float c) { float r; asm("v_max3_f32 %0, %1, %2, %3" : "=v"(r) : "v"(a), "v"(b), "v"(c)); return r; }
__device__ __forceinline__ void diff_unit(LAS unsigned char* lds, int tid, int b, int h, int qb, const bf16_t* Q, const bf16_t* K, const bf16_t* V, bf16_t* Y,
                                          const float* aux  , float lam, float lnscale, const float* subg) {
    constexpr int QB = 128, SLOTB = 16384, LDS_K = 0, LDS_V = 3 * SLOTB, LDS_WS = 6 * SLOTB, LDS_TAB = LDS_WS + 2048, LDS_OST = LDS_TAB + 2048;
    constexpr float DTHR = 48.0f;
    int tid_ = tid; asm volatile("" : "+v"(tid_));
    const int lane = tid_ & 63, r32 = lane & 31, hi = lane >> 5, wid = __builtin_amdgcn_readfirstlane(tid_ >> 6);
    const int qg = wid & 3, m = wid >> 2;
    const int q0 = qb * QB, NT = (q0 + QB) / 64;
    const size_t rowbase = (size_t)b * S;
    const int hcol = h * 128;
    const bf16_t* Qw = Q + (rowbase + q0 + qg * 32) * 512 + hcol + m * 64;
    const bf16_t* Kh = K + rowbase * 512 + hcol;
    const bf16_t* Vh = V + rowbase * 512 + hcol;
    const unsigned lds0 = (unsigned)(uintptr_t)lds;
    LAS float* wsf = (LAS float*)(lds + LDS_WS) + wid * 64;
    LAS float* tab = (LAS float*)(lds + LDS_TAB);
    const int qpos = q0 + qg * 32 + r32;
    const unsigned koff = (unsigned)(((8 * wid + (lane & 7)) * 512 + (lane >> 3) * 8) * 2);
    const int vrow = lane >> 4, vslot = lane & 15;
    const int vchunk = (((vslot >> 2) ^ vrow) << 2) | (vslot & 3);
    const unsigned voff = (unsigned)(((4 * wid + vrow) * 512 + vchunk * 8) * 2);
    const unsigned kdst = lds0 + LDS_K + wid * 1024, vdst = lds0 + LDS_V + wid * 1024;
#define DF_DMA_K(t, slot) do { const bf16_t* kb_ = Kh + (size_t)(t) * 64 * 512; glds16s(kb_, koff, (unsigned)__builtin_amdgcn_readfirstlane(kdst + (slot))); glds16s(kb_ + 64, koff, (unsigned)__builtin_amdgcn_readfirstlane(kdst + (slot) + 8192u)); } while (0)
#define DF_DMA_V(t, slot) do { const bf16_t* vb_ = Vh + (size_t)(t) * 64 * 512; glds16s(vb_, voff, (unsigned)__builtin_amdgcn_readfirstlane(vdst + (slot))); glds16s(vb_ + 32 * 512, voff, (unsigned)__builtin_amdgcn_readfirstlane(vdst + (slot) + 8192u)); } while (0)
    const int vq = (lane & 15) >> 2;
    const LAS unsigned char* vp0 = lds + LDS_V + ((lane >> 4) & 1) * 32 + (lane & 3) * 8 + hi * 1024 + vq * 256;
    const LAS unsigned char* kp0 = lds + LDS_K + m * 8192 + (r32 >> 3) * 1024 + (r32 & 7) * 16 + hi * 128;
    DF_DMA_K(0, 0); DF_DMA_V(0, 0); DF_DMA_K(1, SLOTB); DF_DMA_K(2, 2 * SLOTB);
    {
        const GAS float* auxg = (const GAS float*)aux; const int i_ = tid_ - 128;
        tab[tid_] = i_ < 0 ? -INFINITY : (i_ < 128 ? auxg[i_] - auxg[128] : 0.f);
    }
    bf16x8 qr[4];
#pragma unroll
    for (int d0 = 0; d0 < 4; ++d0) qr[d0] = *(const GAS bf16x8*)(Qw + (size_t)r32 * 512 + d0 * 16 + hi * 8);
    asm volatile("" : "+v"(qr[0]), "+v"(qr[1]), "+v"(qr[2]), "+v"(qr[3]));
    float mhat = 0.f, l_reg = 0.f, fP = 1.f; f32x16 o[4];
#pragma unroll
    for (int db = 0; db < 4; ++db) o[db] = f32x16{};
    bool rescP = false, rescN = false;
    f32x16 pA0, pA1, pB0, pB1; bf16x8 kf[8]; s16x4 vlo[2][4], vhi[2][4]; u32x4 pw0, pw1, pw2, pw3;
    int sl_prev = 0, sl_cur = 0, sl_next = SLOTB;
#define DF_ROT() do { sl_prev = sl_cur; sl_cur = sl_next; sl_next = (sl_next == 2 * SLOTB) ? 0 : sl_next + SLOTB; } while (0)
#define DF_EX(v) __builtin_amdgcn_exp2f(v)
#define DF_RESC(par) do { if (rescP) { _Pragma("unroll") for (int g_ = 0; g_ < 4; ++g_) { const f32x4 a4 = *(const LAS f32x4*)(wsf + 32 * (par) + 8 * g_ + 4 * hi); \
        _Pragma("unroll") for (int d_ = 0; d_ < 4; ++d_) { o[d_][4 * g_] *= a4[0]; o[d_][4 * g_ + 1] *= a4[1]; o[d_][4 * g_ + 2] *= a4[2]; o[d_][4 * g_ + 3] *= a4[3]; } } } rescP = rescN; } while (0)
#define DF_KLOAD2(kp, d0) do { kf[2 * (d0)] = *(const LAS bf16x8*)((kp) + (d0) * 256); kf[2 * (d0) + 1] = *(const LAS bf16x8*)((kp) + (d0) * 256 + 4096); } while (0)
#define DF_CINIT(C0, C1, t) do { const LAS float* tp_ = tab + (qpos - ((t) * 64 + 4 * hi) + 128 - 59); \
        _Pragma("unroll") for (int r = 0; r < 16; ++r) { C0[r] = tp_[59 - ((r & 3) + 8 * (r >> 2))]; C1[r] = tp_[59 - 32 - ((r & 3) + 8 * (r >> 2))]; } } while (0)
#define DF_DECIDE(C0, C1, par) do { const float rm_ = fx_rowmax(C0, C1); rescN = false; float fN_ = 1.f; \
        if (__builtin_expect(__any(rm_ > DTHR), 0)) { const float dl_ = __builtin_fmaxf(rm_, 0.f); mhat += dl_; fN_ = __builtin_amdgcn_exp2f(-dl_); if (hi == 0) wsf[32 * (par) + r32] = fN_; rescN = true; } \
        fNext = fN_; } while (0)
#define DF_DECIDE2(par) do { float rm_ = mx; { auto rr_ = __builtin_amdgcn_permlane32_swap(__float_as_uint(rm_), __float_as_uint(rm_), false, false); rm_ = __builtin_fmaxf(__uint_as_float(rr_[0]), __uint_as_float(rr_[1])); } \
        rescN = false; float fN_ = 1.f; \
        if (__builtin_expect(__any(rm_ > DTHR), 0)) { const float dl_ = __builtin_fmaxf(rm_, 0.f); mhat += dl_; fN_ = __builtin_amdgcn_exp2f(-dl_); if (hi == 0) wsf[32 * (par) + r32] = fN_; rescN = true; } \
        fNext = fN_; } while (0)
    float fNext = 1.f;
    asm volatile("s_waitcnt vmcnt(6) lgkmcnt(0)\n\ts_barrier" ::: "memory");
#pragma unroll
    for (int d0 = 0; d0 < 4; ++d0) DF_KLOAD2(kp0, d0);
    if (NT <= 4) { DF_CINIT(pA0, pA1, 0); pA0 = ATT_MFMA(kf[0], qr[0], pA0); pA1 = ATT_MFMA(kf[1], qr[0], pA1); }
    else { pA0 = ATT_MFMA(kf[0], qr[0], f32x16{}); pA1 = ATT_MFMA(kf[1], qr[0], f32x16{}); }
    pA0 = ATT_MFMA(kf[2], qr[1], pA0); pA1 = ATT_MFMA(kf[3], qr[1], pA1);
    pA0 = ATT_MFMA(kf[4], qr[2], pA0); pA1 = ATT_MFMA(kf[5], qr[2], pA1); pA0 = ATT_MFMA(kf[6], qr[3], pA0); pA1 = ATT_MFMA(kf[7], qr[3], pA1);
    DF_DECIDE(pA0, pA1, 0);
#pragma unroll
    for (int r = 0; r < 16; ++r) { pA0[r] = DF_EX(pA0[r]); pA1[r] = DF_EX(pA1[r]); }
    rescP = rescN; fP = fNext;
    asm volatile("s_waitcnt vmcnt(0) lgkmcnt(0)\n\ts_barrier" ::: "memory");
    DF_DMA_K(3, 0); DF_DMA_V(1, SLOTB); DF_ROT();
#pragma unroll
    for (int d0 = 0; d0 < 4; ++d0) DF_KLOAD2(kp0 + sl_cur, d0);
    asm volatile("s_waitcnt vmcnt(4) lgkmcnt(0)\n\ts_barrier" ::: "memory");
#define DF_PKW(P, i) fx_cvtpk(P[i], P[i + 1])
#define DF_PAF(k) __builtin_bit_cast(bf16x8, pw##k)
#define DF_VFR(bf, db) (bf16x8){vlo[bf][db][0], vlo[bf][db][1], vlo[bf][db][2], vlo[bf][db][3], vhi[bf][db][0], vhi[bf][db][1], vhi[bf][db][2], vhi[bf][db][3]}
#define DF_VRD(bf, ks, i) do { if (((i) & 1) == 0) vlo[bf][(i) >> 1] = vtr(vp_ + ((((i) >> 1) ^ vq) * 64 + (ks) * 4096)); else vhi[bf][(i) >> 1] = vtr(vp_ + ((((i) >> 1) ^ vq) * 64 + (ks) * 4096 + 2048)); } while (0)
#define DF_VRD2(bf, ks, i) do { DF_VRD(bf, ks, i); DF_VRD(bf, ks, (i) + 1); FX_SBAR(); } while (0)
#define DF_KRD(G, d0) do { if (G) { DF_KLOAD2(kp0 + sl_next, d0); FX_SBAR(); } } while (0)
#define DF_GAPA(MF, a0, a1, a2, a3, W0, W1, PW) do { MF; sacc += a0; sacc += a1; sacc += a2; sacc += a3; W0; W1; FX_PIN(PW); FX_PIN(sacc); FX_SBAR(); } while (0)
#define DF_GAPB(MF, X, i) do { MF; mx = fx_max3(mx, X[i], X[i + 1]); X[i] = DF_EX(X[i]); X[i + 1] = DF_EX(X[i + 1]); FX_PIN(X); FX_PIN(mx); FX_SBAR(); } while (0)
#define DF_STEP(C0, C1, P0, P1, t, par, MASK, GK, GV, GL) do { FX_SBAR(); \
    const LAS unsigned char* vp_ = vp0 + sl_prev; \
    if (MASK) { DF_CINIT(C0, C1, t); FX_SBAR(); } \
    DF_VRD(0, 0, 0); FX_SBAR(); float sacc = P0[0] + P0[1]; float mx = -INFINITY; \
                              DF_GAPA(C0 = ATT_MFMA(kf[0], qr[0], (MASK) ? C0 : f32x16{}), P0[2], P0[3], P0[4], P0[5],     pw0[0] = DF_PKW(P0, 0),  pw0[1] = DF_PKW(P0, 2),  pw0); \
    DF_VRD(0, 0, 1); FX_SBAR(); DF_GAPA(C1 = ATT_MFMA(kf[1], qr[0], (MASK) ? C1 : f32x16{}), P0[6], P0[7], P0[8], P0[9],     pw0[2] = DF_PKW(P0, 4),  pw0[3] = DF_PKW(P0, 6),  pw0); \
    if (GK) { DF_DMA_K((t) + 3, sl_cur); FX_SBAR(); }                                                                  \
    DF_VRD(0, 0, 2); FX_SBAR(); DF_GAPA(C0 = ATT_MFMA(kf[2], qr[1], C0),    P0[10], P0[11], P0[12], P0[13], pw1[0] = DF_PKW(P0, 8),  pw1[1] = DF_PKW(P0, 10), pw1); \
    DF_VRD(0, 0, 3); FX_SBAR(); DF_GAPA(C1 = ATT_MFMA(kf[3], qr[1], C1),    P0[14], P0[15], P1[0], P1[1],   pw1[2] = DF_PKW(P0, 12), pw1[3] = DF_PKW(P0, 14), pw1); \
    if (GV) { DF_DMA_V((t) + 1, sl_next); FX_SBAR(); } \
    DF_VRD(0, 0, 4); FX_SBAR(); DF_GAPA(C0 = ATT_MFMA(kf[4], qr[2], C0),    P1[2], P1[3], P1[4], P1[5],     pw2[0] = DF_PKW(P1, 0),  pw2[1] = DF_PKW(P1, 2),  pw2); \
    DF_VRD(0, 0, 5); FX_SBAR(); DF_GAPA(C1 = ATT_MFMA(kf[5], qr[2], C1),    P1[6], P1[7], P1[8], P1[9],     pw2[2] = DF_PKW(P1, 4),  pw2[3] = DF_PKW(P1, 6),  pw2); \
    DF_VRD(0, 0, 6); FX_SBAR(); DF_GAPA(C0 = ATT_MFMA(kf[6], qr[3], C0),    P1[10], P1[11], P1[12], P1[13], pw3[0] = DF_PKW(P1, 8),  pw3[1] = DF_PKW(P1, 10), pw3); \
    DF_VRD(0, 0, 7); FX_SBAR(); DF_GAPA(C1 = ATT_MFMA(kf[7], qr[3], C1),    P1[14], P1[15], 0.f, 0.f,       pw3[2] = DF_PKW(P1, 12), pw3[3] = DF_PKW(P1, 14), pw3); \
    l_reg = (l_reg + sacc) * fP;                                                                           \
    if (__builtin_expect(!__all(mhat == 0.f), 0)) { _Pragma("unroll") for (int r = 0; r < 16; ++r) { C0[r] -= mhat; C1[r] -= mhat; } }       \
    FX_SBAR(); \
    DF_VRD2(1, 1, 0); DF_GAPB(o[0] = ATT_MFMA(DF_PAF(0), DF_VFR(0, 0), o[0]), C0, 0);   DF_VRD2(1, 1, 2); DF_GAPB(o[1] = ATT_MFMA(DF_PAF(0), DF_VFR(0, 1), o[1]), C0, 2); \
    DF_VRD2(1, 1, 4); DF_GAPB(o[2] = ATT_MFMA(DF_PAF(0), DF_VFR(0, 2), o[2]), C0, 4);   DF_VRD2(1, 1, 6); DF_GAPB(o[3] = ATT_MFMA(DF_PAF(0), DF_VFR(0, 3), o[3]), C0, 6); \
    DF_VRD2(0, 2, 0); DF_GAPB(o[0] = ATT_MFMA(DF_PAF(1), DF_VFR(1, 0), o[0]), C0, 8);   DF_VRD2(0, 2, 2); DF_GAPB(o[1] = ATT_MFMA(DF_PAF(1), DF_VFR(1, 1), o[1]), C0, 10); \
    DF_VRD2(0, 2, 4); DF_GAPB(o[2] = ATT_MFMA(DF_PAF(1), DF_VFR(1, 2), o[2]), C0, 12);  DF_VRD2(0, 2, 6); DF_GAPB(o[3] = ATT_MFMA(DF_PAF(1), DF_VFR(1, 3), o[3]), C0, 14); \
    DF_VRD2(1, 3, 0); DF_GAPB(o[0] = ATT_MFMA(DF_PAF(2), DF_VFR(0, 0), o[0]), C1, 0);   DF_VRD2(1, 3, 2); DF_GAPB(o[1] = ATT_MFMA(DF_PAF(2), DF_VFR(0, 1), o[1]), C1, 2); \
    DF_VRD2(1, 3, 4); DF_GAPB(o[2] = ATT_MFMA(DF_PAF(2), DF_VFR(0, 2), o[2]), C1, 4);   DF_VRD2(1, 3, 6); DF_GAPB(o[3] = ATT_MFMA(DF_PAF(2), DF_VFR(0, 3), o[3]), C1, 6); \
    DF_KRD(GL, 0); DF_GAPB(o[0] = ATT_MFMA(DF_PAF(3), DF_VFR(1, 0), o[0]), C1, 8);      DF_KRD(GL, 1); DF_GAPB(o[1] = ATT_MFMA(DF_PAF(3), DF_VFR(1, 1), o[1]), C1, 10); \
    DF_KRD(GL, 2); DF_GAPB(o[2] = ATT_MFMA(DF_PAF(3), DF_VFR(1, 2), o[2]), C1, 12);     DF_KRD(GL, 3); DF_GAPB(o[3] = ATT_MFMA(DF_PAF(3), DF_VFR(1, 3), o[3]), C1, 14); \
    DF_DECIDE2(par); \
    } while (0)
#define DF_WAIT_BAR(N) asm volatile("s_waitcnt vmcnt(" #N ") lgkmcnt(0)\n\ts_barrier" ::: "memory")
#define DF_AFTER(par_prev) do { DF_RESC(par_prev); fP = fNext; } while (0)
    int t = 1;
    for (; t + 5 < NT; t += 2) {
        DF_STEP(pB0, pB1, pA0, pA1, t, 1, false, true, true, true);     DF_WAIT_BAR(4); DF_AFTER(0); DF_ROT();
        DF_STEP(pA0, pA1, pB0, pB1, t + 1, 0, false, true, true, true); DF_WAIT_BAR(4); DF_AFTER(1); DF_ROT();
    }
#define DF_ENDW(tt) do { if ((tt) + 3 < NT) { DF_WAIT_BAR(4); } else if ((tt) + 2 < NT) { DF_WAIT_BAR(2); } else { DF_WAIT_BAR(0); } } while (0)
    for (; t + 1 < NT; t += 2) {
        DF_STEP(pB0, pB1, pA0, pA1, t, 1, true, (t + 3 < NT), (t + 1 < NT), (t + 1 < NT));         DF_ENDW(t);     DF_AFTER(0); DF_ROT();
        DF_STEP(pA0, pA1, pB0, pB1, t + 1, 0, true, (t + 4 < NT), (t + 2 < NT), (t + 2 < NT));     DF_ENDW(t + 1); DF_AFTER(1); DF_ROT();
    }
    if (NT == 2) DF_WAIT_BAR(0);
    DF_STEP(pB0, pB1, pA0, pA1, NT - 1, 1, true, false, false, false); DF_AFTER(0);
    { float sacc = pB0[0] + pB0[1];
#pragma unroll
      for (int r = 2; r < 16; ++r) sacc += pB0[r];
#pragma unroll
      for (int r = 0; r < 16; ++r) sacc += pB1[r];
      l_reg += sacc;
      pw0 = (u32x4){DF_PKW(pB0, 0), DF_PKW(pB0, 2), DF_PKW(pB0, 4), DF_PKW(pB0, 6)}; pw1 = (u32x4){DF_PKW(pB0, 8), DF_PKW(pB0, 10), DF_PKW(pB0, 12), DF_PKW(pB0, 14)};
      pw2 = (u32x4){DF_PKW(pB1, 0), DF_PKW(pB1, 2), DF_PKW(pB1, 4), DF_PKW(pB1, 6)}; pw3 = (u32x4){DF_PKW(pB1, 8), DF_PKW(pB1, 10), DF_PKW(pB1, 12), DF_PKW(pB1, 14)};
      const LAS unsigned char* vp_ = vp0 + sl_cur;
#pragma unroll
      for (int i = 0; i < 8; ++i) { DF_VRD(0, 0, i); DF_VRD(1, 1, i); }
      o[0] = ATT_MFMA(DF_PAF(0), DF_VFR(0, 0), o[0]); o[1] = ATT_MFMA(DF_PAF(0), DF_VFR(0, 1), o[1]); o[2] = ATT_MFMA(DF_PAF(0), DF_VFR(0, 2), o[2]); o[3] = ATT_MFMA(DF_PAF(0), DF_VFR(0, 3), o[3]);
      o[0] = ATT_MFMA(DF_PAF(1), DF_VFR(1, 0), o[0]); o[1] = ATT_MFMA(DF_PAF(1), DF_VFR(1, 1), o[1]); o[2] = ATT_MFMA(DF_PAF(1), DF_VFR(1, 2), o[2]); o[3] = ATT_MFMA(DF_PAF(1), DF_VFR(1, 3), o[3]);
      FX_SBAR();
#pragma unroll
      for (int i = 0; i < 8; ++i) { DF_VRD(0, 2, i); DF_VRD(1, 3, i); }
      o[0] = ATT_MFMA(DF_PAF(2), DF_VFR(0, 0), o[0]); o[1] = ATT_MFMA(DF_PAF(2), DF_VFR(0, 1), o[1]); o[2] = ATT_MFMA(DF_PAF(2), DF_VFR(0, 2), o[2]); o[3] = ATT_MFMA(DF_PAF(2), DF_VFR(0, 3), o[3]);
      o[0] = ATT_MFMA(DF_PAF(3), DF_VFR(1, 0), o[0]); o[1] = ATT_MFMA(DF_PAF(3), DF_VFR(1, 1), o[1]); o[2] = ATT_MFMA(DF_PAF(3), DF_VFR(1, 2), o[2]); o[3] = ATT_MFMA(DF_PAF(3), DF_VFR(1, 3), o[3]); }
    { auto rr = __builtin_amdgcn_permlane32_swap(__float_as_uint(l_reg), __float_as_uint(l_reg), false, false); l_reg = __uint_as_float(rr[0]) + __uint_as_float(rr[1]); }
    if (hi == 0) wsf[32 + r32] = (m == 1) ? lam / l_reg : 1.0f / l_reg;
    asm volatile("s_waitcnt lgkmcnt(0)" ::: "memory");
    float rli[16];
#pragma unroll
    for (int g = 0; g < 4; ++g) { const f32x4 a4 = *(const LAS f32x4*)(wsf + 32 + 8 * g + 4 * hi); rli[4 * g] = a4[0]; rli[4 * g + 1] = a4[1]; rli[4 * g + 2] = a4[2]; rli[4 * g + 3] = a4[3]; }
    ATT_WAIT_BAR();
    {
        LAS float* xch = (LAS float*)lds + qg * 4096;
        if (m == 1) {
#pragma unroll
            for (int db = 0; db < 4; ++db)
#pragma unroll
                for (int r = 0; r < 16; ++r) xch[(db * 16 + r) * 64 + lane] = o[db][r] * rli[r];
        }
        ATT_WAIT_BAR();
        if (m == 0) {
            float ss[16];
#pragma unroll
            for (int r = 0; r < 16; ++r) ss[r] = 0.f;
#pragma unroll
            for (int db = 0; db < 4; ++db)
#pragma unroll
                for (int r = 0; r < 16; ++r) { const float v = o[db][r] * rli[r] - xch[(db * 16 + r) * 64 + lane]; o[db][r] = v; ss[r] += v * v; }
#pragma unroll
            for (int r = 0; r < 16; ++r) {
                float v = ss[r];
                v = sum32(v);
                ss[r] = rsqrtf(v * (1.0f / 128.0f) + EPS) * lnscale;
            }
            LAS bf16_t* stg = (LAS bf16_t*)(lds + LDS_OST) + qg * 4096;
#pragma unroll
            for (int db = 0; db < 4; ++db) { const float gd = ((const GAS float*)subg)[db * 32 + r32];
#pragma unroll
                for (int r = 0; r < 16; ++r) stg[crow(r, hi) * 128 + db * 32 + r32] = (bf16_t)f2bf(o[db][r] * ss[r] * gd); }
            asm volatile("s_waitcnt lgkmcnt(0)" ::: "memory");
            bf16_t* Yw = Y + (rowbase + q0 + qg * 32) * 512 + hcol;
#pragma unroll
            for (int i = 0; i < 8; ++i) { const int row = i * 4 + (lane >> 4), ch = lane & 15; const u32x4 v = *(const LAS u32x4*)(stg + row * 128 + ch * 8); *(GAS u32x4*)(Yw + (size_t)row * 512 + ch * 8) = v; }
        }
    }
    ATT_WAIT_BAR();
#undef DF_DMA_K
#undef DF_DMA_V
#undef DF_ROT
#undef DF_EX
#undef DF_RESC
#undef DF_KLOAD2
#undef DF_CINIT
#undef DF_DECIDE
#undef DF_DECIDE2
#undef DF_PKW
#undef DF_PAF
#undef DF_VFR
#undef DF_VRD
#undef DF_VRD2
#undef DF_KRD
#undef DF_GAPA
#undef DF_GAPB
#undef DF_STEP
#undef DF_WAIT_BAR
#undef DF_AFTER
#undef DF_ENDW
}
}

__device__ __forceinline__ void ph_attention(Frame& F, const bf16_t* QKV, const float* BT, const float* CUM, const float* lamv, const float* subg, float lam_init, bf16_t* YD, bf16_t* YF) {
    const int vcu = (F.G % 8 == 0) ? (F.bid % 8) * (F.G / 8) + F.bid / 8 : F.bid;
    const float l01 = wave_sum(lamv[F.lane] * lamv[64 + F.lane]), l23 = wave_sum(lamv[128 + F.lane] * lamv[192 + F.lane]);
    const float lam = expf(l01) - expf(l23) + lam_init;
    for (int pi = vcu; pi < 256; pi += F.G) {
        const int bh = pi >> 3, s = pi & 7, b = bh >> 2, h = bh & 3;
        for (int k = 0; k < 2; ++k) {
            att::diff_unit(F.lds, F.tid, b, h, k == 0 ? 15 - s : s, QKV, QKV + (size_t)T * 512, QKV + (size_t)2 * T * 512, YD, BT + h * 129, lam, 1.0f - lam_init, subg);
        }
    }
    for (int pi = vcu; pi < 256; pi += F.G) {
        const int bh = pi >> 2, s = pi & 3, b = bh >> 3, h = bh & 7;
        for (int k = 0; k < 2; ++k) {
            att::fox_unit(F.lds, F.tid, b, h, k == 0 ? 7 - s : s, QKV + (size_t)3 * T * 512, QKV + (size_t)4 * T * 512, QKV + (size_t)5 * T * 512, YF, CUM + (size_t)bh * S);
        }
    }
}
namespace peer {
typedef float f32x2 __attribute__((ext_vector_type(2)));
typedef unsigned v6u __attribute__((ext_vector_type(6)));
typedef unsigned u32x2 __attribute__((ext_vector_type(2)));
typedef float v32f __attribute__((ext_vector_type(32)));
constexpr float USCALE = 64.f, VSCALE = 23.f;
constexpr int ROWB = 768;
constexpr size_t TBL_BYTES = (size_t)NEXP * ROWB;

__device__ __forceinline__ unsigned e2m3_code(float x) {
    const float a = fminf(fabsf(x), 7.5f);
    float c = a < 2.f ? __builtin_rintf(a * 8.f) : (a < 4.f ? 16.f + __builtin_rintf((a - 2.f) * 4.f) : 24.f + __builtin_rintf((a - 4.f) * 2.f));
    return (unsigned)c | (x < 0.f ? 32u : 0u);
}
__device__ __forceinline__ void convert_tables(Frame& F, const float* eu, const float* ev, unsigned char* dst) {
    const size_t nch = (size_t)DEPTH * NEXP * D / 2048;
    const size_t per_l = (size_t)NEXP * D / 32;
    const int lane = F.lane;
    LAS unsigned char* stg = F.lds + F.wave * 9216;
    for (int which = 0; which < 2; ++which) {
        const GAS f32x4* src = (const GAS f32x4*)(which == 0 ? eu : ev);
        const float sc = which == 0 ? USCALE : VSCALE;
        f32x4 in_[8], nx_[8];
        size_t ch = (size_t)F.gw;
        if (ch < nch) {
#pragma unroll
            for (int k = 0; k < 8; ++k) in_[k] = src[ch * 512 + k * 64 + lane];
        }
        for (; ch < nch; ch += (size_t)F.ngw) {
            const size_t chn = ch + (size_t)F.ngw;
            if (chn < nch) {
#pragma unroll
                for (int k = 0; k < 8; ++k) nx_[k] = src[chn * 512 + k * 64 + lane];
            }
#pragma unroll
            for (int k = 0; k < 8; ++k) { const int pidx = k * 64 + lane; *(LAS f32x4*)(stg + pidx * 16 + (pidx >> 3) * 16) = in_[k]; }
            asm volatile("s_waitcnt lgkmcnt(0)" ::: "memory");
            const size_t i = ch * 64 + lane;
            const size_t l = i / per_l, r = i % per_l;
            unsigned o[7];
#pragma unroll
            for (int w = 0; w < 7; ++w) o[w] = 0u;
#pragma unroll
            for (int k = 0; k < 8; ++k) {
                const f32x4 v = *(const LAS f32x4*)(stg + lane * 144 + k * 16) * sc;
#pragma unroll
                for (int e = 0; e < 4; ++e) {
                    const int idx = k * 4 + e, pos = 6 * idx, w = pos >> 5, sh = pos & 31;
                    const unsigned c = e2m3_code(v[e]);
                    o[w] |= c << sh;
                    if (sh > 26) o[w + 1] |= c >> (32 - sh);
                }
            }
            asm volatile("s_waitcnt lgkmcnt(0)" ::: "memory");
            GAS u32x2* d2 = (GAS u32x2*)(dst + (l * 2 + which) * TBL_BYTES + r * 24);
            d2[0] = (u32x2){o[0], o[1]}; d2[1] = (u32x2){o[2], o[3]}; d2[2] = (u32x2){o[4], o[5]};
#pragma unroll
            for (int k = 0; k < 8; ++k) in_[k] = nx_[k];
        }
    }
}

__device__ __forceinline__ float allreduce16(float s) {
    s += __builtin_bit_cast(float, __builtin_amdgcn_update_dpp(0, __builtin_bit_cast(int, s), 0xB1, 0xF, 0xF, false));
    s += __builtin_bit_cast(float, __builtin_amdgcn_update_dpp(0, __builtin_bit_cast(int, s), 0x4E, 0xF, 0xF, false));
    s += __builtin_bit_cast(float, __builtin_amdgcn_update_dpp(0, __builtin_bit_cast(int, s), 0x141, 0xF, 0xF, false));
    s += __builtin_bit_cast(float, __builtin_amdgcn_update_dpp(0, __builtin_bit_cast(int, s), 0x140, 0xF, 0xF, false));
    return s;
}
__device__ __forceinline__ v32f dec32(unsigned a, unsigned b, unsigned c, unsigned d, unsigned e, unsigned f) { return __builtin_amdgcn_cvt_scalef32_pk32_f32_fp6((v6u){a, b, c, d, e, f}, 1.0f); }

template <int MODE>
__device__ __forceinline__ void ph_peer_gather(Frame& F, const bf16_t* HNp, const float* g2pp, const float* SSPp, const int* EXPIp, const float* GATEp, const unsigned char* EU6p, const unsigned char* EV6p, float* XRp,
                                               const float* gnp, bf16_t* HNoutp, const float* wffp, const float* bfgp, float* logfp, float* outp) {
    const int lane0 = F.lane;
    LAS float* wl = (LAS float*)F.lds;
    if (MODE == 1) {
        const GAS float* wff = (const GAS float*)wffp;
        for (int k = F.tid; k < D; k += NTHREADS) {
            const f32x4 w0 = *(const GAS f32x4*)(wff + (size_t)k * INW + 3072), w1 = *(const GAS f32x4*)(wff + (size_t)k * INW + 3076);
            const int ln = ((k >> 5) & 31) + 32 * ((k >> 4) & 1), slot = (((k >> 2) & 3) * 64 + ln) * 4 + (k & 3);
            wl[0 * D + slot] = w0[0]; wl[1 * D + slot] = w0[1]; wl[2 * D + slot] = w0[2]; wl[3 * D + slot] = w0[3]; wl[4 * D + slot] = w1[0]; wl[5 * D + slot] = w1[1]; wl[6 * D + slot] = w1[2]; wl[7 * D + slot] = w1[3];
        }
        __syncthreads();
    }
    const unsigned char* wsb0 = (const unsigned char*)HNp - WS_HN;
    const GAS unsigned char* EU6 = (const GAS unsigned char*)EU6p; const GAS unsigned char* EV6 = (const GAS unsigned char*)EV6p;
    const GAS float* g2p = (const GAS float*)g2pp;
    int pi0 = 0, pi1 = 0; float pg0 = 0.f, pg1 = 0.f, pss = 0.f;
#define PEER_PREF(tt, ln, wb) do { const GAS int* ei_ = (const GAS int*)((wb) + WS_EXPI) + (size_t)(tt) * 128 + (ln); const GAS float* ga_ = (const GAS float*)((wb) + WS_GATE) + (size_t)(tt) * 128 + (ln); \
        pi0 = ei_[0]; pi1 = ei_[64]; pg0 = ga_[0]; pg1 = ga_[64]; pss = ((ln) < 16) ? ((const GAS float*)((wb) + WS_SSP))[(size_t)(tt) * 16 + (ln)] : 0.f; } while (0)
    if (F.gw < T) PEER_PREF(F.gw, lane0, wsb0);
    for (int t = F.gw; t < T; t += F.ngw) {
        int lane = lane0; asm volatile("" : "+v"(lane));
        const unsigned char* wsb = opq(wsb0);
        const GAS bf16_t* HN = (const GAS bf16_t*)(wsb + WS_HN); GAS float* XR = (GAS float*)(wsb + WS_XR);
        const int r32 = lane & 31, hi = lane >> 5;
        int idx0 = pi0, idx1 = pi1; float gate0 = pg0, gate1 = pg1; const float ssv0 = pss;
        if (t + F.ngw < T) PEER_PREF(t + F.ngw, lane, wsb);
        {
            unsigned k0 = ((unsigned)idx0 << 7) | (unsigned)lane, k1 = ((unsigned)idx1 << 7) | (unsigned)(64 + lane);
#pragma unroll
            for (int kk = 2; kk <= 128; kk <<= 1) {
#pragma unroll
                for (int j = kk >> 1; j > 0; j >>= 1) {
                    if (j == 64) { const unsigned lo = k0 < k1 ? k0 : k1, hi2 = k0 < k1 ? k1 : k0; k0 = lo; k1 = hi2; }
                    else {
                        const unsigned p0 = (unsigned)bperm_i(lane ^ j, (int)k0), p1 = (unsigned)bperm_i(lane ^ j, (int)k1);
                        const bool lower = (lane & j) == 0;
                        const bool up0 = (lane & kk) == 0 || kk == 128, up1 = ((64 + lane) & kk) == 0 || kk == 128;
                        const bool kmin0 = (lower == up0), kmin1 = (lower == up1);
                        k0 = kmin0 ? (k0 < p0 ? k0 : p0) : (k0 > p0 ? k0 : p0);
                        k1 = kmin1 ? (k1 < p1 ? k1 : p1) : (k1 > p1 ? k1 : p1);
                    }
                }
            }
            const int s0 = (int)(k0 & 127u), s1 = (int)(k1 & 127u);
            const float ga0 = bperm_f(s0 & 63, gate0), gb0 = bperm_f(s0 & 63, gate1), ga1 = bperm_f(s1 & 63, gate0), gb1 = bperm_f(s1 & 63, gate1);
            gate0 = s0 < 64 ? ga0 : gb0; gate1 = s1 < 64 ? ga1 : gb1;
            idx0 = (int)(k0 >> 7); idx1 = (int)(k1 >> 7);
        }
        float cv0 = 0.f, cv1 = 0.f;
        {
            f32x2 tu[16];
            u32x2 ub[4][3];
#define PEER_ULOAD(s, slot) do { const int ix_ = bperm_i((lane & 32) + ((s) & 31), ((s) >> 5) ? idx1 : idx0); \
            const GAS u32x2* p_ = (const GAS u32x2*)(EU6 + (size_t)ix_ * ROWB + r32 * 24); ub[slot][0] = p_[0]; ub[slot][1] = p_[1]; ub[slot][2] = p_[2]; } while (0)
#define PEER_UCOMP(s, slot) do { f32x2 a0_ = {0.f, 0.f}, a1_ = {0.f, 0.f}; \
            { const v32f g_ = dec32(ub[slot][0][0], ub[slot][0][1], ub[slot][1][0], ub[slot][1][1], ub[slot][2][0], ub[slot][2][1]); \
              _Pragma("unroll") for (int j = 0; j < 16; j += 2) { a0_ = (f32x2){g_[2 * j], g_[2 * j + 1]} * tu[j] + a0_; a1_ = (f32x2){g_[2 * j + 2], g_[2 * j + 3]} * tu[j + 1] + a1_; } } \
            const float tot_ = sum32((a0_[0] + a0_[1]) + (a1_[0] + a1_[1])); \
            if (((s) >> 5) == 0) { if (r32 == ((s) & 31)) cv0 = tot_; } else { if (r32 == ((s) & 31)) cv1 = tot_; } } while (0)
            asm volatile("" ::: "memory");
            v4u trow[4];
#pragma unroll
            for (int q = 0; q < 4; ++q) trow[q] = ((const GAS v4u*)(HN + (size_t)t * D + r32 * 32))[q];
            PEER_ULOAD(0, 0); PEER_ULOAD(1, 1); PEER_ULOAD(2, 2);
            {
              const float ssv = sum32(ssv0);
              const float rsn = rsqrtf(__builtin_bit_cast(float, __builtin_amdgcn_readlane(__builtin_bit_cast(int, ssv), 0)) * (1.0f / D) + EPS);
              const GAS f32x4* gq = (const GAS f32x4*)(g2p + r32 * 32);
#pragma unroll
              for (int q = 0; q < 4; ++q) { const v4u a = trow[q]; const f32x4 ga = gq[2 * q] * rsn, gb = gq[2 * q + 1] * rsn;
                  tu[q * 4 + 0] = (f32x2){__uint_as_float(a[0] << 16) * ga[0], __uint_as_float(a[0] & 0xffff0000u) * ga[1]};
                  tu[q * 4 + 1] = (f32x2){__uint_as_float(a[1] << 16) * ga[2], __uint_as_float(a[1] & 0xffff0000u) * ga[3]};
                  tu[q * 4 + 2] = (f32x2){__uint_as_float(a[2] << 16) * gb[0], __uint_as_float(a[2] & 0xffff0000u) * gb[1]};
                  tu[q * 4 + 3] = (f32x2){__uint_as_float(a[3] << 16) * gb[2], __uint_as_float(a[3] & 0xffff0000u) * gb[3]}; } }
            for (int s0 = 0; s0 < 60; s0 += 4) {
                PEER_ULOAD(s0 + 3, 3); PEER_UCOMP(s0, 0);
                PEER_ULOAD(s0 + 4, 0); PEER_UCOMP(s0 + 1, 1);
                PEER_ULOAD(s0 + 5, 1); PEER_UCOMP(s0 + 2, 2);
                PEER_ULOAD(s0 + 6, 2); PEER_UCOMP(s0 + 3, 3);
            }
            PEER_ULOAD(63, 3); PEER_UCOMP(60, 0); PEER_UCOMP(61, 1); PEER_UCOMP(62, 2); PEER_UCOMP(63, 3);
#undef PEER_ULOAD
#undef PEER_UCOMP
        }
        float c0, c1;
        { const float x0 = cv0 * (1.0f / USCALE), x1 = cv1 * (1.0f / USCALE);
          c0 = gate0 * (0.5f * x0 * (1.0f + erff(x0 * 0.70710678118654752f))) * (1.0f / VSCALE);
          c1 = gate1 * (0.5f * x1 * (1.0f + erff(x1 * 0.70710678118654752f))) * (1.0f / VSCALE); }
        f32x2 acc[16];
#pragma unroll
        for (int k = 0; k < 16; ++k) acc[k] = (f32x2){0.f, 0.f};
        u32x2 vb[6][3];
#define PEER_VLOAD(s, slot) do { const int sl_ = (lane & 32) + ((s) & 31); const int ix_ = bperm_i(sl_, ((s) >> 5) ? idx1 : idx0); \
            const GAS u32x2* p_ = (const GAS u32x2*)(EV6 + (size_t)ix_ * ROWB + r32 * 24); vb[slot][0] = p_[0]; vb[slot][1] = p_[1]; vb[slot][2] = p_[2]; } while (0)
#define PEER_VCOMP(s, slot) do { const int sl_ = (lane & 32) + ((s) & 31); const float c_ = bperm_f(sl_, ((s) >> 5) ? c1 : c0); const f32x2 cc_ = {c_, c_}; \
            const v32f g_ = dec32(vb[slot][0][0], vb[slot][0][1], vb[slot][1][0], vb[slot][1][1], vb[slot][2][0], vb[slot][2][1]); \
            _Pragma("unroll") for (int j = 0; j < 16; ++j) acc[j] = (f32x2){g_[2 * j], g_[2 * j + 1]} * cc_ + acc[j]; } while (0)
#pragma unroll
        for (int k = 0; k < 5; ++k) PEER_VLOAD(k, k);
        for (int s0 = 0; s0 < 54; s0 += 6) {
#pragma unroll
            for (int k = 0; k < 6; ++k) { PEER_VLOAD(s0 + k + 5, (k + 5) % 6); PEER_VCOMP(s0 + k, k); }
        }
#pragma unroll
        for (int k = 0; k < 5; ++k) { PEER_VLOAD(59 + k, (k + 5) % 6); PEER_VCOMP(54 + k, k); }
#pragma unroll
        for (int k = 0; k < 5; ++k) PEER_VCOMP(59 + k, (k + 5) % 6);
#undef PEER_VLOAD
#undef PEER_VCOMP
        float pv[16];
#pragma unroll
        for (int j = 0; j < 8; ++j) {
            const float mx = hi ? acc[8 + j][0] : acc[j][0], my = hi ? acc[8 + j][1] : acc[j][1];
            const float ox = hi ? acc[j][0] : acc[8 + j][0], oy = hi ? acc[j][1] : acc[8 + j][1];
            pv[2 * j] = mx + bperm_f(lane ^ 32, ox); pv[2 * j + 1] = my + bperm_f(lane ^ 32, oy);
        }
        int e0 = r32 * 32 + hi * 16; asm volatile("" : "+v"(e0));
        GAS f32x4* xp = (GAS f32x4*)(XR + (size_t)t * D + e0);
        f32x4 xv[4];
#pragma unroll
        for (int j = 0; j < 4; ++j) xv[j] = xp[j];
        float ss = 0.f;
#pragma unroll
        for (int j = 0; j < 4; ++j) { xv[j][0] += pv[4 * j]; xv[j][1] += pv[4 * j + 1]; xv[j][2] += pv[4 * j + 2]; xv[j][3] += pv[4 * j + 3];
            ss += xv[j][0] * xv[j][0] + xv[j][1] * xv[j][1] + xv[j][2] * xv[j][2] + xv[j][3] * xv[j][3]; }
        if (MODE != 2) {
#pragma unroll
            for (int j = 0; j < 4; ++j) xp[j] = xv[j];
        }
        ss = wave_sum(ss);
        const float rs = rsqrtf(ss * (1.0f / D) + EPS);
        const GAS f32x4* gp = (const GAS f32x4*)(gnp + e0);
#pragma unroll
        for (int j = 0; j < 4; ++j) { const f32x4 gg = gp[j]; xv[j] = xv[j] * gg * rs; }
        if (MODE == 2) {
            GAS f32x4* op = (GAS f32x4*)(outp + (size_t)t * D + e0);
#pragma unroll
            for (int j = 0; j < 4; ++j) op[j] = xv[j];
        } else {
            v4u h0, h1;
            h0[0] = pk2(xv[0][0], xv[0][1]); h0[1] = pk2(xv[0][2], xv[0][3]); h0[2] = pk2(xv[1][0], xv[1][1]); h0[3] = pk2(xv[1][2], xv[1][3]);
            h1[0] = pk2(xv[2][0], xv[2][1]); h1[1] = pk2(xv[2][2], xv[2][3]); h1[2] = pk2(xv[3][0], xv[3][1]); h1[3] = pk2(xv[3][2], xv[3][3]);
            GAS v4u* hp = (GAS v4u*)((GAS bf16_t*)(wsb + WS_HN) + (size_t)t * D + e0); hp[0] = h0; hp[1] = h1;
            float a[8];
#pragma unroll
            for (int q = 0; q < 8; ++q) { float s = 0.f;
#pragma unroll
                for (int j = 0; j < 4; ++j) { const f32x4 w = *(const LAS f32x4*)(wl + q * D + (j * 64 + lane) * 4); s += (xv[j][0] * w[0] + xv[j][1] * w[1]) + (xv[j][2] * w[2] + xv[j][3] * w[3]); }
                a[q] = wave_sum(s); }
            if (lane < 8) {
                float f = lane == 0 ? a[0] : lane == 1 ? a[1] : lane == 2 ? a[2] : lane == 3 ? a[3] : lane == 4 ? a[4] : lane == 5 ? a[5] : lane == 6 ? a[6] : a[7];
                f += bfgp[lane];
                ((GAS float*)(wsb + WS_LOGF))[(size_t)t * 8 + lane] = fminf(f, 0.f) - log1pf(expf(-fabsf(f)));
            }
        }
    }
}
}
namespace route {
typedef float f32x16 __attribute__((ext_vector_type(16)));
typedef unsigned u32x2 __attribute__((ext_vector_type(2)));
constexpr int KROW = 272;
constexpr int KIMG = 128 * KROW;
constexpr int OFF_SLOT = 2 * KIMG;

#define RT_CE(a, b) do { const float hi_ = fmaxf(a, b), lo_ = fminf(a, b); a = hi_; b = lo_; } while (0)
template <int BASE> __device__ __forceinline__ void sort16(float (&v)[64]) {
    constexpr int NET[60][2] = {{0, 13}, {1, 12}, {2, 15}, {3, 14}, {4, 8}, {5, 6}, {7, 11}, {9, 10},   {0, 5}, {1, 7}, {2, 9}, {3, 4}, {6, 13}, {8, 14}, {10, 15}, {11, 12},
                                {0, 1}, {2, 3}, {4, 5}, {6, 8}, {7, 9}, {10, 11}, {12, 13}, {14, 15},   {0, 2}, {1, 3}, {4, 10}, {5, 11}, {6, 7}, {8, 9}, {12, 14}, {13, 15},
                                {1, 2}, {3, 12}, {4, 6}, {5, 7}, {8, 10}, {9, 11}, {13, 14},   {1, 4}, {2, 6}, {5, 8}, {7, 10}, {9, 13}, {11, 14},   {2, 4}, {3, 6}, {9, 12}, {11, 13},
                                {3, 5}, {6, 8}, {7, 9}, {10, 12},   {3, 4}, {5, 6}, {7, 8}, {9, 10}, {11, 12},   {6, 7}, {8, 9}};
#pragma unroll
    for (int c = 0; c < 60; ++c) RT_CE(v[BASE + NET[c][0]], v[BASE + NET[c][1]]);
}
template <int A, int B> __device__ __forceinline__ void merge16(float (&v)[64]) {
#pragma unroll
    for (int i = 0; i < 16; ++i) v[A + i] = fmaxf(v[A + i], v[B + 15 - i]);
#pragma unroll
    for (int j = 8; j > 0; j >>= 1)
#pragma unroll
        for (int i = 0; i < 16; ++i) { const int l = i ^ j; if (l > i) RT_CE(v[A + i], v[A + l]); }
}
__device__ __forceinline__ void top16_of_64(float (&v)[64]) { sort16<0>(v); sort16<16>(v); sort16<32>(v); sort16<48>(v); merge16<0, 16>(v); merge16<32, 48>(v); merge16<0, 32>(v); }

__device__ __forceinline__ void ph_route(Frame& F, const pg8::StaticOrder& So, const bf16_t* QPp, const float* SKp, int* EXPIp, float* GATEp) {
    const int lane = F.lane, r32 = lane & 31, hi = lane >> 5;
    const GAS bf16_t* QP = (const GAS bf16_t*)QPp; const GAS float* SK = (const GAS float*)SKp;
    {
        f32x4 k4[16];
#pragma unroll
        for (int q = 0; q < 16; ++q) k4[q] = *(const GAS f32x4*)(SK + (size_t)(F.tid + q * NTHREADS) * 4);
#pragma unroll
        for (int q = 0; q < 16; ++q) {
            const int e = (F.tid + q * NTHREADS) * 4, p = e >> 14, n = (e >> 7) & 127, d = e & 127;
            u32x2 o; o[0] = pk2(k4[q][0], k4[q][1]); o[1] = pk2(k4[q][2], k4[q][3]);
            *(LAS u32x2*)(F.lds + p * KIMG + n * KROW + d * 2) = o;
        }
    }
    __syncthreads();
    LAS unsigned* slot = (LAS unsigned*)(F.lds + OFF_SLOT + F.wave * 8192) + lane;
    pg8::Unit u_;
    for (int ui = 0; So.next(ui, u_); ++ui) {
        const int tile = u_.pm * 8 + F.wave, h = u_.pn;
        const int tok = tile * 32 + r32;
        float s01[2][16];
#pragma unroll
        for (int p = 0; p < 2; ++p) {
            bf16x8 qf[8];
#pragma unroll
            for (int ks = 0; ks < 8; ++ks) qf[ks] = *(const GAS bf16x8*)(QP + (size_t)tok * 2048 + h * 256 + p * 128 + ks * 16 + hi * 8);
            f32x16 acc[4];
#pragma unroll
            for (int kb = 0; kb < 4; ++kb) acc[kb] = f32x16{};
            const LAS unsigned char* kbase = F.lds + p * KIMG + r32 * KROW + hi * 16;
#pragma unroll
            for (int ks = 0; ks < 8; ++ks)
#pragma unroll
                for (int kb = 0; kb < 4; ++kb) {
                    const bf16x8 a = *(const LAS bf16x8*)(kbase + kb * 32 * KROW + ks * 32);
                    acc[kb] = __builtin_amdgcn_mfma_f32_32x32x16_bf16(a, qf[ks], acc[kb], 0, 0, 0);
                }
            float v[64];
#pragma unroll
            for (int kb = 0; kb < 4; ++kb)
#pragma unroll
                for (int r = 0; r < 16; ++r) {
                    const unsigned n = (unsigned)(32 * kb + (r & 3) + 8 * (r >> 2)) + 4u * (unsigned)hi;
                    v[kb * 16 + r] = __uint_as_float((__float_as_uint(acc[kb][r]) & 0xFFFFFF80u) | n);
                }
            top16_of_64(v);
            float w[16];
#pragma unroll
            for (int i = 0; i < 16; ++i) w[i] = bperm_f(lane ^ 32, v[15 - i]);
#pragma unroll
            for (int i = 0; i < 16; ++i) v[i] = fmaxf(v[i], w[i]);
#pragma unroll
            for (int j = 8; j > 0; j >>= 1)
#pragma unroll
                for (int i = 0; i < 16; ++i) { const int l = i ^ j; if (l > i) RT_CE(v[i], v[l]); }
#pragma unroll
            for (int i = 0; i < 16; ++i) s01[p][i] = v[i];
        }
#pragma unroll
        for (int i = 0; i < 16; ++i) { slot[i * 64] = __float_as_uint(s01[0][i]) & 127u; slot[(16 + i) * 64] = __float_as_uint(s01[1][i]) & 127u; }
        float c[64];
        {
            constexpr int CNT[16] = {16, 8, 5, 4, 3, 2, 2, 2, 1, 1, 1, 1, 1, 1, 1, 1}, OFS[16] = {0, 16, 24, 29, 33, 36, 38, 40, 42, 43, 44, 45, 46, 47, 48, 49};
#pragma unroll
            for (int a = 0; a < 16; ++a)
#pragma unroll
                for (int b = 0; b < 16; ++b)
                    if (b < CNT[a]) c[OFS[a] + b] = __uint_as_float((__float_as_uint(s01[0][a] + s01[1][b]) & 0xFFFFFF00u) | (unsigned)(a * 16 + b));
#pragma unroll
            for (int i = 50; i < 64; ++i) c[i] = -INFINITY;
        }
        sort16<16>(c); sort16<32>(c); RT_CE(c[48], c[49]); merge16<0, 16>(c); merge16<32, 48>(c); merge16<0, 32>(c);
        float g[16]; int ex[16];
        asm volatile("s_waitcnt lgkmcnt(0)" ::: "memory");
        const float mx = __uint_as_float(__float_as_uint(c[0]) & 0xFFFFFF00u);
        float sum = 0.f;
#pragma unroll
        for (int i = 0; i < 16; ++i) {
            const unsigned bits = __float_as_uint(c[i]);
            const unsigned a = (bits >> 4) & 15u, b = bits & 15u;
            g[i] = __expf(__uint_as_float(bits & 0xFFFFFF00u) - mx); sum += g[i];
            ex[i] = (int)(slot[a * 64] * 128u + slot[(16 + b) * 64]);
        }
        const float inv = 1.0f / sum;
        GAS int* eo = (GAS int*)EXPIp + ((size_t)tok * 8 + h) * 16 + hi * 8;
        GAS float* go = (GAS float*)GATEp + ((size_t)tok * 8 + h) * 16 + hi * 8;
        if (hi == 0) {
            *(GAS v4u*)eo = (v4u){(unsigned)ex[0], (unsigned)ex[1], (unsigned)ex[2], (unsigned)ex[3]}; *(GAS v4u*)(eo + 4) = (v4u){(unsigned)ex[4], (unsigned)ex[5], (unsigned)ex[6], (unsigned)ex[7]};
            *(GAS f32x4*)go = (f32x4){g[0] * inv, g[1] * inv, g[2] * inv, g[3] * inv}; *(GAS f32x4*)(go + 4) = (f32x4){g[4] * inv, g[5] * inv, g[6] * inv, g[7] * inv};
        } else {
            *(GAS v4u*)eo = (v4u){(unsigned)ex[8], (unsigned)ex[9], (unsigned)ex[10], (unsigned)ex[11]}; *(GAS v4u*)(eo + 4) = (v4u){(unsigned)ex[12], (unsigned)ex[13], (unsigned)ex[14], (unsigned)ex[15]};
            *(GAS f32x4*)go = (f32x4){g[8] * inv, g[9] * inv, g[10] * inv, g[11] * inv}; *(GAS f32x4*)(go + 4) = (f32x4){g[12] * inv, g[13] * inv, g[14] * inv, g[15] * inv};
        }
        asm volatile("s_waitcnt lgkmcnt(0)" ::: "memory");
    }
}
#undef RT_CE
}
constexpr int NPL = 6;
constexpr int N_PHASES = 1 + DEPTH * NPL;
__global__ void __launch_bounds__(NTHREADS, 2) mega_fwd(Args  ) {
    extern __shared__ __attribute__((aligned(16))) unsigned char lds[];
    cg::grid_group grid = cg::this_grid();
    Frame F;
    F.lds = (LAS unsigned char*)lds;
    F.G = gridDim.x; F.ngw = F.G * NWAVES;
    volatile LAS unsigned* bst = (volatile LAS unsigned*)(F.lds + LDS_BYTES - 64);
    const int wave0 = __builtin_amdgcn_readfirstlane((int)threadIdx.x >> 6);
    if (threadIdx.x == 0) { bst[0] = 0u; bst[1] = 0u; }
    __syncthreads();
    const XcdBarrier bar = xcd_barrier_post((unsigned*)(ARG_WS + WS_CTL) + CW_BAR, bst, (int)threadIdx.x);
    for (int ph = ARG_PHLO; ph < ARG_PHHI; ++ph) {
        { int t_; asm volatile("v_mbcnt_lo_u32_b32 %0, -1, 0\n\tv_mbcnt_hi_u32_b32 %0, -1, %0" : "=v"(t_)); t_ += wave0 * 64; asm volatile("" : "+v"(t_)); int b_ = blockIdx.x; asm volatile("" : "+s"(b_));
          int l_ = t_ & 63; asm volatile("" : "+v"(l_));
          F.tid = t_; F.lane = l_; F.wave = __builtin_amdgcn_readfirstlane(t_ >> 6); F.bid = b_; F.gw = b_ * NWAVES + F.wave; }
        unsigned char* ws = ARG_WS;
        float* XR = (float*)(ws + WS_XR);
        bf16_t* HN = (bf16_t*)(ws + WS_HN);
        if (ph == 0) {
            ph_prologue(F);
            __syncthreads();
            peer::convert_tables(F, ARG_IN(12), ARG_IN(13), ws + WS_EXP);
            __syncthreads();
            ph_rmsnorm(F, ARG_IN(0), ARG_IN(1), HN, ARG_IN(2), ARG_IN(3), (float*)(ws + WS_LOGF));
        } else {
            const int l = (ph - 1) / NPL, k = (ph - 1) % NPL;
            const float* xin = (l == 0) ? ARG_IN(0) : XR;
            switch (k) {
            case 0: {
                ph_cumsum(F, (const float*)(ws + WS_LOGF), (float*)(ws + WS_CUM));
                pg8::Gemm g{HN, (const bf16_t*)(ws + WS_WIN + (size_t)l * 10 * MiB), T, NPROJ, D}; pg8::StaticOrder So; So.init(T, NPROJ, F.G, F.bid);
                pg8::EpiProj E{(bf16_t*)(ws + WS_A), (bf16_t*)(ws + WS_SG)};
                pg8::gemm_phase<pg8::EpiProj, pg8::StaticOrder, true, true>(F.lds, g, So, E, F.tid);
            } break;
            case 1: {
                const float lam_init = 0.8f - 0.6f * expf(-0.3f * (float)l);
                ph_attention(F, (const bf16_t*)(ws + WS_A), (const float*)(ws + WS_BT), (const float*)(ws + WS_CUM), ARG_IN(4) + l * 256, ARG_IN(5) + l * 128, lam_init, (bf16_t*)(ws + WS_YD), (bf16_t*)(ws + WS_YF));
            } break;
            case 2: {
                { pg8::Gemm g{(const bf16_t*)(ws + WS_YD), (const bf16_t*)(ws + WS_WDO + (size_t)l * MiB), T, D, 512}; pg8::StaticOrder So; So.init(T, D, F.G, F.bid);
                  pg8::EpiMerge1 E{(const bf16_t*)(ws + WS_SG), (bf16_t*)(ws + WS_MGT)};
                  pg8::gemm_phase<pg8::EpiMerge1, pg8::StaticOrder, true, true>(F.lds, g, So, E, F.tid); }
                ws = opq(ws);
                { pg8::Gemm g{(const bf16_t*)(ws + WS_YF), (const bf16_t*)(ws + WS_WFO + (size_t)l * MiB), T, D, 512}; pg8::StaticOrder So; So.init(T, D, F.G, F.bid);
                  pg8::EpiMerge2 E{(const bf16_t*)(ws + WS_SG) + (size_t)T * 1024, (const bf16_t*)(ws + WS_MGT), (bf16_t*)(ws + WS_MG)};
                  pg8::gemm_phase<pg8::EpiMerge2, pg8::StaticOrder, true, true>(F.lds, g, So, E, F.tid); }
            } break;
            case 3: {
                pg8::Gemm g{(const bf16_t*)(ws + WS_MG), (const bf16_t*)(ws + WS_WOUT + (size_t)l * 2 * MiB), T, D, D}; pg8::StaticOrder So; So.init(T, D, F.G, F.bid);
                pg8::EpiResidSS E{xin, XR, HN, (float*)(ws + WS_SSP)};
                pg8::gemm_phase<pg8::EpiResidSS, pg8::StaticOrder, true, true>(F.lds, g, So, E, F.tid);
            } break;
            case 4: {
                pg8::StaticOrder So; So.init(T, 2048, F.G, F.bid);
                LAS float* rsl = (LAS float*)(F.lds + 131072 + 4096);
                int pm0 = 0;
                { pg8::Unit u_; for (int ui = 0; ui < 2 && So.next(ui, u_); ++ui) { if (ui == 0) pm0 = u_.pm;
                      if (F.tid < 256) { const GAS f32x4* sp = (const GAS f32x4*)((const float*)(ws + WS_SSP) + (size_t)(u_.pm * 256 + F.tid) * 16);
                          const f32x4 s0 = sp[0], s1 = sp[1], s2 = sp[2], s3 = sp[3];
                          const float ss = ((s0[0] + s0[1]) + (s0[2] + s0[3])) + ((s1[0] + s1[1]) + (s1[2] + s1[3])) + ((s2[0] + s2[1]) + (s2[2] + s2[3])) + ((s3[0] + s3[1]) + (s3[2] + s3[3]));
                          rsl[(u_.pm == pm0 ? 0 : 256) + F.tid] = rsqrtf(ss * (1.0f / D) + EPS); } } }
                __syncthreads();
                { pg8::Gemm g{HN, (const bf16_t*)(ws + WS_WQ + (size_t)l * 4 * MiB), T, 2048, D};
                  pg8::EpiQP E{(bf16_t*)(ws + WS_QP), rsl, pm0};
                  pg8::gemm_phase<pg8::EpiQP, pg8::StaticOrder, true, true>(F.lds, g, So, E, F.tid); }
                asm volatile("s_waitcnt vmcnt(0)" ::: "memory");
                __syncthreads();
                if (F.tid == 0) { __builtin_amdgcn_fence(__ATOMIC_ACQUIRE, "agent"); asm volatile("s_waitcnt vmcnt(0)" ::: "memory"); }
                __syncthreads();
                ws = opq(ws);
                route::ph_route(F, So, (const bf16_t*)(ws + WS_QP), ARG_IN(11) + (size_t)l * 2 * 128 * 128, (int*)(ws + WS_EXPI), (float*)(ws + WS_GATE));
            } break;
            case 5: {
                const unsigned char* eu8 = ws + WS_EXP + (size_t)(l * 2) * peer::TBL_BYTES; const unsigned char* ev8 = eu8 + peer::TBL_BYTES;
                if (l + 1 < DEPTH)
                    peer::ph_peer_gather<1>(F, HN, ARG_IN(9) + l * D, (const float*)(ws + WS_SSP), (const int*)(ws + WS_EXPI), (const float*)(ws + WS_GATE), eu8, ev8, XR,
                                            ARG_IN(1) + (l + 1) * D, HN, ARG_IN(2) + (size_t)(l + 1) * D * INW, ARG_IN(3) + (l + 1) * 8, (float*)(ws + WS_LOGF), nullptr);
                else
                    peer::ph_peer_gather<2>(F, HN, ARG_IN(9) + l * D, (const float*)(ws + WS_SSP), (const int*)(ws + WS_EXPI), (const float*)(ws + WS_GATE), eu8, ev8, XR,
                                            ARG_IN(15), nullptr, nullptr, nullptr, nullptr, ARG_OUT);
            } break;
            }
        }
        if (ph + 1 < ARG_PHHI) { if (ARG_PHHI > N_PHASES) grid.sync(); else xcd_barrier(bar, F.tid); }
    }
}

extern "C" void kernel_launch(void* const* d_in, const int* in_sizes, int n_in, void* d_out, int out_size, void* d_ws, size_t ws_size, hipStream_t stream) {
    static int grid = 0;
    if (grid == 0) {
        if (n_in != 16 || ws_size < WS_END) { fprintf(stderr, "kernel_launch: unexpected inputs (n_in %d, ws %zu)\n", n_in, ws_size); grid = -1; return; }
        int dev = 0, cus = 0, per_cu = 0;
        if (hipGetDevice(&dev) != hipSuccess || hipDeviceGetAttribute(&cus, hipDeviceAttributeMultiprocessorCount, dev) != hipSuccess) { grid = -1; return; }
        if (hipFuncSetAttribute((const void*)mega_fwd, hipFuncAttributeMaxDynamicSharedMemorySize, LDS_BYTES) != hipSuccess) { fprintf(stderr, "kernel_launch: hipFuncSetAttribute failed\n"); grid = -1; return; }
        if (hipOccupancyMaxActiveBlocksPerMultiprocessor(&per_cu, (const void*)mega_fwd, NTHREADS, LDS_BYTES) != hipSuccess || per_cu < 1) { fprintf(stderr, "kernel_launch: occupancy query says %d\n", per_cu); per_cu = 1; }
        (void)hipGetLastError();
        grid = cus;
    }
    if (grid < 0) return;
    (void)hipMemsetAsync((char*)d_ws + WS_CTL, 0, CTL_ZERO_BYTES, stream);
    Args a{};
    for (int i = 0; i < 16; ++i) a.in[i] = (const float*)d_in[i];
    a.out = (float*)d_out; a.ws = (unsigned char*)d_ws; a.ph_lo = 0; a.ph_hi = N_PHASES;
    void* kargs[] = {&a};
    hipError_t e = hipLaunchCooperativeKernel((const void*)mega_fwd, dim3(grid), dim3(NTHREADS), kargs, LDS_BYTES, stream);
    if (e != hipSuccess) fprintf(stderr, "kernel_launch: cooperative launch failed: %s (grid %d)\n", hipGetErrorString(e), grid);
}
```

```cpp
#include <hip/hip_runtime.h>
#include <hip/hip_cooperative_groups.h>
#include <cstdio>
#include <cstdint>
#include <math.h>
namespace cg = cooperative_groups;
namespace pg8 {
#define PG8_LAS __attribute__((address_space(3)))
typedef unsigned short bf16_t;
typedef short bf16x8 __attribute__((ext_vector_type(8)));
typedef float f32x4 __attribute__((ext_vector_type(4)));
typedef unsigned u32x4 __attribute__((ext_vector_type(4)));
constexpr int BM = 256, BK = 64, HALF = 128, HTB = HALF * BK * 2  , STAGE_BYTES = 8 * HTB, NXCD = 8, WGM = 8;

__host__ __device__ __forceinline__ int lds_byte(int r, int c) { const int st = (r >> 4) * 2 + (c >> 5), rr = r & 15, cc = c & 31, ob = rr * 64 + cc * 2; return st * 1024 + (ob ^ (((ob >> 9) & 1) << 5)); }
__host__ __device__ __forceinline__ void stage_rc(int b, int& R, int& C) { const int st = b / 1024, sb = b % 1024, swz = sb ^ (((sb >> 9) & 1) << 5); R = (st >> 1) * 16 + swz / 64; C = (st & 1) * 32 + (swz % 64) / 2; }
__host__ __device__ __forceinline__ int perm32(int rho) { const int n = rho >> 4, i = rho & 15; return 8 * (i >> 2) + 4 * n + (i & 3); }

struct Unit { int pm, pn; };
struct Gemm { const bf16_t* A; const bf16_t* Bt; int M, N, K; };

struct StaticOrder {
    int nM, nN, nwg, G, c;
    __host__ __device__ void init(int M, int N, int G_, int c_) { nM = M / BM; nN = N / BM; nwg = nM * nN; G = G_; c = c_; }
    __host__ __device__ bool next(int i, Unit& u) const {
        const long L = (long)i * G + c; if (L >= nwg) return false;
        int wgid = (int)L; { const int q = nwg / NXCD, r = nwg % NXCD, xcd = wgid % NXCD, off = wgid / NXCD; wgid = (xcd < r ? xcd * (q + 1) : r * (q + 1) + (xcd - r) * q) + off; }
        const int nig = WGM * nN, gid = wgid / nig, fm = gid * WGM, gsz = (nM - fm) < WGM ? (nM - fm) : WGM;
        u.pm = fm + ((wgid % nig) % gsz); u.pn = (wgid % nig) / gsz; return true;
    }
    __device__ __forceinline__ void a_ready(const Unit&) const {}
    __device__ __forceinline__ void done(const Unit&) const {}
};

__device__ __forceinline__ unsigned cvt_pk_bf16(float lo, float hi) { unsigned r; asm volatile("v_cvt_pk_bf16_f32 %0, %1, %2" : "=v"(r) : "v"(lo), "v"(hi)); return r; }
typedef float f32x2 __attribute__((ext_vector_type(2)));
__device__ __forceinline__ f32x2 gelu_pk(f32x2 v) {
    const f32x2 av = __builtin_elementwise_abs(v), d = av * 0.2316418882f + 1.0f;
    f32x2 t; t.x = __builtin_amdgcn_rcpf(d.x); t.y = __builtin_amdgcn_rcpf(d.y);
    f32x2 q = t * 0.5307027145f + (-0.7265760135f); q = q * t + 0.7107068705f; q = q * t + (-0.142248368f); q = q * t + 0.127414796f; q = q * t;
    const f32x2 s = (v * v) * (-0.72134752044f);
    f32x2 e; e.x = __builtin_amdgcn_exp2f(s.x); e.y = __builtin_amdgcn_exp2f(s.y);
    const f32x2 m = v * (q * e), r = v - m;
    f32x2 o; o.x = v.x < 0.f ? m.x : r.x; o.y = v.y < 0.f ? m.y : r.y; return o;
}

template <int ACT  > struct EpiBf16 {
    static constexpr bool PERM = true, AFTER_DRAIN = false; static_assert(ACT == 0 || ACT == 1, "EpiBf16: ACT is 0 (none) or 1 (gelu_pk)");
    bf16_t* O; int ldc; const float* bias; int split_cols; size_t split_stride; float scale0;
    __device__ __forceinline__ void operator()(const f32x4 (&acc)[2][2][4][2], const Unit& u, int wr, int wc, int fr, int fq) const {
        const int row0 = u.pm * BM + wr * 64 + fr; int colt = u.pn * BM; bf16_t* base = O;
        float sc = 1.f; if (split_cols) { const int t = colt / split_cols; base += (size_t)t * split_stride; colt -= t * split_cols; if (t == 0) sc = scale0; }
        const int col0 = colt + wc * 32 + 8 * fq, bcol0 = u.pn * BM + wc * 32 + 8 * fq;
        f32x4 bv[2][2];
#pragma unroll
        for (int bj = 0; bj < 2; ++bj)
#pragma unroll
            for (int n = 0; n < 2; ++n) bv[bj][n] = bias ? *(const f32x4*)(bias + bcol0 + bj * HALF + 4 * n) : (f32x4){0.f, 0.f, 0.f, 0.f};
#pragma unroll
        for (int ai = 0; ai < 2; ++ai)
#pragma unroll
            for (int m = 0; m < 4; ++m) { bf16_t* rowp = base + (size_t)(row0 + ai * HALF + m * 16) * ldc + col0;
#pragma unroll
                for (int bj = 0; bj < 2; ++bj) { f32x4 v0 = acc[ai][bj][m][0] + bv[bj][0], v1 = acc[ai][bj][m][1] + bv[bj][1];
                    if (ACT == 1) { f32x2 a = gelu_pk((f32x2){v0[0], v0[1]}), b = gelu_pk((f32x2){v0[2], v0[3]}), c = gelu_pk((f32x2){v1[0], v1[1]}), d = gelu_pk((f32x2){v1[2], v1[3]});
                        v0 = (f32x4){a.x, a.y, b.x, b.y}; v1 = (f32x4){c.x, c.y, d.x, d.y}; }
                    v0 = v0 * sc; v1 = v1 * sc; u32x4 w; w.x = cvt_pk_bf16(v0[0], v0[1]); w.y = cvt_pk_bf16(v0[2], v0[3]); w.z = cvt_pk_bf16(v1[0], v1[1]); w.w = cvt_pk_bf16(v1[2], v1[3]);
                    *(u32x4*)(rowp + bj * HALF) = w; } }
    }
};
template <class Epi, class Sched, bool ALIGN_EPI = false, bool SP2 = false>
__device__ __forceinline__ void gemm_phase(PG8_LAS unsigned char* lds, const Gemm g, const Sched& S, const Epi& E, const int tid_in) {
    int tid_ = tid_in; asm volatile("" : "+v"(tid_));
    const int tid = tid_, wid = __builtin_amdgcn_readfirstlane(tid >> 6), lane = tid & 63, wr = wid >> 2, wc = wid & 3, fr = lane & 15, fq = lane >> 4;
    const int K = g.K, nt = K / BK;
    unsigned voffA[2], voffB[2];
#pragma unroll
    for (int i = 0; i < 2; ++i) { int R, C; stage_rc(tid * 16 + i * 8192, R, C); const int Rb = Epi::PERM ? ((R & ~31) + perm32(R & 31)) : R;
        voffA[i] = (unsigned)(R * K + C) * 2u; voffB[i] = (unsigned)(Rb * K + C) * 2u; }
    const size_t kstep = (size_t)(BK * 2);
    const size_t hstep = (size_t)HALF * K * 2;
    const size_t tstep = 2 * hstep;
    const unsigned ldsw = (unsigned)wid * 1024u;
    const int aoff = lds_byte(wr * 64 + fr, fq * 8), boff = lds_byte(wc * 32 + fr, fq * 8);
#define PG8_SA(b, h) (((b) * 2 + (h)) * HTB)
#define PG8_SB(b, h) ((4 + (b) * 2 + (h)) * HTB)
#define PG8_STAGE(bufoff, gbase, voff) do { _Pragma("unroll") for (int _i = 0; _i < 2; ++_i) \
        __builtin_amdgcn_global_load_lds((const unsigned*)((const char*)(gbase) + (voff)[_i]), (PG8_LAS unsigned*)(lds + (bufoff) + ldsw + _i * 8192), 16, 0, 0); } while (0)
#define PG8_LDA(dst, b, h) do { _Pragma("unroll") for (int m = 0; m < 4; ++m) _Pragma("unroll") for (int k = 0; k < 2; ++k) dst[m][k] = *(const PG8_LAS bf16x8*)(lds + PG8_SA(b, h) + aoff + m * 2048 + k * 1024); } while (0)
#define PG8_LDB(dst, b, h) do { _Pragma("unroll") for (int n = 0; n < 2; ++n) _Pragma("unroll") for (int k = 0; k < 2; ++k) dst[n][k] = *(const PG8_LAS bf16x8*)(lds + PG8_SB(b, h) + boff + n * 2048 + k * 1024); } while (0)
#define PG8_MMA(ai, bj, At, Bt) do { __builtin_amdgcn_s_setprio(1); _Pragma("unroll") for (int m = 0; m < 4; ++m) _Pragma("unroll") for (int n = 0; n < 2; ++n) _Pragma("unroll") for (int k = 0; k < 2; ++k) \
        acc[ai][bj][m][n] = __builtin_amdgcn_mfma_f32_16x16x32_bf16(Bt[n][k], At[m][k], acc[ai][bj][m][n], 0, 0, 0); __builtin_amdgcn_s_setprio(0); } while (0)
#define PG8_WAIT_V(n) asm volatile("s_waitcnt vmcnt(" #n ")" ::: "memory")
#define PG8_WAIT_L(n) asm volatile("s_waitcnt lgkmcnt(" #n ")" ::: "memory")
#define PG8_BAR __builtin_amdgcn_s_barrier()
#define PG8_SCHED __builtin_amdgcn_sched_barrier(0)
    Unit cur, nxt; int ui = 0;
    if (!S.next(0, cur)) return;
    f32x4 acc[2][2][4][2];
#pragma unroll
    for (int a = 0; a < 2; ++a)
#pragma unroll
        for (int b = 0; b < 2; ++b)
#pragma unroll
            for (int m = 0; m < 4; ++m)
#pragma unroll
                for (int n = 0; n < 2; ++n) acc[a][b][m][n] = (f32x4){0.f, 0.f, 0.f, 0.f};
    bf16x8 At[4][2], B0[2][2], B1[2][2];
    const char* cA = (const char*)g.A + (size_t)cur.pm * tstep; const char* cB = (const char*)g.Bt + (size_t)cur.pn * tstep;
    S.a_ready(cur);
    if constexpr (SP2) {
        PG8_STAGE(PG8_SB(0, 0), cB, voffB); PG8_STAGE(PG8_SB(0, 1), cB + hstep, voffB); PG8_STAGE(PG8_SA(0, 0), cA, voffA); PG8_STAGE(PG8_SA(0, 1), cA + hstep, voffA);
        if (wr == 1) PG8_BAR;
        PG8_WAIT_V(2); PG8_BAR;
        PG8_STAGE(PG8_SB(1, 0), cB + kstep, voffB); PG8_STAGE(PG8_SA(1, 0), cA + kstep, voffA); PG8_STAGE(PG8_SB(1, 1), cB + hstep + kstep, voffB);
        PG8_WAIT_V(6); PG8_BAR;
    } else {
        PG8_STAGE(PG8_SB(0, 0), cB, voffB); PG8_STAGE(PG8_SA(0, 0), cA, voffA); PG8_STAGE(PG8_SB(0, 1), cB + hstep, voffB); PG8_STAGE(PG8_SA(0, 1), cA + hstep, voffA);
        if (wr == 1) PG8_BAR;
        PG8_WAIT_V(4); PG8_BAR;
        PG8_STAGE(PG8_SB(1, 0), cB + kstep, voffB); PG8_STAGE(PG8_SA(1, 0), cA + kstep, voffA); PG8_STAGE(PG8_SB(1, 1), cB + hstep + kstep, voffB);
        PG8_WAIT_V(6); PG8_BAR;
    }
    for (;;) {
        const bool has_next = S.next(ui + 1, nxt);
        const char* nA = has_next ? (const char*)g.A + (size_t)nxt.pm * tstep : cA; const char* nB = has_next ? (const char*)g.Bt + (size_t)nxt.pn * tstep : cB;
        for (int t = 0; t < nt; t += 2) {
            const bool last = (t == nt - 2);
            const char* a1 = cA + (size_t)(t + 1) * kstep;
            const char* a2 = last ? nA : cA + (size_t)(t + 2) * kstep; const char* b2 = last ? nB : cB + (size_t)(t + 2) * kstep;
            const char* a3 = a2 + kstep; const char* b3 = b2 + kstep;
            if (last && has_next) S.a_ready(nxt);
            if constexpr (SP2) {
            PG8_LDB(B0, 0, 0); PG8_LDB(B1, 0, 1); PG8_SCHED; PG8_LDA(At, 0, 0); PG8_STAGE(PG8_SA(1, 1), a1 + hstep, voffA);
            PG8_WAIT_V(8); PG8_WAIT_L(0); PG8_BAR; PG8_MMA(0, 0, At, B0); PG8_MMA(0, 1, At, B1); PG8_BAR; PG8_SCHED;
            PG8_LDA(At, 0, 1); PG8_STAGE(PG8_SB(0, 0), b2, voffB); PG8_STAGE(PG8_SB(0, 1), b2 + hstep, voffB); PG8_STAGE(PG8_SA(0, 0), a2, voffA);
            PG8_WAIT_V(8); PG8_WAIT_L(0); PG8_BAR; PG8_MMA(1, 0, At, B0); PG8_MMA(1, 1, At, B1); PG8_BAR; PG8_SCHED;
            PG8_LDB(B0, 1, 0); PG8_LDB(B1, 1, 1); PG8_SCHED; PG8_LDA(At, 1, 0); PG8_STAGE(PG8_SA(0, 1), a2 + hstep, voffA);
            PG8_WAIT_V(8); PG8_WAIT_L(0); PG8_BAR; PG8_MMA(0, 0, At, B0); PG8_MMA(0, 1, At, B1); PG8_BAR; PG8_SCHED;
            PG8_LDA(At, 1, 1); PG8_STAGE(PG8_SB(1, 0), b3, voffB); PG8_STAGE(PG8_SB(1, 1), b3 + hstep, voffB); PG8_STAGE(PG8_SA(1, 0), a3, voffA);
            PG8_WAIT_V(8); PG8_WAIT_L(0); PG8_BAR; PG8_MMA(1, 0, At, B0); PG8_MMA(1, 1, At, B1); PG8_BAR; PG8_SCHED;
            } else {
            PG8_LDB(B0, 0, 0); PG8_SCHED; PG8_LDA(At, 0, 0); PG8_STAGE(PG8_SA(1, 1), a1 + hstep, voffA);
            PG8_WAIT_L(8); PG8_BAR; PG8_WAIT_L(0); PG8_MMA(0, 0, At, B0); PG8_BAR; PG8_SCHED;
            PG8_LDB(B1, 0, 1); PG8_STAGE(PG8_SB(0, 0), b2, voffB);
            PG8_BAR; PG8_WAIT_L(0); PG8_MMA(0, 1, At, B1); PG8_BAR;
            PG8_LDA(At, 0, 1); PG8_STAGE(PG8_SA(0, 0), a2, voffA);
            PG8_BAR; PG8_WAIT_L(0); PG8_MMA(1, 0, At, B0); PG8_BAR; PG8_SCHED;
            PG8_STAGE(PG8_SB(0, 1), b2 + hstep, voffB);
            PG8_WAIT_V(6); PG8_BAR; PG8_MMA(1, 1, At, B1); PG8_BAR;
            PG8_LDB(B0, 1, 0); PG8_SCHED; PG8_LDA(At, 1, 0); PG8_STAGE(PG8_SA(0, 1), a2 + hstep, voffA);
            PG8_WAIT_L(8); PG8_BAR; PG8_WAIT_L(0); PG8_MMA(0, 0, At, B0); PG8_BAR; PG8_SCHED;
            PG8_LDB(B1, 1, 1); PG8_STAGE(PG8_SB(1, 0), b3, voffB);
            PG8_BAR; PG8_WAIT_L(0); PG8_MMA(0, 1, At, B1); PG8_BAR;
            PG8_LDA(At, 1, 1); PG8_STAGE(PG8_SA(1, 0), a3, voffA);
            PG8_BAR; PG8_WAIT_L(0); PG8_MMA(1, 0, At, B0); PG8_BAR; PG8_SCHED;
            PG8_STAGE(PG8_SB(1, 1), b3 + hstep, voffB);
            PG8_WAIT_V(6); PG8_BAR; PG8_MMA(1, 1, At, B1); PG8_BAR;
            }
        }
        if constexpr (ALIGN_EPI) { if (wr == 0) PG8_BAR; }
        if constexpr (!Epi::AFTER_DRAIN) { E(acc, cur, wr, wc, fr, fq); S.done(cur); }
        if (!has_next) break;
#pragma unroll
        for (int a = 0; a < 2; ++a)
#pragma unroll
            for (int b = 0; b < 2; ++b)
#pragma unroll
                for (int m = 0; m < 4; ++m)
#pragma unroll
                    for (int n = 0; n < 2; ++n) acc[a][b][m][n] = (f32x4){0.f, 0.f, 0.f, 0.f};
        cur = nxt; cA = nA; cB = nB; ++ui;
        if constexpr (ALIGN_EPI) { if (wr == 1) PG8_BAR; }
    }
    PG8_WAIT_V(0);
    if constexpr (!ALIGN_EPI) { if (wr == 0) PG8_BAR; }
    PG8_BAR;
    if constexpr (Epi::AFTER_DRAIN) { E.fused(acc, cur, wr, wc, fr, fq, lds, wid, lane); S.done(cur); }
#undef PG8_SA
#undef PG8_SB
#undef PG8_STAGE
#undef PG8_LDA
#undef PG8_LDB
#undef PG8_MMA
#undef PG8_WAIT_V
#undef PG8_WAIT_L
#undef PG8_BAR
#undef PG8_SCHED
}
}
#define GAS __attribute__((address_space(1)))
#define LAS __attribute__((address_space(3)))
typedef unsigned short bf16_t;
typedef unsigned v4u __attribute__((ext_vector_type(4)));
typedef float f32x4 __attribute__((ext_vector_type(4)));
typedef short bf16x8 __attribute__((ext_vector_type(8)));
#define LDS_WAIT() asm volatile("s_waitcnt lgkmcnt(0)" ::: "memory")
#define VM_WAIT() asm volatile("s_waitcnt vmcnt(0)" ::: "memory")
__device__ __forceinline__ float bf2f(bf16_t v) { return __uint_as_float((uint32_t)v << 16); }
__device__ __forceinline__ unsigned f2bf(float f) { unsigned u = __builtin_bit_cast(unsigned, f); return (u + 0x7fffu + ((u >> 16) & 1u)) >> 16; }
__device__ __forceinline__ unsigned pk2(float lo, float hi) { return f2bf(lo) | (f2bf(hi) << 16); }
#define DPP_F(s, ctrl) __builtin_bit_cast(float, __builtin_amdgcn_update_dpp(0, __builtin_bit_cast(int, s), ctrl, 0xF, 0xF, false))
__device__ __forceinline__ float sum32(float v) {
    v += DPP_F(v, 0xB1); v += DPP_F(v, 0x4E); v += DPP_F(v, 0x141); v += DPP_F(v, 0x140);
    v += __builtin_bit_cast(float, __builtin_amdgcn_ds_swizzle(__builtin_bit_cast(int, v), 0x401F));
    return v;
}
__device__ __forceinline__ float max32(float v) {
    v = fmaxf(v, DPP_F(v, 0xB1)); v = fmaxf(v, DPP_F(v, 0x4E)); v = fmaxf(v, DPP_F(v, 0x141)); v = fmaxf(v, DPP_F(v, 0x140));
    v = fmaxf(v, __builtin_bit_cast(float, __builtin_amdgcn_ds_swizzle(__builtin_bit_cast(int, v), 0x401F)));
    return v;
}
__device__ __forceinline__ float wave_sum(float v) {
    v = sum32(v);
    return __builtin_bit_cast(float, __builtin_amdgcn_readlane(__builtin_bit_cast(int, v), 0)) + __builtin_bit_cast(float, __builtin_amdgcn_readlane(__builtin_bit_cast(int, v), 32));
}
__device__ __forceinline__ float wave_max(float v) {
    v = max32(v);
    return fmaxf(__builtin_bit_cast(float, __builtin_amdgcn_readlane(__builtin_bit_cast(int, v), 0)), __builtin_bit_cast(float, __builtin_amdgcn_readlane(__builtin_bit_cast(int, v), 32)));
}
__device__ __forceinline__ float bperm_f(int srclane, float v) { return __builtin_bit_cast(float, __builtin_amdgcn_ds_bpermute(srclane << 2, __builtin_bit_cast(int, v))); }
__device__ __forceinline__ int bperm_i(int srclane, int v) { return __builtin_amdgcn_ds_bpermute(srclane << 2, v); }
#define XB_TMO      128
#define XB_XCNT(j)  (256  + 64 * (j))
#define XB_XSUB(j)  (1280 + 64 * (j))
#define XB_XGEN(j)  (2304 + 64 * (j))
#define XB_TOP      3328
#define XB_TOPGEN   3392
#define XCD_BAR_WORDS 3456
#define XB_SPIN_CAP (1u << 24)

__device__ __forceinline__ unsigned xb_ld(unsigned* p)              { return __hip_atomic_load(p, __ATOMIC_RELAXED, __HIP_MEMORY_SCOPE_AGENT); }
__device__ __forceinline__ unsigned xb_add(unsigned* p, unsigned v) { return __hip_atomic_fetch_add(p, v, __ATOMIC_RELAXED, __HIP_MEMORY_SCOPE_AGENT); }
__device__ __forceinline__ unsigned xb_xcc_id() { return (unsigned)__builtin_amdgcn_s_getreg((3 << 11) | 20) & 0xFu; }
#define XB_SPIN(cond, bar) do { unsigned _sp = 0; while (cond) { __builtin_amdgcn_s_sleep(1); \
    if ((++_sp & 255u) == 0u) { if (xb_ld(&(bar)[XB_TMO])) break; if (_sp > XB_SPIN_CAP) { atomicAdd(&(bar)[XB_TMO], 1u); break; } } } } while (0)

struct XcdBarrier {
    unsigned* bar; unsigned x;
    volatile LAS unsigned* st;
};

__device__ __forceinline__ XcdBarrier xcd_barrier_post(unsigned* bar, volatile LAS unsigned* st, const int tid) {
    XcdBarrier b; b.bar = bar; b.x = xb_xcc_id(); b.st = st;
    if (tid == 0) (void)xb_add(&bar[XB_XCNT(b.x)], 1u);
    return b;
}
__device__ __forceinline__ void xcd_barrier_complete(unsigned* bar, unsigned x, unsigned& nloc, unsigned& nx) {
    const unsigned G = gridDim.x * gridDim.y * gridDim.z;
    unsigned sum, cnt, mine, sp = 0u;
    for (;;) {
        sum = 0u; cnt = 0u; mine = 0u;
#pragma unroll
        for (unsigned j = 0; j < 16; ++j) { const unsigned c = xb_ld(&bar[XB_XCNT(j)]); sum += c; cnt += (c > 0u) ? 1u : 0u; mine = (j == x) ? c : mine; }
        if (sum == G) break;
        __builtin_amdgcn_s_sleep(1);
        if ((++sp & 255u) == 0u) { if (xb_ld(&bar[XB_TMO])) break; if (sp > XB_SPIN_CAP) { atomicAdd(&bar[XB_TMO], 1u); break; } }
    }
    nloc = mine > 0u ? mine : 1u; nx = cnt > 0u ? cnt : 1u;
}

__device__ __forceinline__ void xcd_barrier(const XcdBarrier& b, const int tid) {
    asm volatile("s_waitcnt vmcnt(0)" ::: "memory");
    __syncthreads();
    if (tid == 0) {
        unsigned* bar = b.bar;
        __builtin_amdgcn_s_waitcnt(0);
        unsigned nloc = b.st[0], nx = b.st[1];
        if (nloc == 0u) { xcd_barrier_complete(bar, b.x, nloc, nx); b.st[0] = nloc; b.st[1] = nx; }
        const unsigned old = xb_add(&bar[XB_XSUB(b.x)], 1u);
        const unsigned gen = old / nloc;
        if (old + 1u == (gen + 1u) * nloc) {
            __builtin_amdgcn_fence(__ATOMIC_RELEASE, "agent");
            asm volatile("s_waitcnt vmcnt(0)" ::: "memory");
            const unsigned og = xb_add(&bar[XB_TOP], 1u);
            const unsigned tg = og / nx;
            if (og + 1u == (tg + 1u) * nx) xb_add(&bar[XB_TOPGEN], 1u);
            else XB_SPIN(xb_ld(&bar[XB_TOPGEN]) == tg, bar);
            __builtin_amdgcn_fence(__ATOMIC_ACQUIRE, "agent");
            xb_add(&bar[XB_XGEN(b.x)], 1u);
            asm volatile("s_waitcnt vmcnt(0)" ::: "memory");
        } else {
            XB_SPIN(xb_ld(&bar[XB_XGEN(b.x)]) == gen, bar);
            __builtin_amdgcn_fence(__ATOMIC_ACQUIRE, "agent");
            asm volatile("s_waitcnt vmcnt(0)" ::: "memory");
        }
    }
    __syncthreads();
}
constexpr int D = 1024, NB = 8, S = 2048, T = NB * S, DEPTH = 2, INW = 5128, NEXP = 16384;
constexpr int NPROJ = 5120;
constexpr float EPS = 1e-6f;
constexpr float LOG2E = 1.4426950408889634f;
constexpr float C2 = 0.125f * LOG2E;
constexpr int NWAVES = 8, NTHREADS = 512;
constexpr int LDS_BYTES = 147456;

constexpr size_t MiB = 1u << 20;
constexpr size_t WS_CTL = 0, CTL_ZERO_BYTES = 32 * 1024;
constexpr size_t WS_WIN = 1 * MiB;
constexpr size_t WS_WDO = 21 * MiB;
constexpr size_t WS_WFO = 23 * MiB;
constexpr size_t WS_WOUT = 25 * MiB;
constexpr size_t WS_WQ = 29 * MiB;
constexpr size_t WS_BT = 38 * MiB;
constexpr size_t WS_LOGF = 39 * MiB;
constexpr size_t WS_CUM = 39 * MiB + 512 * 1024;
constexpr size_t WS_EXP = 41 * MiB;
constexpr size_t WS_HN = 169 * MiB;
constexpr size_t WS_A = 201 * MiB;
constexpr size_t WS_MGT = WS_A, WS_MG = WS_A + 64 * MiB, WS_QP = WS_A;
constexpr size_t WS_SG = 297 * MiB;
constexpr size_t WS_SSP = 106 * MiB;
constexpr size_t WS_YD = 361 * MiB, WS_YF = 377 * MiB;
constexpr size_t WS_XR = 393 * MiB;
constexpr size_t WS_EXPI = 457 * MiB, WS_GATE = 465 * MiB;
constexpr size_t WS_END = 473 * MiB;
constexpr int CW_BAR = 4096;

struct Args {
    const float* in[16]; float* out; unsigned char* ws; int ph_lo, ph_hi;
};
struct Frame {
    LAS unsigned char* lds;
    int tid, lane, wave, gw, ngw, G, bid;
};
typedef __attribute__((address_space(4))) const unsigned char* kargp_t;
__device__ __forceinline__ kargp_t kargp() { kargp_t p = (kargp_t)__builtin_amdgcn_kernarg_segment_ptr(); asm volatile("" : "+s"(p)); return p; }
#define ARG_IN(i) (*(const float* const __attribute__((address_space(4)))*)(kargp() + 8 * (i)))
#define ARG_OUT   (*(float* const __attribute__((address_space(4)))*)(kargp() + 128))
#define ARG_WS    (*(unsigned char* const __attribute__((address_space(4)))*)(kargp() + 136))
#define ARG_PHLO  (*(const int __attribute__((address_space(4)))*)(kargp() + 144))
#define ARG_PHHI  (*(const int __attribute__((address_space(4)))*)(kargp() + 148))
static_assert(sizeof(Args) == 152, "kernarg layout: in[16] | out | ws | ph_lo | ph_hi");
template <class P> __device__ __forceinline__ P* opq(P* p) { asm volatile("" : "+s"(p)); return p; }

namespace pg8 {
struct EpiProj {
    static constexpr bool PERM = true, AFTER_DRAIN = false;
    bf16_t* qkv; bf16_t* sg;
    __device__ __forceinline__ void operator()(const f32x4 (&acc)[2][2][4][2], const Unit& u, int wr, int wc, int fr, int fq) const {
        const int row0 = u.pm * BM + wr * 64 + fr; const int ct = u.pn * BM;
        bf16_t* base; int ld, colt; bool sig; float sc = 1.f;
        if (ct < 3072) { const int t = ct >> 9; base = qkv + (size_t)t * T * 512; ld = 512; colt = ct & 511; sig = false; if (t == 0 || t == 3) sc = C2; }
        else { const int c2 = ct - 3072, t = c2 >> 10; base = sg + (size_t)t * T * 1024; ld = 1024; colt = c2 & 1023; sig = true; }
        const int col0 = colt + wc * 32 + 8 * fq;
#pragma unroll
        for (int ai = 0; ai < 2; ++ai)
#pragma unroll
            for (int m = 0; m < 4; ++m) { bf16_t* rowp = base + (size_t)(row0 + ai * HALF + m * 16) * ld + col0;
#pragma unroll
                for (int bj = 0; bj < 2; ++bj) { f32x4 v0 = acc[ai][bj][m][0], v1 = acc[ai][bj][m][1];
                    if (sig) {
#pragma unroll
                        for (int e = 0; e < 4; ++e) { v0[e] = __builtin_amdgcn_rcpf(1.0f + __builtin_amdgcn_exp2f(-LOG2E * v0[e])); v1[e] = __builtin_amdgcn_rcpf(1.0f + __builtin_amdgcn_exp2f(-LOG2E * v1[e])); }
                    } else { v0 = v0 * sc; v1 = v1 * sc; }
                    u32x4 w; w.x = cvt_pk_bf16(v0[0], v0[1]); w.y = cvt_pk_bf16(v0[2], v0[3]); w.z = cvt_pk_bf16(v1[0], v1[1]); w.w = cvt_pk_bf16(v1[2], v1[3]);
                    *(GAS u32x4*)(rowp + bj * HALF) = w; } }
    }
};
__device__ __forceinline__ void unpack8(const u32x4 w, float (&f)[8]) {
    f[0] = __uint_as_float(w.x << 16); f[1] = __uint_as_float(w.x & 0xffff0000u); f[2] = __uint_as_float(w.y << 16); f[3] = __uint_as_float(w.y & 0xffff0000u);
    f[4] = __uint_as_float(w.z << 16); f[5] = __uint_as_float(w.z & 0xffff0000u); f[6] = __uint_as_float(w.w << 16); f[7] = __uint_as_float(w.w & 0xffff0000u);
}
struct EpiMerge1 {
    static constexpr bool PERM = true, AFTER_DRAIN = false;
    const bf16_t* sga; bf16_t* tmp;
    __device__ __forceinline__ void operator()(const f32x4 (&acc)[2][2][4][2], const Unit& u, int wr, int wc, int fr, int fq) const {
        const int row0 = u.pm * BM + wr * 64 + fr, col0 = u.pn * BM + wc * 32 + 8 * fq;
#pragma unroll
        for (int ai = 0; ai < 2; ++ai)
#pragma unroll
            for (int m = 0; m < 4; ++m) { const size_t off = (size_t)(row0 + ai * HALF + m * 16) * 1024 + col0;
#pragma unroll
                for (int bj = 0; bj < 2; ++bj) { float g[8]; unpack8(*(const GAS u32x4*)(sga + off + bj * HALF), g);
                    const f32x4 v0 = acc[ai][bj][m][0], v1 = acc[ai][bj][m][1];
                    u32x4 w; w.x = cvt_pk_bf16(v0[0] * g[0], v0[1] * g[1]); w.y = cvt_pk_bf16(v0[2] * g[2], v0[3] * g[3]); w.z = cvt_pk_bf16(v1[0] * g[4], v1[1] * g[5]); w.w = cvt_pk_bf16(v1[2] * g[6], v1[3] * g[7]);
                    *(GAS u32x4*)(tmp + off + bj * HALF) = w; } }
    }
};
struct EpiMerge2 {
    static constexpr bool PERM = true, AFTER_DRAIN = false;
    const bf16_t* sgb; const bf16_t* tmp; bf16_t* mg;
    __device__ __forceinline__ void operator()(const f32x4 (&acc)[2][2][4][2], const Unit& u, int wr, int wc, int fr, int fq) const {
        const int row0 = u.pm * BM + wr * 64 + fr, col0 = u.pn * BM + wc * 32 + 8 * fq;
#pragma unroll
        for (int ai = 0; ai < 2; ++ai)
#pragma unroll
            for (int m = 0; m < 4; ++m) { const size_t off = (size_t)(row0 + ai * HALF + m * 16) * 1024 + col0;
#pragma unroll
                for (int bj = 0; bj < 2; ++bj) { float g[8], t[8]; unpack8(*(const GAS u32x4*)(sgb + off + bj * HALF), g); unpack8(*(const GAS u32x4*)(tmp + off + bj * HALF), t);
                    const f32x4 a0 = acc[ai][bj][m][0], a1 = acc[ai][bj][m][1];
                    u32x4 w; w.x = cvt_pk_bf16(t[0] + g[0] * a0[0], t[1] + g[1] * a0[1]); w.y = cvt_pk_bf16(t[2] + g[2] * a0[2], t[3] + g[3] * a0[3]);
                    w.z = cvt_pk_bf16(t[4] + g[4] * a1[0], t[5] + g[5] * a1[1]); w.w = cvt_pk_bf16(t[6] + g[6] * a1[2], t[7] + g[7] * a1[3]);
                    *(GAS u32x4*)(mg + off + bj * HALF) = w; } }
    }
};
struct EpiResidSS {
    static constexpr bool PERM = true, AFTER_DRAIN = false;
    const float* xin; float* xout; bf16_t* xb; float* ssp;
    __device__ __forceinline__ void operator()(const f32x4 (&acc)[2][2][4][2], const Unit& u, int wr, int wc, int fr, int fq) const {
        const int row0 = u.pm * BM + wr * 64 + fr, col0 = u.pn * BM + wc * 32 + 8 * fq;
#pragma unroll
        for (int ai = 0; ai < 2; ++ai)
#pragma unroll
            for (int m = 0; m < 4; ++m) { const int row = row0 + ai * HALF + m * 16; const size_t off = (size_t)row * 1024 + col0; float s = 0.f;
#pragma unroll
                for (int bj = 0; bj < 2; ++bj) {
                    const f32x4 v0 = *(const GAS f32x4*)(xin + off + bj * HALF) + acc[ai][bj][m][0], v1 = *(const GAS f32x4*)(xin + off + bj * HALF + 4) + acc[ai][bj][m][1];
                    *(GAS f32x4*)(xout + off + bj * HALF) = v0; *(GAS f32x4*)(xout + off + bj * HALF + 4) = v1;
                    u32x4 w; w.x = cvt_pk_bf16(v0[0], v0[1]); w.y = cvt_pk_bf16(v0[2], v0[3]); w.z = cvt_pk_bf16(v1[0], v1[1]); w.w = cvt_pk_bf16(v1[2], v1[3]);
                    *(GAS u32x4*)(xb + off + bj * HALF) = w;
                    s += ((v0[0] * v0[0] + v0[1] * v0[1]) + (v0[2] * v0[2] + v0[3] * v0[3])) + ((v1[0] * v1[0] + v1[1] * v1[1]) + (v1[2] * v1[2] + v1[3] * v1[3])); }
                s += __builtin_bit_cast(float, __builtin_amdgcn_ds_swizzle(__builtin_bit_cast(int, s), 0x401F));
                { auto rr = __builtin_amdgcn_permlane32_swap(__builtin_bit_cast(unsigned, s), __builtin_bit_cast(unsigned, s), false, false); s = __builtin_bit_cast(float, rr[0]) + __builtin_bit_cast(float, rr[1]); }
                if (fq == 0) ((GAS float*)ssp)[(size_t)row * 16 + u.pn * 4 + wc] = s; }
    }
};
struct EpiQP {
    static constexpr bool PERM = true, AFTER_DRAIN = false;
    bf16_t* qp; const PG8_LAS float* rsl; int pm0;
    __device__ __forceinline__ void operator()(const f32x4 (&acc)[2][2][4][2], const Unit& u, int wr, int wc, int fr, int fq) const {
        const int rl0 = wr * 64 + fr, col0 = u.pn * BM + wc * 32 + 8 * fq;
        const PG8_LAS float* rs_ = rsl + (u.pm == pm0 ? 0 : 256);
#pragma unroll
        for (int ai = 0; ai < 2; ++ai)
#pragma unroll
            for (int m = 0; m < 4; ++m) { const int rl = rl0 + ai * HALF + m * 16;
                const float rs = rs_[rl];
                bf16_t* rowp = qp + (size_t)(u.pm * BM + rl) * 2048 + col0;
#pragma unroll
                for (int bj = 0; bj < 2; ++bj) { const f32x4 v0 = acc[ai][bj][m][0] * rs, v1 = acc[ai][bj][m][1] * rs;
                    u32x4 w; w.x = cvt_pk_bf16(v0[0], v0[1]); w.y = cvt_pk_bf16(v0[2], v0[3]); w.z = cvt_pk_bf16(v1[0], v1[1]); w.w = cvt_pk_bf16(v1[2], v1[3]);
                    *(GAS u32x4*)(rowp + bj * HALF) = w; } }
    }
};
}

__device__ __forceinline__ void p0_transpose_item(const float* W, int ldw, int K, int Nd, int skip_from, int skip, bf16_t* WT, LAS float* scr, int item, int lane, const float* kscale = nullptr) {
    const int nblk = Nd / 32, kb = item / nblk, nb = item % nblk, k0 = 64 * kb, n0 = 32 * nb;
    const int s0 = n0 + (n0 >= skip_from ? skip : 0);
    float wv_[32];
    const GAS float* Wg = (const GAS float*)W + (size_t)(k0 + (lane >> 5)) * ldw + s0 + (lane & 31);
#pragma unroll
    for (int i = 0; i < 32; ++i) wv_[i] = Wg[(size_t)(2 * i) * ldw];
    if (kscale) {
        const GAS float* ks = (const GAS float*)kscale + k0 + (lane >> 5);
#pragma unroll
        for (int i = 0; i < 32; ++i) wv_[i] *= ks[2 * i];
    }
#pragma unroll
    for (int i = 0; i < 32; ++i) scr[(2 * i + (lane >> 5)) * 33 + (lane & 31)] = wv_[i];
    LDS_WAIT(); asm volatile("" ::: "memory");
    const int c = lane & 7;
#pragma unroll
    for (int j = 0; j < 4; ++j) { const int n = (lane >> 3) + 8 * j; const LAS float* s = scr + (8 * c) * 33 + n;
        v4u o; o.x = pk2(s[0 * 33], s[1 * 33]); o.y = pk2(s[2 * 33], s[3 * 33]); o.z = pk2(s[4 * 33], s[5 * 33]); o.w = pk2(s[6 * 33], s[7 * 33]);
        *(GAS v4u*)(WT + (size_t)(n0 + n) * K + k0 + 8 * c) = o; }
    LDS_WAIT(); asm volatile("" ::: "memory");
}
__device__ __forceinline__ void ph_prologue(Frame& F) {
    unsigned char* ws = ARG_WS;
    LAS float* scr = (LAS float*)(F.lds + F.wave * 16384);
    constexpr int I_IN = (D / 64) * (NPROJ / 32), I_DO = (512 / 64) * (D / 32), I_OUT = (D / 64) * (D / 32), I_Q = (D / 64) * (2048 / 32);
    constexpr int PER_L = I_IN + 2 * I_DO + I_OUT + I_Q;
    for (int it = F.gw; it < DEPTH * PER_L; it += F.ngw) {
        const int l = it / PER_L; int r = it % PER_L;
        if (r < I_IN) { p0_transpose_item(ARG_IN(2) + (size_t)l * D * INW, INW, D, NPROJ, 3072, 8, (bf16_t*)(ws + WS_WIN + (size_t)l * 10 * MiB), scr, r, F.lane); continue; } r -= I_IN;
        if (r < I_DO) { p0_transpose_item(ARG_IN(6) + (size_t)l * 512 * D, D, 512, D, 1 << 30, 0, (bf16_t*)(ws + WS_WDO + (size_t)l * MiB), scr, r, F.lane); continue; } r -= I_DO;
        if (r < I_DO) { p0_transpose_item(ARG_IN(7) + (size_t)l * 512 * D, D, 512, D, 1 << 30, 0, (bf16_t*)(ws + WS_WFO + (size_t)l * MiB), scr, r, F.lane); continue; } r -= I_DO;
        if (r < I_OUT) { p0_transpose_item(ARG_IN(8) + (size_t)l * D * D, D, D, D, 1 << 30, 0, (bf16_t*)(ws + WS_WOUT + (size_t)l * 2 * MiB), scr, r, F.lane); continue; } r -= I_OUT;
        p0_transpose_item(ARG_IN(10) + (size_t)l * D * 2048, 2048, D, 2048, 1 << 30, 0, (bf16_t*)(ws + WS_WQ + (size_t)l * 4 * MiB), scr, r, F.lane, ARG_IN(9) + l * D);
    }
    if (F.bid == 0) {
        float* tab = (float*)(ws + WS_BT); const float* rel_bias = ARG_IN(14);
        for (int i = F.tid; i < 4 * 129; i += NTHREADS) {
            const int h = i / 129, d = i % 129; int bucket;
            if (d < 16) bucket = d;
            else { const int large = 16 + (int)(logf((float)d / 16.0f) / 2.0794415416798357f * 16.0f); bucket = large < 31 ? large : 31; }
            tab[i] = rel_bias[bucket * 4 + h] * LOG2E;
        }
    }
}

__device__ __forceinline__ void ph_rmsnorm(Frame& F, const float* xp_, const float* gp_, bf16_t* outp_, const float* wffp_, const float* bfgp_, float* logfp_) {
    const int lane = F.lane;
    const GAS float* x = (const GAS float*)xp_; const GAS f32x4* gr = (const GAS f32x4*)gp_; GAS bf16_t* out = (GAS bf16_t*)outp_;
    const GAS float* wff = (const GAS float*)wffp_; const GAS float* bfg = (const GAS float*)bfgp_; GAS float* logf = (GAS float*)logfp_;
    LAS float* wl = (LAS float*)F.lds;
    for (int k = F.tid; k < D; k += NTHREADS) {
        const f32x4 w0 = *(const GAS f32x4*)(wff + (size_t)k * INW + 3072), w1 = *(const GAS f32x4*)(wff + (size_t)k * INW + 3076);
        wl[0 * D + k] = w0[0]; wl[1 * D + k] = w0[1]; wl[2 * D + k] = w0[2]; wl[3 * D + k] = w0[3]; wl[4 * D + k] = w1[0]; wl[5 * D + k] = w1[1]; wl[6 * D + k] = w1[2]; wl[7 * D + k] = w1[3];
    }
    __syncthreads();
    f32x4 nx[4];
    if (F.gw < T) {
#pragma unroll
        for (int j = 0; j < 4; ++j) nx[j] = ((const GAS f32x4*)(x + (size_t)F.gw * D))[j * 64 + lane];
    }
    for (int row = F.gw; row < T; row += F.ngw) {
        f32x4 v[4]; float ss = 0.f;
#pragma unroll
        for (int j = 0; j < 4; ++j) { v[j] = nx[j]; ss += (v[j][0] * v[j][0] + v[j][1] * v[j][1]) + (v[j][2] * v[j][2] + v[j][3] * v[j][3]); }
        if (row + F.ngw < T) {
#pragma unroll
            for (int j = 0; j < 4; ++j) nx[j] = ((const GAS f32x4*)(x + (size_t)(row + F.ngw) * D))[j * 64 + lane];
        }
        ss = wave_sum(ss);
        const float rs = rsqrtf(ss * (1.0f / D) + EPS);
#pragma unroll
        for (int j = 0; j < 4; ++j) v[j] = v[j] * gr[j * 64 + lane] * rs;
#pragma unroll
        for (int j = 0; j < 4; ++j) { typedef unsigned u32x2_ __attribute__((ext_vector_type(2))); u32x2_ o; o[0] = pk2(v[j][0], v[j][1]); o[1] = pk2(v[j][2], v[j][3]); *(GAS u32x2_*)(out + (size_t)row * D + (j * 64 + lane) * 4) = o; }
        float a[8];
#pragma unroll
        for (int hh = 0; hh < 8; ++hh) { float s = 0.f;
#pragma unroll
            for (int j = 0; j < 4; ++j) { const f32x4 w = *(const LAS f32x4*)(wl + hh * D + (j * 64 + lane) * 4); s += (v[j][0] * w[0] + v[j][1] * w[1]) + (v[j][2] * w[2] + v[j][3] * w[3]); }
            a[hh] = wave_sum(s); }
        if (lane < 8) {
            float f = lane == 0 ? a[0] : lane == 1 ? a[1] : lane == 2 ? a[2] : lane == 3 ? a[3] : lane == 4 ? a[4] : lane == 5 ? a[5] : lane == 6 ? a[6] : a[7];
            f += bfg[lane];
            logf[(size_t)row * 8 + lane] = fminf(f, 0.f) - log1pf(expf(-fabsf(f)));
        }
    }
    __syncthreads();
}
__device__ __forceinline__ void ph_cumsum(Frame& F, const float* logfp_, float* cump_) {
    const int lane = F.lane;
    const GAS float* logf = (const GAS float*)logfp_; GAS float* cum = (GAS float*)cump_;
    for (int task = F.gw; task < 64; task += F.ngw) {
        const int b = task >> 3, hh = task & 7;
        float v[32];
#pragma unroll
        for (int i = 0; i < 32; ++i) v[i] = logf[((size_t)(b * S + lane * 32 + i)) * 8 + hh];
#pragma unroll
        for (int i = 1; i < 32; ++i) v[i] += v[i - 1];
        float tot = v[31];
#pragma unroll
        for (int o = 1; o < 64; o <<= 1) { const float n = bperm_f(lane - o, tot); if (lane >= o) tot += n; }
        const float base = tot - v[31];
        GAS float* cp = cum + (size_t)task * S + lane * 32;
#pragma unroll
        for (int i = 0; i < 32; i += 4) { f32x4 o4 = {(v[i] + base) * LOG2E, (v[i + 1] + base) * LOG2E, (v[i + 2] + base) * LOG2E, (v[i + 3] + base) * LOG2E}; *(GAS f32x4*)(cp + i) = o4; }
    }
}
namespace att {
typedef float f32x16 __attribute__((ext_vector_type(16)));
typedef short s16x4 __attribute__((ext_vector_type(4)));
typedef short v4i16_t __attribute__((ext_vector_type(4)));
typedef unsigned u32x4 __attribute__((ext_vector_type(4)));
typedef float f32x2_t __attribute__((ext_vector_type(2))); typedef __bf16 bf16x2_t __attribute__((ext_vector_type(2)));
__device__ __forceinline__ int crow(int r, int hi) { return (r & 3) + 8 * (r >> 2) + 4 * hi; }
__device__ __forceinline__ unsigned cvtpk(float lo, float hi) { f32x2_t v = {lo, hi}; bf16x2_t b = __builtin_convertvector(v, bf16x2_t); return __builtin_bit_cast(unsigned, b); }
__device__ __forceinline__ void glds16(const void* gsrc, unsigned lds_dst) { unsigned keep;
    asm volatile("s_mov_b32 %0, m0\n\ts_mov_b32 m0, %2\n\ts_nop 0\n\tglobal_load_lds_dwordx4 %1, off\n\ts_mov_b32 m0, %0" : "=&s"(keep) : "v"(gsrc), "s"(lds_dst) : "memory"); }
__device__ __forceinline__ void glds16s(const void* gbase  , unsigned voff, unsigned lds_dst) { unsigned keep;
    asm volatile("s_mov_b32 %0, m0\n\ts_mov_b32 m0, %3\n\ts_nop 0\n\tglobal_load_lds_dwordx4 %1, %2\n\ts_mov_b32 m0, %0" : "=&s"(keep) : "v"(voff), "s"(gbase), "s"(lds_dst) : "memory"); }
#define ATT_WAIT_BAR() asm volatile("s_waitcnt vmcnt(0) lgkmcnt(0)\n\ts_barrier" ::: "memory")
#define ATT_MFMA(a, b, c) __builtin_amdgcn_mfma_f32_32x32x16_bf16(a, b, c, 0, 0, 0)
__device__ __forceinline__ s16x4 vtr(const LAS unsigned char* p) { return __builtin_bit_cast(s16x4, __builtin_amdgcn_ds_read_tr16_b64_v4i16((LAS v4i16_t*)p)); }
#define FX_SBAR() __builtin_amdgcn_sched_barrier(0)
#define FX_PIN(x) asm volatile("" : "+v"(x))
#define FX_WAIT_BAR(N) asm volatile("s_waitcnt vmcnt(" #N ") lgkmcnt(0)\n\ts_barrier" ::: "memory")
#define FX_MX3(a, b, c) __builtin_fmaxf(__builtin_fmaxf((a), (b)), (c))
__device__ __forceinline__ unsigned fx_cvtpk(float lo, float hi) { unsigned r; asm("v_cvt_pk_bf16_f32 %0, %1, %2" : "=v"(r) : "v"(lo), "v"(hi)); return r; }
__device__ __forceinline__ float fx_rowmax(const f32x16& p0, const f32x16& p1) {
    float a = FX_MX3(p0[0], p0[1], p1[0]), b = FX_MX3(p0[2], p0[3], p1[1]); a = FX_MX3(a, p1[2], p1[3]);
#pragma unroll
    for (int r = 4; r < 16; r += 4) { a = FX_MX3(a, p0[r], p0[r + 1]); b = FX_MX3(b, p0[r + 2], p0[r + 3]); a = FX_MX3(a, p1[r], p1[r + 1]); b = FX_MX3(b, p1[r + 2], p1[r + 3]); }
    float m = __builtin_fmaxf(a, b); auto rr = __builtin_amdgcn_permlane32_swap(__float_as_uint(m), __float_as_uint(m), false, false);
    return __builtin_fmaxf(__uint_as_float(rr[0]), __uint_as_float(rr[1])); }
__device__ __forceinline__ void fx_cmask(f32x16& p0, f32x16& p1, int jb, int qrel, int hi) {
    const int kb = 64 * jb + 4 * hi;
#pragma unroll
    for (int r = 0; r < 16; ++r) { const int kv = kb + (r & 3) + 8 * (r >> 2); if (kv > qrel) p0[r] = -INFINITY; if (kv + 32 > qrel) p1[r] = -INFINITY; } }

__device__ __forceinline__ void fox_unit(LAS unsigned char* lds, int tid, int b, int h, int qb, const bf16_t* Q, const bf16_t* K, const bf16_t* V, bf16_t* Y, const float* cum) {
    constexpr int QB = 256, SLOTB = 8192, LDS_K = 0, LDS_V = 3 * SLOTB, LDS_WS = 6 * SLOTB, LDS_TAB = LDS_WS + 2048, LDS_OST = LDS_TAB + 8192;
    constexpr float FTHR = 40.0f;
    int tid_ = tid; asm volatile("" : "+v"(tid_));
    const int lane = tid_ & 63, r32 = lane & 31, hi = lane >> 5, wid = __builtin_amdgcn_readfirstlane(tid_ >> 6);
    const int q0 = qb * QB, NT = (q0 + QB) / 64;
    const size_t rowbase = (size_t)b * S;
    const int hcol = h * 64;
    const bf16_t* Qw = Q + (rowbase + q0 + wid * 32) * 512 + hcol;
    const bf16_t* Kh = K + rowbase * 512 + hcol;
    const bf16_t* Vh = V + rowbase * 512 + hcol;
    const unsigned lds0 = (unsigned)(uintptr_t)lds;
    LAS float* wsf = (LAS float*)(lds + LDS_WS) + wid * 64;
    LAS float* tab = (LAS float*)(lds + LDS_TAB);
    const int qrel = wid * 32 + r32, qpos = q0 + qrel;
    const GAS float* cumg = (const GAS float*)cum;
    const bf16_t* ksrc = Kh + (size_t)(8 * wid + (lane & 7)) * 512 + (lane >> 3) * 8;
    const int vrow = lane >> 3, vslot = lane & 7;
    const int vchunk = (((vslot >> 2) ^ ((vrow >> 1) & 1)) << 2) | (vslot & 3);
    const bf16_t* vsrc = Vh + (size_t)(8 * wid + vrow) * 512 + vchunk * 8;
    const unsigned kdst = lds0 + LDS_K + wid * 1024, vdst = lds0 + LDS_V + wid * 1024;
#define FX_DMA_K(t, slot) glds16(ksrc + (size_t)(t) * 64 * 512, (unsigned)__builtin_amdgcn_readfirstlane(kdst + (slot)))
#define FX_DMA_V(t, slot) glds16(vsrc + (size_t)(t) * 64 * 512, (unsigned)__builtin_amdgcn_readfirstlane(vdst + (slot)))
    const int vq = (lane & 15) >> 2;
    const LAS unsigned char* vp0 = lds + LDS_V + ((lane >> 4) & 1) * 32 + (lane & 3) * 8 + (4 * hi + vq) * 128;
    const int vsw0 = ((vq >> 1) & 1) * 64, vsw1 = vsw0 ^ 64;
    const LAS unsigned char* kp0 = lds + LDS_K + (r32 >> 3) * 1024 + (r32 & 7) * 16 + hi * 128;
    const LAS float* cp0 = tab + 4 * hi;
    FX_DMA_K(0, 0); FX_DMA_V(0, 0); FX_DMA_K(1, SLOTB); FX_DMA_K(2, 2 * SLOTB);
    if (tid_ * 4 < q0 + QB) { const f32x4 c4 = ((const GAS f32x4*)cumg)[tid_]; ((LAS f32x4*)tab)[tid_] = (f32x4){-c4[0], -c4[1], -c4[2], -c4[3]}; }
    bf16x8 qr[4];
#pragma unroll
    for (int d0 = 0; d0 < 4; ++d0) qr[d0] = *(const GAS bf16x8*)(Qw + (size_t)r32 * 512 + d0 * 16 + hi * 8);
    float cq = cumg[qpos];
    asm volatile("" : "+v"(qr[0]), "+v"(qr[1]), "+v"(qr[2]), "+v"(qr[3]), "+v"(cq));
    float mhat = 0.f, l_reg = 0.f; f32x16 o[2]; o[0] = f32x16{}; o[1] = f32x16{};
    bool resc = false;
    f32x16 pA0, pA1, pB0, pB1; bf16x8 kf[8]; s16x4 vlo[8], vhi[8]; u32x4 pw0, pw1, pw2, pw3;
    int sl_prev = 0, sl_cur = 0, sl_next = SLOTB;
#define FX_ROT() do { sl_prev = sl_cur; sl_cur = sl_next; sl_next = (sl_next == 2 * SLOTB) ? 0 : sl_next + SLOTB; } while (0)
#define FX_EX(v) __builtin_amdgcn_exp2f((v) + nmh)
#define FX_RESC() do { if (resc) { _Pragma("unroll") for (int g_ = 0; g_ < 4; ++g_) { const f32x4 a4 = *(const LAS f32x4*)(wsf + 8 * g_ + 4 * hi); \
        _Pragma("unroll") for (int d_ = 0; d_ < 2; ++d_) { o[d_][4 * g_] *= a4[0]; o[d_][4 * g_ + 1] *= a4[1]; o[d_][4 * g_ + 2] *= a4[2]; o[d_][4 * g_ + 3] *= a4[3]; } } } } while (0)
#define FX_KLOAD2(kp, d0) do { kf[2 * (d0)] = *(const LAS bf16x8*)((kp) + (d0) * 256); kf[2 * (d0) + 1] = *(const LAS bf16x8*)((kp) + (d0) * 256 + 4096); } while (0)
#define FX_CLOAD(X0, X1, cp, g) do { const f32x4 c0_ = *(const LAS f32x4*)((cp) + 8 * (g)), c1_ = *(const LAS f32x4*)((cp) + 32 + 8 * (g)); \
        X0[4 * (g)] = c0_[0]; X0[4 * (g) + 1] = c0_[1]; X0[4 * (g) + 2] = c0_[2]; X0[4 * (g) + 3] = c0_[3]; X1[4 * (g)] = c1_[0]; X1[4 * (g) + 1] = c1_[1]; X1[4 * (g) + 2] = c1_[2]; X1[4 * (g) + 3] = c1_[3]; } while (0)
    FX_WAIT_BAR(3);
#pragma unroll
    for (int d0 = 0; d0 < 4; ++d0) FX_KLOAD2(kp0, d0);
#pragma unroll
    for (int g = 0; g < 4; ++g) FX_CLOAD(pA0, pA1, cp0, g);
    pA0 = ATT_MFMA(kf[0], qr[0], pA0); pA1 = ATT_MFMA(kf[1], qr[0], pA1); pA0 = ATT_MFMA(kf[2], qr[1], pA0); pA1 = ATT_MFMA(kf[3], qr[1], pA1);
    pA0 = ATT_MFMA(kf[4], qr[2], pA0); pA1 = ATT_MFMA(kf[5], qr[2], pA1); pA0 = ATT_MFMA(kf[6], qr[3], pA0); pA1 = ATT_MFMA(kf[7], qr[3], pA1);
    if (NT == 4) fx_cmask(pA0, pA1, 0, qrel, hi);
    { const float rm = fx_rowmax(pA0, pA1); mhat = rm + cq; const float nmh = cq - mhat;
#pragma unroll
      for (int r = 0; r < 16; ++r) { pA0[r] = FX_EX(pA0[r]); pA1[r] = FX_EX(pA1[r]); } }
    FX_WAIT_BAR(0);
    FX_DMA_K(3, 0); FX_DMA_V(1, SLOTB); FX_ROT();
#pragma unroll
    for (int d0 = 0; d0 < 4; ++d0) FX_KLOAD2(kp0 + sl_cur, d0);
#pragma unroll
    for (int g = 0; g < 4; ++g) FX_CLOAD(pB0, pB1, cp0 + 64, g);
    FX_WAIT_BAR(2);
#define FX_PKW(P, i) fx_cvtpk(P[i], P[i + 1])
#define FX_PAF(k) __builtin_bit_cast(bf16x8, pw##k)
#define FX_VFR(i) (bf16x8){vlo[i][0], vlo[i][1], vlo[i][2], vlo[i][3], vhi[i][0], vhi[i][1], vhi[i][2], vhi[i][3]}
#define FX_VRD(i) do { vlo[i] = vtr(vp_ + ((((i) >> 2) ? vsw1 : vsw0) + ((i) & 3) * 2048)); vhi[i] = vtr(vp_ + ((((i) >> 2) ? vsw1 : vsw0) + ((i) & 3) * 2048 + 1024)); } while (0)
#define FX_KRD(G, d0) do { if (G) { FX_KLOAD2(kp0 + sl_next, d0); FX_SBAR(); } } while (0)
#define FX_CRD(G, X0, X1, t, g) do { if (G) { FX_CLOAD(X0, X1, cp0 + 64 * ((t) + 1), g); FX_SBAR(); } } while (0)
#define FX_GAPA(MF, a0, a1, a2, a3, W0, W1, PW) do { MF; sacc += a0; sacc += a1; sacc += a2; sacc += a3; W0; W1; FX_PIN(PW); FX_PIN(sacc); FX_SBAR(); } while (0)
#define FX_GAPB(MF, X, i) do { MF; X[i] = FX_EX(X[i]); X[i + 1] = FX_EX(X[i + 1]); X[i + 2] = FX_EX(X[i + 2]); X[i + 3] = FX_EX(X[i + 3]); FX_PIN(X); FX_SBAR(); } while (0)
#define FX_STEP(C0, C1, P0, P1, t, MASK, GK, GV, GL) do { FX_SBAR(); \
    const LAS unsigned char* vp_ = vp0 + sl_prev; \
    FX_VRD(0); FX_SBAR(); float sacc = P0[0] + P0[1]; \
                       FX_GAPA(C0 = ATT_MFMA(kf[0], qr[0], C0), P0[2], P0[3], P0[4], P0[5],     pw0[0] = FX_PKW(P0, 0),  pw0[1] = FX_PKW(P0, 2),  pw0); \
    FX_VRD(4); FX_SBAR(); FX_GAPA(C1 = ATT_MFMA(kf[1], qr[0], C1), P0[6], P0[7], P0[8], P0[9],     pw0[2] = FX_PKW(P0, 4),  pw0[3] = FX_PKW(P0, 6),  pw0); \
    FX_VRD(1); FX_SBAR(); FX_GAPA(C0 = ATT_MFMA(kf[2], qr[1], C0),    P0[10], P0[11], P0[12], P0[13], pw1[0] = FX_PKW(P0, 8),  pw1[1] = FX_PKW(P0, 10), pw1); \
    FX_VRD(5); FX_SBAR(); FX_GAPA(C1 = ATT_MFMA(kf[3], qr[1], C1),    P0[14], P0[15], P1[0], P1[1],   pw1[2] = FX_PKW(P0, 12), pw1[3] = FX_PKW(P0, 14), pw1); \
    FX_VRD(2); FX_SBAR(); FX_GAPA(C0 = ATT_MFMA(kf[4], qr[2], C0),    P1[2], P1[3], P1[4], P1[5],     pw2[0] = FX_PKW(P1, 0),  pw2[1] = FX_PKW(P1, 2),  pw2); \
    FX_VRD(6); FX_SBAR(); FX_GAPA(C1 = ATT_MFMA(kf[5], qr[2], C1),    P1[6], P1[7], P1[8], P1[9],     pw2[2] = FX_PKW(P1, 4),  pw2[3] = FX_PKW(P1, 6),  pw2); \
    FX_VRD(3); FX_SBAR(); FX_GAPA(C0 = ATT_MFMA(kf[6], qr[3], C0),    P1[10], P1[11], P1[12], P1[13], pw3[0] = FX_PKW(P1, 8),  pw3[1] = FX_PKW(P1, 10), pw3); \
    FX_VRD(7); FX_SBAR(); FX_GAPA(C1 = ATT_MFMA(kf[7], qr[3], C1),    P1[14], P1[15], 0.f, 0.f,       pw3[2] = FX_PKW(P1, 12), pw3[3] = FX_PKW(P1, 14), pw3); \
    l_reg += sacc; \
    if (GK) FX_DMA_K((t) + 3, sl_cur); if (GV) FX_DMA_V((t) + 1, sl_next);                                \
    if (MASK) fx_cmask(C0, C1, (t) - (NT - 4), qrel, hi); \
    { const float rm = fx_rowmax(C0, C1) + (cq - mhat); resc = false;                                      \
      if (__builtin_expect(__any(rm > FTHR), 0)) { const float dl = __builtin_fmaxf(rm, 0.f); mhat += dl;     \
          const float f = __builtin_amdgcn_exp2f(-dl); l_reg *= f; if (hi == 0) wsf[r32] = f; resc = true; } } \
    const float nmh = cq - mhat; FX_SBAR(); \
    FX_CRD(GL, P0, P1, t, 0); FX_GAPB(o[0] = ATT_MFMA(FX_PAF(0), FX_VFR(0), o[0]), C0, 0);  FX_CRD(GL, P0, P1, t, 1); FX_GAPB(o[1] = ATT_MFMA(FX_PAF(0), FX_VFR(4), o[1]), C0, 4); \
    FX_KRD(GL, 0); FX_GAPB(o[0] = ATT_MFMA(FX_PAF(1), FX_VFR(1), o[0]), C0, 8);  FX_KRD(GL, 1); FX_GAPB(o[1] = ATT_MFMA(FX_PAF(1), FX_VFR(5), o[1]), C0, 12); \
    FX_KRD(GL, 2); FX_GAPB(o[0] = ATT_MFMA(FX_PAF(2), FX_VFR(2), o[0]), C1, 0);  FX_KRD(GL, 3); FX_GAPB(o[1] = ATT_MFMA(FX_PAF(2), FX_VFR(6), o[1]), C1, 4); \
    FX_CRD(GL, P0, P1, t, 2); FX_GAPB(o[0] = ATT_MFMA(FX_PAF(3), FX_VFR(3), o[0]), C1, 8);  FX_CRD(GL, P0, P1, t, 3); FX_GAPB(o[1] = ATT_MFMA(FX_PAF(3), FX_VFR(7), o[1]), C1, 12); \
    } while (0)
    int t = 1;
    for (; t + 5 < NT; t += 2) {
        FX_STEP(pB0, pB1, pA0, pA1, t, false, true, true, true);     FX_WAIT_BAR(2); FX_RESC(); FX_ROT();
        FX_STEP(pA0, pA1, pB0, pB1, t + 1, false, true, true, true); FX_WAIT_BAR(2); FX_RESC(); FX_ROT();
    }
#define FX_ENDW(tt) do { if ((tt) + 3 < NT) { FX_WAIT_BAR(2); } else if ((tt) + 2 < NT) { FX_WAIT_BAR(1); } else { FX_WAIT_BAR(0); } } while (0)
    for (; t + 1 < NT; t += 2) {
        FX_STEP(pB0, pB1, pA0, pA1, t, true, (t + 3 < NT), (t + 1 < NT), (t + 1 < NT));         FX_ENDW(t);     FX_RESC(); FX_ROT();
        FX_STEP(pA0, pA1, pB0, pB1, t + 1, true, (t + 4 < NT), (t + 2 < NT), (t + 2 < NT));     FX_ENDW(t + 1); FX_RESC(); FX_ROT();
    }
    FX_STEP(pB0, pB1, pA0, pA1, NT - 1, true, false, false, false); FX_RESC();
    { float sacc = pB0[0] + pB0[1];
#pragma unroll
      for (int r = 2; r < 16; ++r) sacc += pB0[r];
#pragma unroll
      for (int r = 0; r < 16; ++r) sacc += pB1[r];
      l_reg += sacc;
      pw0 = (u32x4){FX_PKW(pB0, 0), FX_PKW(pB0, 2), FX_PKW(pB0, 4), FX_PKW(pB0, 6)}; pw1 = (u32x4){FX_PKW(pB0, 8), FX_PKW(pB0, 10), FX_PKW(pB0, 12), FX_PKW(pB0, 14)};
      pw2 = (u32x4){FX_PKW(pB1, 0), FX_PKW(pB1, 2), FX_PKW(pB1, 4), FX_PKW(pB1, 6)}; pw3 = (u32x4){FX_PKW(pB1, 8), FX_PKW(pB1, 10), FX_PKW(pB1, 12), FX_PKW(pB1, 14)};
      const LAS unsigned char* vp_ = vp0 + sl_cur;
#pragma unroll
      for (int i = 0; i < 8; ++i) FX_VRD(i);
      o[0] = ATT_MFMA(FX_PAF(0), FX_VFR(0), o[0]); o[1] = ATT_MFMA(FX_PAF(0), FX_VFR(4), o[1]); o[0] = ATT_MFMA(FX_PAF(1), FX_VFR(1), o[0]); o[1] = ATT_MFMA(FX_PAF(1), FX_VFR(5), o[1]);
      o[0] = ATT_MFMA(FX_PAF(2), FX_VFR(2), o[0]); o[1] = ATT_MFMA(FX_PAF(2), FX_VFR(6), o[1]); o[0] = ATT_MFMA(FX_PAF(3), FX_VFR(3), o[0]); o[1] = ATT_MFMA(FX_PAF(3), FX_VFR(7), o[1]); }
    { auto rr = __builtin_amdgcn_permlane32_swap(__float_as_uint(l_reg), __float_as_uint(l_reg), false, false); l_reg = __uint_as_float(rr[0]) + __uint_as_float(rr[1]); }
    if (hi == 0) wsf[32 + r32] = 1.0f / l_reg;
    asm volatile("s_waitcnt lgkmcnt(0)" ::: "memory");
    float rli[16];
#pragma unroll
    for (int g = 0; g < 4; ++g) { const f32x4 a4 = *(const LAS f32x4*)(wsf + 32 + 8 * g + 4 * hi); rli[4 * g] = a4[0]; rli[4 * g + 1] = a4[1]; rli[4 * g + 2] = a4[2]; rli[4 * g + 3] = a4[3]; }
    LAS bf16_t* stg = (LAS bf16_t*)(lds + LDS_OST) + wid * 2048;
#pragma unroll
    for (int db = 0; db < 2; ++db)
#pragma unroll
        for (int r = 0; r < 16; ++r) stg[crow(r, hi) * 64 + db * 32 + r32] = (bf16_t)f2bf(o[db][r] * rli[r]);
    asm volatile("s_waitcnt lgkmcnt(0)" ::: "memory");
    bf16_t* Yw = Y + (rowbase + q0 + wid * 32) * 512 + hcol;
#pragma unroll
    for (int i = 0; i < 4; ++i) { const int row = i * 8 + (lane >> 3), ch = lane & 7; const u32x4 v = *(const LAS u32x4*)(stg + row * 64 + ch * 8); *(GAS u32x4*)(Yw + (size_t)row * 512 + ch * 8) = v; }
    ATT_WAIT_BAR();
#undef FX_DMA_K
#undef FX_DMA_V
#undef FX_ROT
#undef FX_EX
#undef FX_RESC
#undef FX_KLOAD2
#undef FX_CLOAD
#undef FX_PKW
#undef FX_PAF
#undef FX_VFR
#undef FX_VRD
#undef FX_KRD
#undef FX_CRD
#undef FX_ENDW
#undef FX_GAPA
#undef FX_GAPB
#undef FX_STEP
}
__device__ __forceinline__ float fx_max3(float a, float b, float c) { float r; asm("v_max3_f32 %0, %1, %2, %3" : "=v"(r) : "v"(a), "v"(b), "v"(c)); return r; }
__device__ __forceinline__ void diff_unit(LAS unsigned char* lds, int tid, int b, int h, int qb, const bf16_t* Q, const bf16_t* K, const bf16_t* V, bf16_t* Y,
                                          const float* aux  , float lam, float lnscale, const float* subg) {
    constexpr int QB = 128, SLOTB = 16384, LDS_K = 0, LDS_V = 3 * SLOTB, LDS_WS = 6 * SLOTB, LDS_TAB = LDS_WS + 2048, LDS_OST = LDS_TAB + 2048;
    constexpr float DTHR = 48.0f;
    int tid_ = tid; asm volatile("" : "+v"(tid_));
    const int lane = tid_ & 63, r32 = lane & 31, hi = lane >> 5, wid = __builtin_amdgcn_readfirstlane(tid_ >> 6);
    const int qg = wid & 3, m = wid >> 2;
    const int q0 = qb * QB, NT = (q0 + QB) / 64;
    const size_t rowbase = (size_t)b * S;
    const int hcol = h * 128;
    const bf16_t* Qw = Q + (rowbase + q0 + qg * 32) * 512 + hcol + m * 64;
    const bf16_t* Kh = K + rowbase * 512 + hcol;
    const bf16_t* Vh = V + rowbase * 512 + hcol;
    const unsigned lds0 = (unsigned)(uintptr_t)lds;
    LAS float* wsf = (LAS float*)(lds + LDS_WS) + wid * 64;
    LAS float* tab = (LAS float*)(lds + LDS_TAB);
    const int qpos = q0 + qg * 32 + r32;
    const unsigned koff = (unsigned)(((8 * wid + (lane & 7)) * 512 + (lane >> 3) * 8) * 2);
    const int vrow = lane >> 4, vslot = lane & 15;
    const int vchunk = (((vslot >> 2) ^ vrow) << 2) | (vslot & 3);
    const unsigned voff = (unsigned)(((4 * wid + vrow) * 512 + vchunk * 8) * 2);
    const unsigned kdst = lds0 + LDS_K + wid * 1024, vdst = lds0 + LDS_V + wid * 1024;
#define DF_DMA_K(t, slot) do { const bf16_t* kb_ = Kh + (size_t)(t) * 64 * 512; glds16s(kb_, koff, (unsigned)__builtin_amdgcn_readfirstlane(kdst + (slot))); glds16s(kb_ + 64, koff, (unsigned)__builtin_amdgcn_readfirstlane(kdst + (slot) + 8192u)); } while (0)
#define DF_DMA_V(t, slot) do { const bf16_t* vb_ = Vh + (size_t)(t) * 64 * 512; glds16s(vb_, voff, (unsigned)__builtin_amdgcn_readfirstlane(vdst + (slot))); glds16s(vb_ + 32 * 512, voff, (unsigned)__builtin_amdgcn_readfirstlane(vdst + (slot) + 8192u)); } while (0)
    const int vq = (lane & 15) >> 2;
    const LAS unsigned char* vp0 = lds + LDS_V + ((lane >> 4) & 1) * 32 + (lane & 3) * 8 + hi * 1024 + vq * 256;
    const LAS unsigned char* kp0 = lds + LDS_K + m * 8192 + (r32 >> 3) * 1024 + (r32 & 7) * 16 + hi * 128;
    DF_DMA_K(0, 0); DF_DMA_V(0, 0); DF_DMA_K(1, SLOTB); DF_DMA_K(2, 2 * SLOTB);
    {
        const GAS float* auxg = (const GAS float*)aux; const int i_ = tid_ - 128;
        tab[tid_] = i_ < 0 ? -INFINITY : (i_ < 128 ? auxg[i_] - auxg[128] : 0.f);
    }
    bf16x8 qr[4];
#pragma unroll
    for (int d0 = 0; d0 < 4; ++d0) qr[d0] = *(const GAS bf16x8*)(Qw + (size_t)r32 * 512 + d0 * 16 + hi * 8);
    asm volatile("" : "+v"(qr[0]), "+v"(qr[1]), "+v"(qr[2]), "+v"(qr[3]));
    float mhat = 0.f, l_reg = 0.f, fP = 1.f; f32x16 o[4];
#pragma unroll
    for (int db = 0; db < 4; ++db) o[db] = f32x16{};
    bool rescP = false, rescN = false;
    f32x16 pA0, pA1, pB0, pB1; bf16x8 kf[8]; s16x4 vlo[2][4], vhi[2][4]; u32x4 pw0, pw1, pw2, pw3;
    int sl_prev = 0, sl_cur = 0, sl_next = SLOTB;
#define DF_ROT() do { sl_prev = sl_cur; sl_cur = sl_next; sl_next = (sl_next == 2 * SLOTB) ? 0 : sl_next + SLOTB; } while (0)
#define DF_EX(v) __builtin_amdgcn_exp2f(v)
#define DF_RESC(par) do { if (rescP) { _Pragma("unroll") for (int g_ = 0; g_ < 4; ++g_) { const f32x4 a4 = *(const LAS f32x4*)(wsf + 32 * (par) + 8 * g_ + 4 * hi); \
        _Pragma("unroll") for (int d_ = 0; d_ < 4; ++d_) { o[d_][4 * g_] *= a4[0]; o[d_][4 * g_ + 1] *= a4[1]; o[d_][4 * g_ + 2] *= a4[2]; o[d_][4 * g_ + 3] *= a4[3]; } } } rescP = rescN; } while (0)
#define DF_KLOAD2(kp, d0) do { kf[2 * (d0)] = *(const LAS bf16x8*)((kp) + (d0) * 256); kf[2 * (d0) + 1] = *(const LAS bf16x8*)((kp) + (d0) * 256 + 4096); } while (0)
#define DF_CINIT(C0, C1, t) do { const LAS float* tp_ = tab + (qpos - ((t) * 64 + 4 * hi) + 128 - 59); \
        _Pragma("unroll") for (int r = 0; r < 16; ++r) { C0[r] = tp_[59 - ((r & 3) + 8 * (r >> 2))]; C1[r] = tp_[59 - 32 - ((r & 3) + 8 * (r >> 2))]; } } while (0)
#define DF_DECIDE(C0, C1, par) do { const float rm_ = fx_rowmax(C0, C1); rescN = false; float fN_ = 1.f; \
        if (__builtin_expect(__any(rm_ > DTHR), 0)) { const float dl_ = __builtin_fmaxf(rm_, 0.f); mhat += dl_; fN_ = __builtin_amdgcn_exp2f(-dl_); if (hi == 0) wsf[32 * (par) + r32] = fN_; rescN = true; } \
        fNext = fN_; } while (0)
#define DF_DECIDE2(par) do { float rm_ = mx; { auto rr_ = __builtin_amdgcn_permlane32_swap(__float_as_uint(rm_), __float_as_uint(rm_), false, false); rm_ = __builtin_fmaxf(__uint_as_float(rr_[0]), __uint_as_float(rr_[1])); } \
        rescN = false; float fN_ = 1.f; \
        if (__builtin_expect(__any(rm_ > DTHR), 0)) { const float dl_ = __builtin_fmaxf(rm_, 0.f); mhat += dl_; fN_ = __builtin_amdgcn_exp2f(-dl_); if (hi == 0) wsf[32 * (par) + r32] = fN_; rescN = true; } \
        fNext = fN_; } while (0)
    float fNext = 1.f;
    asm volatile("s_waitcnt vmcnt(6) lgkmcnt(0)\n\ts_barrier" ::: "memory");
#pragma unroll
    for (int d0 = 0; d0 < 4; ++d0) DF_KLOAD2(kp0, d0);
    if (NT <= 4) { DF_CINIT(pA0, pA1, 0); pA0 = ATT_MFMA(kf[0], qr[0], pA0); pA1 = ATT_MFMA(kf[1], qr[0], pA1); }
    else { pA0 = ATT_MFMA(kf[0], qr[0], f32x16{}); pA1 = ATT_MFMA(kf[1], qr[0], f32x16{}); }
    pA0 = ATT_MFMA(kf[2], qr[1], pA0); pA1 = ATT_MFMA(kf[3], qr[1], pA1);
    pA0 = ATT_MFMA(kf[4], qr[2], pA0); pA1 = ATT_MFMA(kf[5], qr[2], pA1); pA0 = ATT_MFMA(kf[6], qr[3], pA0); pA1 = ATT_MFMA(kf[7], qr[3], pA1);
    DF_DECIDE(pA0, pA1, 0);
#pragma unroll
    for (int r = 0; r < 16; ++r) { pA0[r] = DF_EX(pA0[r]); pA1[r] = DF_EX(pA1[r]); }
    rescP = rescN; fP = fNext;
    asm volatile("s_waitcnt vmcnt(0) lgkmcnt(0)\n\ts_barrier" ::: "memory");
    DF_DMA_K(3, 0); DF_DMA_V(1, SLOTB); DF_ROT();
#pragma unroll
    for (int d0 = 0; d0 < 4; ++d0) DF_KLOAD2(kp0 + sl_cur, d0);
    asm volatile("s_waitcnt vmcnt(4) lgkmcnt(0)\n\ts_barrier" ::: "memory");
#define DF_PKW(P, i) fx_cvtpk(P[i], P[i + 1])
#define DF_PAF(k) __builtin_bit_cast(bf16x8, pw##k)
#define DF_VFR(bf, db) (bf16x8){vlo[bf][db][0], vlo[bf][db][1], vlo[bf][db][2], vlo[bf][db][3], vhi[bf][db][0], vhi[bf][db][1], vhi[bf][db][2], vhi[bf][db][3]}
#define DF_VRD(bf, ks, i) do { if (((i) & 1) == 0) vlo[bf][(i) >> 1] = vtr(vp_ + ((((i) >> 1) ^ vq) * 64 + (ks) * 4096)); else vhi[bf][(i) >> 1] = vtr(vp_ + ((((i) >> 1) ^ vq) * 64 + (ks) * 4096 + 2048)); } while (0)
#define DF_VRD2(bf, ks, i) do { DF_VRD(bf, ks, i); DF_VRD(bf, ks, (i) + 1); FX_SBAR(); } while (0)
#define DF_KRD(G, d0) do { if (G) { DF_KLOAD2(kp0 + sl_next, d0); FX_SBAR(); } } while (0)
#define DF_GAPA(MF, a0, a1, a2, a3, W0, W1, PW) do { MF; sacc += a0; sacc += a1; sacc += a2; sacc += a3; W0; W1; FX_PIN(PW); FX_PIN(sacc); FX_SBAR(); } while (0)
#define DF_GAPB(MF, X, i) do { MF; mx = fx_max3(mx, X[i], X[i + 1]); X[i] = DF_EX(X[i]); X[i + 1] = DF_EX(X[i + 1]); FX_PIN(X); FX_PIN(mx); FX_SBAR(); } while (0)
#define DF_STEP(C0, C1, P0, P1, t, par, MASK, GK, GV, GL) do { FX_SBAR(); \
    const LAS unsigned char* vp_ = vp0 + sl_prev; \
    if (MASK) { DF_CINIT(C0, C1, t); FX_SBAR(); } \
    DF_VRD(0, 0, 0); FX_SBAR(); float sacc = P0[0] + P0[1]; float mx = -INFINITY; \
                              DF_GAPA(C0 = ATT_MFMA(kf[0], qr[0], (MASK) ? C0 : f32x16{}), P0[2], P0[3], P0[4], P0[5],     pw0[0] = DF_PKW(P0, 0),  pw0[1] = DF_PKW(P0, 2),  pw0); \
    DF_VRD(0, 0, 1); FX_SBAR(); DF_GAPA(C1 = ATT_MFMA(kf[1], qr[0], (MASK) ? C1 : f32x16{}), P0[6], P0[7], P0[8], P0[9],     pw0[2] = DF_PKW(P0, 4),  pw0[3] = DF_PKW(P0, 6),  pw0); \
    if (GK) { DF_DMA_K((t) + 3, sl_cur); FX_SBAR(); }                                                                  \
    DF_VRD(0, 0, 2); FX_SBAR(); DF_GAPA(C0 = ATT_MFMA(kf[2], qr[1], C0),    P0[10], P0[11], P0[12], P0[13], pw1[0] = DF_PKW(P0, 8),  pw1[1] = DF_PKW(P0, 10), pw1); \
    DF_VRD(0, 0, 3); FX_SBAR(); DF_GAPA(C1 = ATT_MFMA(kf[3], qr[1], C1),    P0[14], P0[15], P1[0], P1[1],   pw1[2] = DF_PKW(P0, 12), pw1[3] = DF_PKW(P0, 14), pw1); \
    if (GV) { DF_DMA_V((t) + 1, sl_next); FX_SBAR(); } \
    DF_VRD(0, 0, 4); FX_SBAR(); DF_GAPA(C0 = ATT_MFMA(kf[4], qr[2], C0),    P1[2], P1[3], P1[4], P1[5],     pw2[0] = DF_PKW(P1, 0),  pw2[1] = DF_PKW(P1, 2),  pw2); \
    DF_VRD(0, 0, 5); FX_SBAR(); DF_GAPA(C1 = ATT_MFMA(kf[5], qr[2], C1),    P1[6], P1[7], P1[8], P1[9],     pw2[2] = DF_PKW(P1, 4),  pw2[3] = DF_PKW(P1, 6),  pw2); \
    DF_VRD(0, 0, 6); FX_SBAR(); DF_GAPA(C0 = ATT_MFMA(kf[6], qr[3], C0),    P1[10], P1[11], P1[12], P1[13], pw3[0] = DF_PKW(P1, 8),  pw3[1] = DF_PKW(P1, 10), pw3); \
    DF_VRD(0, 0, 7); FX_SBAR(); DF_GAPA(C1 = ATT_MFMA(kf[7], qr[3], C1),    P1[14], P1[15], 0.f, 0.f,       pw3[2] = DF_PKW(P1, 12), pw3[3] = DF_PKW(P1, 14), pw3); \
    l_reg = (l_reg + sacc) * fP;                                                                           \
    if (__builtin_expect(!__all(mhat == 0.f), 0)) { _Pragma("unroll") for (int r = 0; r < 16; ++r) { C0[r] -= mhat; C1[r] -= mhat; } }       \
    FX_SBAR(); \
    DF_VRD2(1, 1, 0); DF_GAPB(o[0] = ATT_MFMA(DF_PAF(0), DF_VFR(0, 0), o[0]), C0, 0);   DF_VRD2(1, 1, 2); DF_GAPB(o[1] = ATT_MFMA(DF_PAF(0), DF_VFR(0, 1), o[1]), C0, 2); \
    DF_VRD2(1, 1, 4); DF_GAPB(o[2] = ATT_MFMA(DF_PAF(0), DF_VFR(0, 2), o[2]), C0, 4);   DF_VRD2(1, 1, 6); DF_GAPB(o[3] = ATT_MFMA(DF_PAF(0), DF_VFR(0, 3), o[3]), C0, 6); \
    DF_VRD2(0, 2, 0); DF_GAPB(o[0] = ATT_MFMA(DF_PAF(1), DF_VFR(1, 0), o[0]), C0, 8);   DF_VRD2(0, 2, 2); DF_GAPB(o[1] = ATT_MFMA(DF_PAF(1), DF_VFR(1, 1), o[1]), C0, 10); \
    DF_VRD2(0, 2, 4); DF_GAPB(o[2] = ATT_MFMA(DF_PAF(1), DF_VFR(1, 2), o[2]), C0, 12);  DF_VRD2(0, 2, 6); DF_GAPB(o[3] = ATT_MFMA(DF_PAF(1), DF_VFR(1, 3), o[3]), C0, 14); \
    DF_VRD2(1, 3, 0); DF_GAPB(o[0] = ATT_MFMA(DF_PAF(2), DF_VFR(0, 0), o[0]), C1, 0);   DF_VRD2(1, 3, 2); DF_GAPB(o[1] = ATT_MFMA(DF_PAF(2), DF_VFR(0, 1), o[1]), C1, 2); \
    DF_VRD2(1, 3, 4); DF_GAPB(o[2] = ATT_MFMA(DF_PAF(2), DF_VFR(0, 2), o[2]), C1, 4);   DF_VRD2(1, 3, 6); DF_GAPB(o[3] = ATT_MFMA(DF_PAF(2), DF_VFR(0, 3), o[3]), C1, 6); \
    DF_KRD(GL, 0); DF_GAPB(o[0] = ATT_MFMA(DF_PAF(3), DF_VFR(1, 0), o[0]), C1, 8);      DF_KRD(GL, 1); DF_GAPB(o[1] = ATT_MFMA(DF_PAF(3), DF_VFR(1, 1), o[1]), C1, 10); \
    DF_KRD(GL, 2); DF_GAPB(o[2] = ATT_MFMA(DF_PAF(3), DF_VFR(1, 2), o[2]), C1, 12);     DF_KRD(GL, 3); DF_GAPB(o[3] = ATT_MFMA(DF_PAF(3), DF_VFR(1, 3), o[3]), C1, 14); \
    DF_DECIDE2(par); \
    } while (0)
#define DF_WAIT_BAR(N) asm volatile("s_waitcnt vmcnt(" #N ") lgkmcnt(0)\n\ts_barrier" ::: "memory")
#define DF_AFTER(par_prev) do { DF_RESC(par_prev); fP = fNext; } while (0)
    int t = 1;
    for (; t + 5 < NT; t += 2) {
        DF_STEP(pB0, pB1, pA0, pA1, t, 1, false, true, true, true);     DF_WAIT_BAR(4); DF_AFTER(0); DF_ROT();
        DF_STEP(pA0, pA1, pB0, pB1, t + 1, 0, false, true, true, true); DF_WAIT_BAR(4); DF_AFTER(1); DF_ROT();
    }
#define DF_ENDW(tt) do { if ((tt) + 3 < NT) { DF_WAIT_BAR(4); } else if ((tt) + 2 < NT) { DF_WAIT_BAR(2); } else { DF_WAIT_BAR(0); } } while (0)
    for (; t + 1 < NT; t += 2) {
        DF_STEP(pB0, pB1, pA0, pA1, t, 1, true, (t + 3 < NT), (t + 1 < NT), (t + 1 < NT));         DF_ENDW(t);     DF_AFTER(0); DF_ROT();
        DF_STEP(pA0, pA1, pB0, pB1, t + 1, 0, true, (t + 4 < NT), (t + 2 < NT), (t + 2 < NT));     DF_ENDW(t + 1); DF_AFTER(1); DF_ROT();
    }
    if (NT == 2) DF_WAIT_BAR(0);
    DF_STEP(pB0, pB1, pA0, pA1, NT - 1, 1, true, false, false, false); DF_AFTER(0);
    { float sacc = pB0[0] + pB0[1];
#pragma unroll
      for (int r = 2; r < 16; ++r) sacc += pB0[r];
#pragma unroll
      for (int r = 0; r < 16; ++r) sacc += pB1[r];
      l_reg += sacc;
      pw0 = (u32x4){DF_PKW(pB0, 0), DF_PKW(pB0, 2), DF_PKW(pB0, 4), DF_PKW(pB0, 6)}; pw1 = (u32x4){DF_PKW(pB0, 8), DF_PKW(pB0, 10), DF_PKW(pB0, 12), DF_PKW(pB0, 14)};
      pw2 = (u32x4){DF_PKW(pB1, 0), DF_PKW(pB1, 2), DF_PKW(pB1, 4), DF_PKW(pB1, 6)}; pw3 = (u32x4){DF_PKW(pB1, 8), DF_PKW(pB1, 10), DF_PKW(pB1, 12), DF_PKW(pB1, 14)};
      const LAS unsigned char* vp_ = vp0 + sl_cur;
#pragma unroll
      for (int i = 0; i < 8; ++i) { DF_VRD(0, 0, i); DF_VRD(1, 1, i); }
      o[0] = ATT_MFMA(DF_PAF(0), DF_VFR(0, 0), o[0]); o[1] = ATT_MFMA(DF_PAF(0), DF_VFR(0, 1), o[1]); o[2] = ATT_MFMA(DF_PAF(0), DF_VFR(0, 2), o[2]); o[3] = ATT_MFMA(DF_PAF(0), DF_VFR(0, 3), o[3]);
      o[0] = ATT_MFMA(DF_PAF(1), DF_VFR(1, 0), o[0]); o[1] = ATT_MFMA(DF_PAF(1), DF_VFR(1, 1), o[1]); o[2] = ATT_MFMA(DF_PAF(1), DF_VFR(1, 2), o[2]); o[3] = ATT_MFMA(DF_PAF(1), DF_VFR(1, 3), o[3]);
      FX_SBAR();
#pragma unroll
      for (int i = 0; i < 8; ++i) { DF_VRD(0, 2, i); DF_VRD(1, 3, i); }
      o[0] = ATT_MFMA(DF_PAF(2), DF_VFR(0, 0), o[0]); o[1] = ATT_MFMA(DF_PAF(2), DF_VFR(0, 1), o[1]); o[2] = ATT_MFMA(DF_PAF(2), DF_VFR(0, 2), o[2]); o[3] = ATT_MFMA(DF_PAF(2), DF_VFR(0, 3), o[3]);
      o[0] = ATT_MFMA(DF_PAF(3), DF_VFR(1, 0), o[0]); o[1] = ATT_MFMA(DF_PAF(3), DF_VFR(1, 1), o[1]); o[2] = ATT_MFMA(DF_PAF(3), DF_VFR(1, 2), o[2]); o[3] = ATT_MFMA(DF_PAF(3), DF_VFR(1, 3), o[3]); }
    { auto rr = __builtin_amdgcn_permlane32_swap(__float_as_uint(l_reg), __float_as_uint(l_reg), false, false); l_reg = __uint_as_float(rr[0]) + __uint_as_float(rr[1]); }
    if (hi == 0) wsf[32 + r32] = (m == 1) ? lam / l_reg : 1.0f / l_reg;
    asm volatile("s_waitcnt lgkmcnt(0)" ::: "memory");
    float rli[16];
#pragma unroll
    for (int g = 0; g < 4; ++g) { const f32x4 a4 = *(const LAS f32x4*)(wsf + 32 + 8 * g + 4 * hi); rli[4 * g] = a4[0]; rli[4 * g + 1] = a4[1]; rli[4 * g + 2] = a4[2]; rli[4 * g + 3] = a4[3]; }
    ATT_WAIT_BAR();
    {
        LAS float* xch = (LAS float*)lds + qg * 4096;
        if (m == 1) {
#pragma unroll
            for (int db = 0; db < 4; ++db)
#pragma unroll
                for (int r = 0; r < 16; ++r) xch[(db * 16 + r) * 64 + lane] = o[db][r] * rli[r];
        }
        ATT_WAIT_BAR();
        if (m == 0) {
            float ss[16];
#pragma unroll
            for (int r = 0; r < 16; ++r) ss[r] = 0.f;
#pragma unroll
            for (int db = 0; db < 4; ++db)
#pragma unroll
                for (int r = 0; r < 16; ++r) { const float v = o[db][r] * rli[r] - xch[(db * 16 + r) * 64 + lane]; o[db][r] = v; ss[r] += v * v; }
#pragma unroll
            for (int r = 0; r < 16; ++r) {
                float v = ss[r];
                v = sum32(v);
                ss[r] = rsqrtf(v * (1.0f / 128.0f) + EPS) * lnscale;
            }
            LAS bf16_t* stg = (LAS bf16_t*)(lds + LDS_OST) + qg * 4096;
#pragma unroll
            for (int db = 0; db < 4; ++db) { const float gd = ((const GAS float*)subg)[db * 32 + r32];
#pragma unroll
                for (int r = 0; r < 16; ++r) stg[crow(r, hi) * 128 + db * 32 + r32] = (bf16_t)f2bf(o[db][r] * ss[r] * gd); }
            asm volatile("s_waitcnt lgkmcnt(0)" ::: "memory");
            bf16_t* Yw = Y + (rowbase + q0 + qg * 32) * 512 + hcol;
#pragma unroll
            for (int i = 0; i < 8; ++i) { const int row = i * 4 + (lane >> 4), ch = lane & 15; const u32x4 v = *(const LAS u32x4*)(stg + row * 128 + ch * 8); *(GAS u32x4*)(Yw + (size_t)row * 512 + ch * 8) = v; }
        }
    }
    ATT_WAIT_BAR();
#undef DF_DMA_K
#undef DF_DMA_V
#undef DF_ROT
#undef DF_EX
#undef DF_RESC
#undef DF_KLOAD2
#undef DF_CINIT
#undef DF_DECIDE
#undef DF_DECIDE2
#undef DF_PKW
#undef DF_PAF
#undef DF_VFR
#undef DF_VRD
#undef DF_VRD2
#undef DF_KRD
#undef DF_GAPA
#undef DF_GAPB
#undef DF_STEP
#undef DF_WAIT_BAR
#undef DF_AFTER
#undef DF_ENDW
}
}

__device__ __forceinline__ void ph_attention(Frame& F, const bf16_t* QKV, const float* BT, const float* CUM, const float* lamv, const float* subg, float lam_init, bf16_t* YD, bf16_t* YF) {
    const int vcu = (F.G % 8 == 0) ? (F.bid % 8) * (F.G / 8) + F.bid / 8 : F.bid;
    const float l01 = wave_sum(lamv[F.lane] * lamv[64 + F.lane]), l23 = wave_sum(lamv[128 + F.lane] * lamv[192 + F.lane]);
    const float lam = expf(l01) - expf(l23) + lam_init;
    for (int pi = vcu; pi < 256; pi += F.G) {
        const int bh = pi >> 3, s = pi & 7, b = bh >> 2, h = bh & 3;
        for (int k = 0; k < 2; ++k) {
            att::diff_unit(F.lds, F.tid, b, h, k == 0 ? 15 - s : s, QKV, QKV + (size_t)T * 512, QKV + (size_t)2 * T * 512, YD, BT + h * 129, lam, 1.0f - lam_init, subg);
        }
    }
    for (int pi = vcu; pi < 256; pi += F.G) {
        const int bh = pi >> 2, s = pi & 3, b = bh >> 3, h = bh & 7;
        for (int k = 0; k < 2; ++k) {
            att::fox_unit(F.lds, F.tid, b, h, k == 0 ? 7 - s : s, QKV + (size_t)3 * T * 512, QKV + (size_t)4 * T * 512, QKV + (size_t)5 * T * 512, YF, CUM + (size_t)bh * S);
        }
    }
}
namespace peer {
typedef float f32x2 __attribute__((ext_vector_type(2)));
typedef unsigned v6u __attribute__((ext_vector_type(6)));
typedef unsigned u32x2 __attribute__((ext_vector_type(2)));
typedef float v32f __attribute__((ext_vector_type(32)));
constexpr float USCALE = 64.f, VSCALE = 23.f;
constexpr int ROWB = 768;
constexpr size_t TBL_BYTES = (size_t)NEXP * ROWB;

__device__ __forceinline__ unsigned e2m3_code(float x) {
    const float a = fminf(fabsf(x), 7.5f);
    float c = a < 2.f ? __builtin_rintf(a * 8.f) : (a < 4.f ? 16.f + __builtin_rintf((a - 2.f) * 4.f) : 24.f + __builtin_rintf((a - 4.f) * 2.f));
    return (unsigned)c | (x < 0.f ? 32u : 0u);
}
__device__ __forceinline__ void convert_chunk(const float* eu, const float* ev, unsigned char* dst, LAS unsigned char* stg, int lane, int which, size_t ch) {
    const size_t per_l = (size_t)NEXP * D / 32;
    const GAS f32x4* src = (const GAS f32x4*)(which == 0 ? eu : ev);
    const float sc = which == 0 ? USCALE : VSCALE;
    f32x4 in_[8];
#pragma unroll
    for (int k = 0; k < 8; ++k) in_[k] = src[ch * 512 + k * 64 + lane];
#pragma unroll
    for (int k = 0; k < 8; ++k) { const int pidx = k * 64 + lane; *(LAS f32x4*)(stg + pidx * 16 + (pidx >> 3) * 16) = in_[k]; }
    asm volatile("s_waitcnt lgkmcnt(0)" ::: "memory");
    const size_t i = ch * 64 + lane;
    const size_t l = i / per_l, r = i % per_l;
    unsigned o[7];
#pragma unroll
    for (int w = 0; w < 7; ++w) o[w] = 0u;
#pragma unroll
    for (int k = 0; k < 8; ++k) {
        const f32x4 v = *(const LAS f32x4*)(stg + lane * 144 + k * 16) * sc;
#pragma unroll
        for (int e = 0; e < 4; ++e) {
            const int idx = k * 4 + e, pos = 6 * idx, w = pos >> 5, sh = pos & 31;
            const unsigned c = e2m3_code(v[e]);
            o[w] |= c << sh;
            if (sh > 26) o[w + 1] |= c >> (32 - sh);
        }
    }
    asm volatile("s_waitcnt lgkmcnt(0)" ::: "memory");
    GAS u32x2* d2 = (GAS u32x2*)(dst + (l * 2 + which) * TBL_BYTES + r * 24);
    d2[0] = (u32x2){o[0], o[1]}; d2[1] = (u32x2){o[2], o[3]}; d2[2] = (u32x2){o[4], o[5]};
}
__device__ __forceinline__ void convert_tables(Frame& F, const float* eu, const float* ev, unsigned char* dst) {
    const size_t nch = (size_t)NEXP * D / 2048;
    const size_t per_l = (size_t)NEXP * D / 32;
    const int lane = F.lane;
    LAS unsigned char* stg = F.lds + F.wave * 9216;
    for (int which = 0; which < 2; ++which) {
        const GAS f32x4* src = (const GAS f32x4*)(which == 0 ? eu : ev);
        const float sc = which == 0 ? USCALE : VSCALE;
        f32x4 in_[8], nx_[8];
        size_t ch = (size_t)F.gw;
        if (ch < nch) {
#pragma unroll
            for (int k = 0; k < 8; ++k) in_[k] = src[ch * 512 + k * 64 + lane];
        }
        for (; ch < nch; ch += (size_t)F.ngw) {
            const size_t chn = ch + (size_t)F.ngw;
            if (chn < nch) {
#pragma unroll
                for (int k = 0; k < 8; ++k) nx_[k] = src[chn * 512 + k * 64 + lane];
            }
#pragma unroll
            for (int k = 0; k < 8; ++k) { const int pidx = k * 64 + lane; *(LAS f32x4*)(stg + pidx * 16 + (pidx >> 3) * 16) = in_[k]; }
            asm volatile("s_waitcnt lgkmcnt(0)" ::: "memory");
            const size_t i = ch * 64 + lane;
            const size_t l = i / per_l, r = i % per_l;
            unsigned o[7];
#pragma unroll
            for (int w = 0; w < 7; ++w) o[w] = 0u;
#pragma unroll
            for (int k = 0; k < 8; ++k) {
                const f32x4 v = *(const LAS f32x4*)(stg + lane * 144 + k * 16) * sc;
#pragma unroll
                for (int e = 0; e < 4; ++e) {
                    const int idx = k * 4 + e, pos = 6 * idx, w = pos >> 5, sh = pos & 31;
                    const unsigned c = e2m3_code(v[e]);
                    o[w] |= c << sh;
                    if (sh > 26) o[w + 1] |= c >> (32 - sh);
                }
            }
            asm volatile("s_waitcnt lgkmcnt(0)" ::: "memory");
            GAS u32x2* d2 = (GAS u32x2*)(dst + (l * 2 + which) * TBL_BYTES + r * 24);
            d2[0] = (u32x2){o[0], o[1]}; d2[1] = (u32x2){o[2], o[3]}; d2[2] = (u32x2){o[4], o[5]};
#pragma unroll
            for (int k = 0; k < 8; ++k) in_[k] = nx_[k];
        }
    }
}

__device__ __forceinline__ float allreduce16(float s) {
    s += __builtin_bit_cast(float, __builtin_amdgcn_update_dpp(0, __builtin_bit_cast(int, s), 0xB1, 0xF, 0xF, false));
    s += __builtin_bit_cast(float, __builtin_amdgcn_update_dpp(0, __builtin_bit_cast(int, s), 0x4E, 0xF, 0xF, false));
    s += __builtin_bit_cast(float, __builtin_amdgcn_update_dpp(0, __builtin_bit_cast(int, s), 0x141, 0xF, 0xF, false));
    s += __builtin_bit_cast(float, __builtin_amdgcn_update_dpp(0, __builtin_bit_cast(int, s), 0x140, 0xF, 0xF, false));
    return s;
}
__device__ __forceinline__ v32f dec32(unsigned a, unsigned b, unsigned c, unsigned d, unsigned e, unsigned f) { return __builtin_amdgcn_cvt_scalef32_pk32_f32_fp6((v6u){a, b, c, d, e, f}, 1.0f); }

template <int MODE>
__device__ __forceinline__ void ph_peer_gather(Frame& F, const bf16_t* HNp, const float* g2pp, const float* SSPp, const int* EXPIp, const float* GATEp, const unsigned char* EU6p, const unsigned char* EV6p, float* XRp,
                                               const float* gnp, bf16_t* HNoutp, const float* wffp, const float* bfgp, float* logfp, float* outp) {
    const int lane0 = F.lane;
    LAS float* wl = (LAS float*)F.lds;
    if (MODE == 1) {
        const GAS float* wff = (const GAS float*)wffp;
        for (int k = F.tid; k < D; k += NTHREADS) {
            const f32x4 w0 = *(const GAS f32x4*)(wff + (size_t)k * INW + 3072), w1 = *(const GAS f32x4*)(wff + (size_t)k * INW + 3076);
            const int ln = ((k >> 5) & 31) + 32 * ((k >> 4) & 1), slot = (((k >> 2) & 3) * 64 + ln) * 4 + (k & 3);
            wl[0 * D + slot] = w0[0]; wl[1 * D + slot] = w0[1]; wl[2 * D + slot] = w0[2]; wl[3 * D + slot] = w0[3]; wl[4 * D + slot] = w1[0]; wl[5 * D + slot] = w1[1]; wl[6 * D + slot] = w1[2]; wl[7 * D + slot] = w1[3];
        }
        __syncthreads();
    }
    const unsigned char* wsb0 = (const unsigned char*)HNp - WS_HN;
    const GAS unsigned char* EU6 = (const GAS unsigned char*)EU6p; const GAS unsigned char* EV6 = (const GAS unsigned char*)EV6p;
    const GAS float* g2p = (const GAS float*)g2pp;
    int pi0 = 0, pi1 = 0; float pg0 = 0.f, pg1 = 0.f, pss = 0.f;
#define PEER_PREF(tt, ln, wb) do { const GAS int* ei_ = (const GAS int*)((wb) + WS_EXPI) + (size_t)(tt) * 128 + (ln); const GAS float* ga_ = (const GAS float*)((wb) + WS_GATE) + (size_t)(tt) * 128 + (ln); \
        pi0 = ei_[0]; pi1 = ei_[64]; pg0 = ga_[0]; pg1 = ga_[64]; pss = ((ln) < 16) ? ((const GAS float*)((wb) + WS_SSP))[(size_t)(tt) * 16 + (ln)] : 0.f; } while (0)
    if (F.gw < T) PEER_PREF(F.gw, lane0, wsb0);
    size_t cvc = (size_t)F.gw;
    for (int t = F.gw; t < T; t += F.ngw) {
        int lane = lane0; asm volatile("" : "+v"(lane));
        const unsigned char* wsb = opq(wsb0);
        const GAS bf16_t* HN = (const GAS bf16_t*)(wsb + WS_HN); GAS float* XR = (GAS float*)(wsb + WS_XR);
        const int r32 = lane & 31, hi = lane >> 5;
        int idx0 = pi0, idx1 = pi1; float gate0 = pg0, gate1 = pg1; const float ssv0 = pss;
        if (t + F.ngw < T) PEER_PREF(t + F.ngw, lane, wsb);
        {
            unsigned k0 = ((unsigned)idx0 << 7) | (unsigned)lane, k1 = ((unsigned)idx1 << 7) | (unsigned)(64 + lane);
#pragma unroll
            for (int kk = 2; kk <= 128; kk <<= 1) {
#pragma unroll
                for (int j = kk >> 1; j > 0; j >>= 1) {
                    if (j == 64) { const unsigned lo = k0 < k1 ? k0 : k1, hi2 = k0 < k1 ? k1 : k0; k0 = lo; k1 = hi2; }
                    else {
                        const unsigned p0 = (unsigned)bperm_i(lane ^ j, (int)k0), p1 = (unsigned)bperm_i(lane ^ j, (int)k1);
                        const bool lower = (lane & j) == 0;
                        const bool up0 = (lane & kk) == 0 || kk == 128, up1 = ((64 + lane) & kk) == 0 || kk == 128;
                        const bool kmin0 = (lower == up0), kmin1 = (lower == up1);
                        k0 = kmin0 ? (k0 < p0 ? k0 : p0) : (k0 > p0 ? k0 : p0);
                        k1 = kmin1 ? (k1 < p1 ? k1 : p1) : (k1 > p1 ? k1 : p1);
                    }
                }
            }
            const int s0 = (int)(k0 & 127u), s1 = (int)(k1 & 127u);
            const float ga0 = bperm_f(s0 & 63, gate0), gb0 = bperm_f(s0 & 63, gate1), ga1 = bperm_f(s1 & 63, gate0), gb1 = bperm_f(s1 & 63, gate1);
            gate0 = s0 < 64 ? ga0 : gb0; gate1 = s1 < 64 ? ga1 : gb1;
            idx0 = (int)(k0 >> 7); idx1 = (int)(k1 >> 7);
        }
        float cv0 = 0.f, cv1 = 0.f;
        {
            f32x2 tu[16];
            u32x2 ub[4][3];
#define PEER_ULOAD(s, slot) do { const int ix_ = bperm_i((lane & 32) + ((s) & 31), ((s) >> 5) ? idx1 : idx0); \
            const GAS u32x2* p_ = (const GAS u32x2*)(EU6 + (size_t)ix_ * ROWB + r32 * 24); ub[slot][0] = p_[0]; ub[slot][1] = p_[1]; ub[slot][2] = p_[2]; } while (0)
#define PEER_UCOMP(s, slot) do { f32x2 a0_ = {0.f, 0.f}, a1_ = {0.f, 0.f}; \
            { const v32f g_ = dec32(ub[slot][0][0], ub[slot][0][1], ub[slot][1][0], ub[slot][1][1], ub[slot][2][0], ub[slot][2][1]); \
              _Pragma("unroll") for (int j = 0; j < 16; j += 2) { a0_ = (f32x2){g_[2 * j], g_[2 * j + 1]} * tu[j] + a0_; a1_ = (f32x2){g_[2 * j + 2], g_[2 * j + 3]} * tu[j + 1] + a1_; } } \
            const float tot_ = sum32((a0_[0] + a0_[1]) + (a1_[0] + a1_[1])); \
            if (((s) >> 5) == 0) { if (r32 == ((s) & 31)) cv0 = tot_; } else { if (r32 == ((s) & 31)) cv1 = tot_; } } while (0)
            asm volatile("" ::: "memory");
            v4u trow[4];
#pragma unroll
            for (int q = 0; q < 4; ++q) trow[q] = ((const GAS v4u*)(HN + (size_t)t * D + r32 * 32))[q];
            PEER_ULOAD(0, 0); PEER_ULOAD(1, 1); PEER_ULOAD(2, 2);
            {
              const float ssv = sum32(ssv0);
              const float rsn = rsqrtf(__builtin_bit_cast(float, __builtin_amdgcn_readlane(__builtin_bit_cast(int, ssv), 0)) * (1.0f / D) + EPS);
              const GAS f32x4* gq = (const GAS f32x4*)(g2p + r32 * 32);
#pragma unroll
              for (int q = 0; q < 4; ++q) { const v4u a = trow[q]; const f32x4 ga = gq[2 * q] * rsn, gb = gq[2 * q + 1] * rsn;
                  tu[q * 4 + 0] = (f32x2){__uint_as_float(a[0] << 16) * ga[0], __uint_as_float(a[0] & 0xffff0000u) * ga[1]};
                  tu[q * 4 + 1] = (f32x2){__uint_as_float(a[1] << 16) * ga[2], __uint_as_float(a[1] & 0xffff0000u) * ga[3]};
                  tu[q * 4 + 2] = (f32x2){__uint_as_float(a[2] << 16) * gb[0], __uint_as_float(a[2] & 0xffff0000u) * gb[1]};
                  tu[q * 4 + 3] = (f32x2){__uint_as_float(a[3] << 16) * gb[2], __uint_as_float(a[3] & 0xffff0000u) * gb[3]}; } }
            for (int s0 = 0; s0 < 60; s0 += 4) {
                PEER_ULOAD(s0 + 3, 3); PEER_UCOMP(s0, 0);
                PEER_ULOAD(s0 + 4, 0); PEER_UCOMP(s0 + 1, 1);
                PEER_ULOAD(s0 + 5, 1); PEER_UCOMP(s0 + 2, 2);
                PEER_ULOAD(s0 + 6, 2); PEER_UCOMP(s0 + 3, 3);
            }
            PEER_ULOAD(63, 3); PEER_UCOMP(60, 0); PEER_UCOMP(61, 1); PEER_UCOMP(62, 2); PEER_UCOMP(63, 3);
#undef PEER_ULOAD
#undef PEER_UCOMP
        }
        float c0, c1;
        { const float x0 = cv0 * (1.0f / USCALE), x1 = cv1 * (1.0f / USCALE);
          c0 = gate0 * (0.5f * x0 * (1.0f + erff(x0 * 0.70710678118654752f))) * (1.0f / VSCALE);
          c1 = gate1 * (0.5f * x1 * (1.0f + erff(x1 * 0.70710678118654752f))) * (1.0f / VSCALE); }
        f32x2 acc[16];
#pragma unroll
        for (int k = 0; k < 16; ++k) acc[k] = (f32x2){0.f, 0.f};
        u32x2 vb[6][3];
#define PEER_VLOAD(s, slot) do { const int sl_ = (lane & 32) + ((s) & 31); const int ix_ = bperm_i(sl_, ((s) >> 5) ? idx1 : idx0); \
            const GAS u32x2* p_ = (const GAS u32x2*)(EV6 + (size_t)ix_ * ROWB + r32 * 24); vb[slot][0] = p_[0]; vb[slot][1] = p_[1]; vb[slot][2] = p_[2]; } while (0)
#define PEER_VCOMP(s, slot) do { const int sl_ = (lane & 32) + ((s) & 31); const float c_ = bperm_f(sl_, ((s) >> 5) ? c1 : c0); const f32x2 cc_ = {c_, c_}; \
            const v32f g_ = dec32(vb[slot][0][0], vb[slot][0][1], vb[slot][1][0], vb[slot][1][1], vb[slot][2][0], vb[slot][2][1]); \
            _Pragma("unroll") for (int j = 0; j < 16; ++j) acc[j] = (f32x2){g_[2 * j], g_[2 * j + 1]} * cc_ + acc[j]; } while (0)
#pragma unroll
        for (int k = 0; k < 5; ++k) PEER_VLOAD(k, k);
        for (int s0 = 0; s0 < 54; s0 += 6) {
#pragma unroll
            for (int k = 0; k < 6; ++k) { PEER_VLOAD(s0 + k + 5, (k + 5) % 6); PEER_VCOMP(s0 + k, k); }
        }
#pragma unroll
        for (int k = 0; k < 5; ++k) { PEER_VLOAD(59 + k, (k + 5) % 6); PEER_VCOMP(54 + k, k); }
#pragma unroll
        for (int k = 0; k < 5; ++k) PEER_VCOMP(59 + k, (k + 5) % 6);
#undef PEER_VLOAD
#undef PEER_VCOMP
        float pv[16];
#pragma unroll
        for (int j = 0; j < 8; ++j) {
            const float mx = hi ? acc[8 + j][0] : acc[j][0], my = hi ? acc[8 + j][1] : acc[j][1];
            const float ox = hi ? acc[j][0] : acc[8 + j][0], oy = hi ? acc[j][1] : acc[8 + j][1];
            pv[2 * j] = mx + bperm_f(lane ^ 32, ox); pv[2 * j + 1] = my + bperm_f(lane ^ 32, oy);
        }
        int e0 = r32 * 32 + hi * 16; asm volatile("" : "+v"(e0));
        GAS f32x4* xp = (GAS f32x4*)(XR + (size_t)t * D + e0);
        f32x4 xv[4];
#pragma unroll
        for (int j = 0; j < 4; ++j) xv[j] = xp[j];
        float ss = 0.f;
#pragma unroll
        for (int j = 0; j < 4; ++j) { xv[j][0] += pv[4 * j]; xv[j][1] += pv[4 * j + 1]; xv[j][2] += pv[4 * j + 2]; xv[j][3] += pv[4 * j + 3];
            ss += xv[j][0] * xv[j][0] + xv[j][1] * xv[j][1] + xv[j][2] * xv[j][2] + xv[j][3] * xv[j][3]; }
        if (MODE != 2) {
#pragma unroll
            for (int j = 0; j < 4; ++j) xp[j] = xv[j];
        }
        ss = wave_sum(ss);
        const float rs = rsqrtf(ss * (1.0f / D) + EPS);
        const GAS f32x4* gp = (const GAS f32x4*)(gnp + e0);
#pragma unroll
        for (int j = 0; j < 4; ++j) { const f32x4 gg = gp[j]; xv[j] = xv[j] * gg * rs; }
        if (MODE == 2) {
            GAS f32x4* op = (GAS f32x4*)(outp + (size_t)t * D + e0);
#pragma unroll
            for (int j = 0; j < 4; ++j) op[j] = xv[j];
        } else {
            v4u h0, h1;
            h0[0] = pk2(xv[0][0], xv[0][1]); h0[1] = pk2(xv[0][2], xv[0][3]); h0[2] = pk2(xv[1][0], xv[1][1]); h0[3] = pk2(xv[1][2], xv[1][3]);
            h1[0] = pk2(xv[2][0], xv[2][1]); h1[1] = pk2(xv[2][2], xv[2][3]); h1[2] = pk2(xv[3][0], xv[3][1]); h1[3] = pk2(xv[3][2], xv[3][3]);
            GAS v4u* hp = (GAS v4u*)((GAS bf16_t*)(wsb + WS_HN) + (size_t)t * D + e0); hp[0] = h0; hp[1] = h1;
            float a[8];
#pragma unroll
            for (int q = 0; q < 8; ++q) { float s = 0.f;
#pragma unroll
                for (int j = 0; j < 4; ++j) { const f32x4 w = *(const LAS f32x4*)(wl + q * D + (j * 64 + lane) * 4); s += (xv[j][0] * w[0] + xv[j][1] * w[1]) + (xv[j][2] * w[2] + xv[j][3] * w[3]); }
                a[q] = wave_sum(s); }
            if (lane < 8) {
                float f = lane == 0 ? a[0] : lane == 1 ? a[1] : lane == 2 ? a[2] : lane == 3 ? a[3] : lane == 4 ? a[4] : lane == 5 ? a[5] : lane == 6 ? a[6] : a[7];
                f += bfgp[lane];
                ((GAS float*)(wsb + WS_LOGF))[(size_t)t * 8 + lane] = fminf(f, 0.f) - log1pf(expf(-fabsf(f)));
            }
        }
        if (MODE == 1) {
            constexpr size_t NCHL = (size_t)NEXP * D / 2048;
            if (cvc < 2 * NCHL) { int lc_ = lane; asm volatile("" : "+v"(lc_));
                peer::convert_chunk(ARG_IN(12), ARG_IN(13), (unsigned char*)(opq(wsb0) + WS_EXP), F.lds + 32768 + F.wave * 9216, lc_, (int)(cvc / NCHL), NCHL + cvc % NCHL); cvc += (size_t)F.ngw; }
        }
    }
    if (MODE == 1) {
        constexpr size_t NCHL = (size_t)NEXP * D / 2048;
        for (; cvc < 2 * NCHL; cvc += (size_t)F.ngw) { int lc_ = lane0; asm volatile("" : "+v"(lc_)); peer::convert_chunk(ARG_IN(12), ARG_IN(13), (unsigned char*)(opq(wsb0) + WS_EXP), F.lds + 32768 + F.wave * 9216, lc_, (int)(cvc / NCHL), NCHL + cvc % NCHL); }
    }
}
}
namespace route {
typedef float f32x16 __attribute__((ext_vector_type(16)));
typedef unsigned u32x2 __attribute__((ext_vector_type(2)));
constexpr int KROW = 272;
constexpr int KIMG = 128 * KROW;
constexpr int OFF_SLOT = 2 * KIMG;

#define RT_CE(a, b) do { const float hi_ = fmaxf(a, b), lo_ = fminf(a, b); a = hi_; b = lo_; } while (0)
template <int BASE> __device__ __forceinline__ void sort16(float (&v)[64]) {
    constexpr int NET[60][2] = {{0, 13}, {1, 12}, {2, 15}, {3, 14}, {4, 8}, {5, 6}, {7, 11}, {9, 10},   {0, 5}, {1, 7}, {2, 9}, {3, 4}, {6, 13}, {8, 14}, {10, 15}, {11, 12},
                                {0, 1}, {2, 3}, {4, 5}, {6, 8}, {7, 9}, {10, 11}, {12, 13}, {14, 15},   {0, 2}, {1, 3}, {4, 10}, {5, 11}, {6, 7}, {8, 9}, {12, 14}, {13, 15},
                                {1, 2}, {3, 12}, {4, 6}, {5, 7}, {8, 10}, {9, 11}, {13, 14},   {1, 4}, {2, 6}, {5, 8}, {7, 10}, {9, 13}, {11, 14},   {2, 4}, {3, 6}, {9, 12}, {11, 13},
                                {3, 5}, {6, 8}, {7, 9}, {10, 12},   {3, 4}, {5, 6}, {7, 8}, {9, 10}, {11, 12},   {6, 7}, {8, 9}};
#pragma unroll
    for (int c = 0; c < 60; ++c) RT_CE(v[BASE + NET[c][0]], v[BASE + NET[c][1]]);
}
template <int A, int B> __device__ __forceinline__ void merge16(float (&v)[64]) {
#pragma unroll
    for (int i = 0; i < 16; ++i) v[A + i] = fmaxf(v[A + i], v[B + 15 - i]);
#pragma unroll
    for (int j = 8; j > 0; j >>= 1)
#pragma unroll
        for (int i = 0; i < 16; ++i) { const int l = i ^ j; if (l > i) RT_CE(v[A + i], v[A + l]); }
}
__device__ __forceinline__ void top16_of_64(float (&v)[64]) { sort16<0>(v); sort16<16>(v); sort16<32>(v); sort16<48>(v); merge16<0, 16>(v); merge16<32, 48>(v); merge16<0, 32>(v); }

__device__ __forceinline__ void ph_route(Frame& F, const pg8::StaticOrder& So, const bf16_t* QPp, const float* SKp, int* EXPIp, float* GATEp) {
    const int lane = F.lane, r32 = lane & 31, hi = lane >> 5;
    const GAS bf16_t* QP = (const GAS bf16_t*)QPp; const GAS float* SK = (const GAS float*)SKp;
    {
        f32x4 k4[16];
#pragma unroll
        for (int q = 0; q < 16; ++q) k4[q] = *(const GAS f32x4*)(SK + (size_t)(F.tid + q * NTHREADS) * 4);
#pragma unroll
        for (int q = 0; q < 16; ++q) {
            const int e = (F.tid + q * NTHREADS) * 4, p = e >> 14, n = (e >> 7) & 127, d = e & 127;
            u32x2 o; o[0] = pk2(k4[q][0], k4[q][1]); o[1] = pk2(k4[q][2], k4[q][3]);
            *(LAS u32x2*)(F.lds + p * KIMG + n * KROW + d * 2) = o;
        }
    }
    __syncthreads();
    LAS unsigned* slot = (LAS unsigned*)(F.lds + OFF_SLOT + F.wave * 8192) + lane;
    pg8::Unit u_;
    for (int ui = 0; So.next(ui, u_); ++ui) {
        const int tile = u_.pm * 8 + F.wave, h = u_.pn;
        const int tok = tile * 32 + r32;
        float s01[2][16];
#pragma unroll
        for (int p = 0; p < 2; ++p) {
            bf16x8 qf[8];
#pragma unroll
            for (int ks = 0; ks < 8; ++ks) qf[ks] = *(const GAS bf16x8*)(QP + (size_t)tok * 2048 + h * 256 + p * 128 + ks * 16 + hi * 8);
            f32x16 acc[4];
#pragma unroll
            for (int kb = 0; kb < 4; ++kb) acc[kb] = f32x16{};
            const LAS unsigned char* kbase = F.lds + p * KIMG + r32 * KROW + hi * 16;
#pragma unroll
            for (int ks = 0; ks < 8; ++ks)
#pragma unroll
                for (int kb = 0; kb < 4; ++kb) {
                    const bf16x8 a = *(const LAS bf16x8*)(kbase + kb * 32 * KROW + ks * 32);
                    acc[kb] = __builtin_amdgcn_mfma_f32_32x32x16_bf16(a, qf[ks], acc[kb], 0, 0, 0);
                }
            float v[64];
#pragma unroll
            for (int kb = 0; kb < 4; ++kb)
#pragma unroll
                for (int r = 0; r < 16; ++r) {
                    const unsigned n = (unsigned)(32 * kb + (r & 3) + 8 * (r >> 2)) + 4u * (unsigned)hi;
                    v[kb * 16 + r] = __uint_as_float((__float_as_uint(acc[kb][r]) & 0xFFFFFF80u) | n);
                }
            top16_of_64(v);
            float w[16];
#pragma unroll
            for (int i = 0; i < 16; ++i) w[i] = bperm_f(lane ^ 32, v[15 - i]);
#pragma unroll
            for (int i = 0; i < 16; ++i) v[i] = fmaxf(v[i], w[i]);
#pragma unroll
            for (int j = 8; j > 0; j >>= 1)
#pragma unroll
                for (int i = 0; i < 16; ++i) { const int l = i ^ j; if (l > i) RT_CE(v[i], v[l]); }
#pragma unroll
            for (int i = 0; i < 16; ++i) s01[p][i] = v[i];
        }
#pragma unroll
        for (int i = 0; i < 16; ++i) { slot[i * 64] = __float_as_uint(s01[0][i]) & 127u; slot[(16 + i) * 64] = __float_as_uint(s01[1][i]) & 127u; }
        float c[64];
        {
            constexpr int CNT[16] = {16, 8, 5, 4, 3, 2, 2, 2, 1, 1, 1, 1, 1, 1, 1, 1}, OFS[16] = {0, 16, 24, 29, 33, 36, 38, 40, 42, 43, 44, 45, 46, 47, 48, 49};
#pragma unroll
            for (int a = 0; a < 16; ++a)
#pragma unroll
                for (int b = 0; b < 16; ++b)
                    if (b < CNT[a]) c[OFS[a] + b] = __uint_as_float((__float_as_uint(s01[0][a] + s01[1][b]) & 0xFFFFFF00u) | (unsigned)(a * 16 + b));
#pragma unroll
            for (int i = 50; i < 64; ++i) c[i] = -INFINITY;
        }
        sort16<16>(c); sort16<32>(c); RT_CE(c[48], c[49]); merge16<0, 16>(c); merge16<32, 48>(c); merge16<0, 32>(c);
        float g[16]; int ex[16];
        asm volatile("s_waitcnt lgkmcnt(0)" ::: "memory");
        const float mx = __uint_as_float(__float_as_uint(c[0]) & 0xFFFFFF00u);
        float sum = 0.f;
#pragma unroll
        for (int i = 0; i < 16; ++i) {
            const unsigned bits = __float_as_uint(c[i]);
            const unsigned a = (bits >> 4) & 15u, b = bits & 15u;
            g[i] = __expf(__uint_as_float(bits & 0xFFFFFF00u) - mx); sum += g[i];
            ex[i] = (int)(slot[a * 64] * 128u + slot[(16 + b) * 64]);
        }
        const float inv = 1.0f / sum;
        GAS int* eo = (GAS int*)EXPIp + ((size_t)tok * 8 + h) * 16 + hi * 8;
        GAS float* go = (GAS float*)GATEp + ((size_t)tok * 8 + h) * 16 + hi * 8;
        if (hi == 0) {
            *(GAS v4u*)eo = (v4u){(unsigned)ex[0], (unsigned)ex[1], (unsigned)ex[2], (unsigned)ex[3]}; *(GAS v4u*)(eo + 4) = (v4u){(unsigned)ex[4], (unsigned)ex[5], (unsigned)ex[6], (unsigned)ex[7]};
            *(GAS f32x4*)go = (f32x4){g[0] * inv, g[1] * inv, g[2] * inv, g[3] * inv}; *(GAS f32x4*)(go + 4) = (f32x4){g[4] * inv, g[5] * inv, g[6] * inv, g[7] * inv};
        } else {
            *(GAS v4u*)eo = (v4u){(unsigned)ex[8], (unsigned)ex[9], (unsigned)ex[10], (unsigned)ex[11]}; *(GAS v4u*)(eo + 4) = (v4u){(unsigned)ex[12], (unsigned)ex[13], (unsigned)ex[14], (unsigned)ex[15]};
            *(GAS f32x4*)go = (f32x4){g[8] * inv, g[9] * inv, g[10] * inv, g[11] * inv}; *(GAS f32x4*)(go + 4) = (f32x4){g[12] * inv, g[13] * inv, g[14] * inv, g[15] * inv};
        }
        asm volatile("s_waitcnt lgkmcnt(0)" ::: "memory");
    }
}
#undef RT_CE
}
constexpr int NPL = 6;
constexpr int N_PHASES = 1 + DEPTH * NPL;
__global__ void __launch_bounds__(NTHREADS, 2) mega_fwd(Args  ) {
    extern __shared__ __attribute__((aligned(16))) unsigned char lds[];
    cg::grid_group grid = cg::this_grid();
    Frame F;
    F.lds = (LAS unsigned char*)lds;
    F.G = gridDim.x; F.ngw = F.G * NWAVES;
    volatile LAS unsigned* bst = (volatile LAS unsigned*)(F.lds + LDS_BYTES - 64);
    const int wave0 = __builtin_amdgcn_readfirstlane((int)threadIdx.x >> 6);
    if (threadIdx.x == 0) { bst[0] = 0u; bst[1] = 0u; }
    __syncthreads();
    const XcdBarrier bar = xcd_barrier_post((unsigned*)(ARG_WS + WS_CTL) + CW_BAR, bst, (int)threadIdx.x);
    for (int ph = ARG_PHLO; ph < ARG_PHHI; ++ph) {
        { int t_; asm volatile("v_mbcnt_lo_u32_b32 %0, -1, 0\n\tv_mbcnt_hi_u32_b32 %0, -1, %0" : "=v"(t_)); t_ += wave0 * 64; asm volatile("" : "+v"(t_)); int b_ = blockIdx.x; asm volatile("" : "+s"(b_));
          int l_ = t_ & 63; asm volatile("" : "+v"(l_));
          F.tid = t_; F.lane = l_; F.wave = __builtin_amdgcn_readfirstlane(t_ >> 6); F.bid = b_; F.gw = b_ * NWAVES + F.wave; }
        unsigned char* ws = ARG_WS;
        float* XR = (float*)(ws + WS_XR);
        bf16_t* HN = (bf16_t*)(ws + WS_HN);
        if (ph == 0) {
            ph_prologue(F);
            __syncthreads();
            peer::convert_tables(F, ARG_IN(12), ARG_IN(13), ws + WS_EXP);
            __syncthreads();
            ph_rmsnorm(F, ARG_IN(0), ARG_IN(1), HN, ARG_IN(2), ARG_IN(3), (float*)(ws + WS_LOGF));
        } else {
            const int l = (ph - 1) / NPL, k = (ph - 1) % NPL;
            const float* xin = (l == 0) ? ARG_IN(0) : XR;
            switch (k) {
            case 0: {
                ph_cumsum(F, (const float*)(ws + WS_LOGF), (float*)(ws + WS_CUM));
                pg8::Gemm g{HN, (const bf16_t*)(ws + WS_WIN + (size_t)l * 10 * MiB), T, NPROJ, D}; pg8::StaticOrder So; So.init(T, NPROJ, F.G, F.bid);
                pg8::EpiProj E{(bf16_t*)(ws + WS_A), (bf16_t*)(ws + WS_SG)};
                pg8::gemm_phase<pg8::EpiProj, pg8::StaticOrder, true, true>(F.lds, g, So, E, F.tid);
            } break;
            case 1: {
                const float lam_init = 0.8f - 0.6f * expf(-0.3f * (float)l);
                ph_attention(F, (const bf16_t*)(ws + WS_A), (const float*)(ws + WS_BT), (const float*)(ws + WS_CUM), ARG_IN(4) + l * 256, ARG_IN(5) + l * 128, lam_init, (bf16_t*)(ws + WS_YD), (bf16_t*)(ws + WS_YF));
            } break;
            case 2: {
                { pg8::Gemm g{(const bf16_t*)(ws + WS_YD), (const bf16_t*)(ws + WS_WDO + (size_t)l * MiB), T, D, 512}; pg8::StaticOrder So; So.init(T, D, F.G, F.bid);
                  pg8::EpiMerge1 E{(const bf16_t*)(ws + WS_SG), (bf16_t*)(ws + WS_MGT)};
                  pg8::gemm_phase<pg8::EpiMerge1, pg8::StaticOrder, true, true>(F.lds, g, So, E, F.tid); }
                ws = opq(ws);
                { pg8::Gemm g{(const bf16_t*)(ws + WS_YF), (const bf16_t*)(ws + WS_WFO + (size_t)l * MiB), T, D, 512}; pg8::StaticOrder So; So.init(T, D, F.G, F.bid);
                  pg8::EpiMerge2 E{(const bf16_t*)(ws + WS_SG) + (size_t)T * 1024, (const bf16_t*)(ws + WS_MGT), (bf16_t*)(ws + WS_MG)};
                  pg8::gemm_phase<pg8::EpiMerge2, pg8::StaticOrder, true, true>(F.lds, g, So, E, F.tid); }
            } break;
            case 3: {
                pg8::Gemm g{(const bf16_t*)(ws + WS_MG), (const bf16_t*)(ws + WS_WOUT + (size_t)l * 2 * MiB), T, D, D}; pg8::StaticOrder So; So.init(T, D, F.G, F.bid);
                pg8::EpiResidSS E{xin, XR, HN, (float*)(ws + WS_SSP)};
                pg8::gemm_phase<pg8::EpiResidSS, pg8::StaticOrder, true, true>(F.lds, g, So, E, F.tid);
            } break;
            case 4: {
                pg8::StaticOrder So; So.init(T, 2048, F.G, F.bid);
                LAS float* rsl = (LAS float*)(F.lds + 131072 + 4096);
                int pm0 = 0;
                { pg8::Unit u_; for (int ui = 0; ui < 2 && So.next(ui, u_); ++ui) { if (ui == 0) pm0 = u_.pm;
                      if (F.tid < 256) { const GAS f32x4* sp = (const GAS f32x4*)((const float*)(ws + WS_SSP) + (size_t)(u_.pm * 256 + F.tid) * 16);
                          const f32x4 s0 = sp[0], s1 = sp[1], s2 = sp[2], s3 = sp[3];
                          const float ss = ((s0[0] + s0[1]) + (s0[2] + s0[3])) + ((s1[0] + s1[1]) + (s1[2] + s1[3])) + ((s2[0] + s2[1]) + (s2[2] + s2[3])) + ((s3[0] + s3[1]) + (s3[2] + s3[3]));
                          rsl[(u_.pm == pm0 ? 0 : 256) + F.tid] = rsqrtf(ss * (1.0f / D) + EPS); } } }
                __syncthreads();
                { pg8::Gemm g{HN, (const bf16_t*)(ws + WS_WQ + (size_t)l * 4 * MiB), T, 2048, D};
                  pg8::EpiQP E{(bf16_t*)(ws + WS_QP), rsl, pm0};
                  pg8::gemm_phase<pg8::EpiQP, pg8::StaticOrder, true, true>(F.lds, g, So, E, F.tid); }
                asm volatile("s_waitcnt vmcnt(0)" ::: "memory");
                __syncthreads();
                if (F.tid == 0) { __builtin_amdgcn_fence(__ATOMIC_ACQUIRE, "agent"); asm volatile("s_waitcnt vmcnt(0)" ::: "memory"); }
                __syncthreads();
                ws = opq(ws);
                route::ph_route(F, So, (const bf16_t*)(ws + WS_QP), ARG_IN(11) + (size_t)l * 2 * 128 * 128, (int*)(ws + WS_EXPI), (float*)(ws + WS_GATE));
            } break;
            case 5: {
                const unsigned char* eu8 = ws + WS_EXP + (size_t)(l * 2) * peer::TBL_BYTES; const unsigned char* ev8 = eu8 + peer::TBL_BYTES;
                if (l + 1 < DEPTH)
                    peer::ph_peer_gather<1>(F, HN, ARG_IN(9) + l * D, (const float*)(ws + WS_SSP), (const int*)(ws + WS_EXPI), (const float*)(ws + WS_GATE), eu8, ev8, XR,
                                            ARG_IN(1) + (l + 1) * D, HN, ARG_IN(2) + (size_t)(l + 1) * D * INW, ARG_IN(3) + (l + 1) * 8, (float*)(ws + WS_LOGF), nullptr);
                else
                    peer::ph_peer_gather<2>(F, HN, ARG_IN(9) + l * D, (const float*)(ws + WS_SSP), (const int*)(ws + WS_EXPI), (const float*)(ws + WS_GATE), eu8, ev8, XR,
                                            ARG_IN(15), nullptr, nullptr, nullptr, nullptr, ARG_OUT);
            } break;
            }
        }
        if (ph + 1 < ARG_PHHI) { if (ARG_PHHI > N_PHASES) grid.sync(); else xcd_barrier(bar, F.tid); }
    }
}

extern "C" void kernel_launch(void* const* d_in, const int* in_sizes, int n_in, void* d_out, int out_size, void* d_ws, size_t ws_size, hipStream_t stream) {
    static int grid = 0;
    if (grid == 0) {
        if (n_in != 16 || ws_size < WS_END) { fprintf(stderr, "kernel_launch: unexpected inputs (n_in %d, ws %zu)\n", n_in, ws_size); grid = -1; return; }
        int dev = 0, cus = 0, per_cu = 0;
        if (hipGetDevice(&dev) != hipSuccess || hipDeviceGetAttribute(&cus, hipDeviceAttributeMultiprocessorCount, dev) != hipSuccess) { grid = -1; return; }
        if (hipFuncSetAttribute((const void*)mega_fwd, hipFuncAttributeMaxDynamicSharedMemorySize, LDS_BYTES) != hipSuccess) { fprintf(stderr, "kernel_launch: hipFuncSetAttribute failed\n"); grid = -1; return; }
        if (hipOccupancyMaxActiveBlocksPerMultiprocessor(&per_cu, (const void*)mega_fwd, NTHREADS, LDS_BYTES) != hipSuccess || per_cu < 1) { fprintf(stderr, "kernel_launch: occupancy query says %d\n", per_cu); per_cu = 1; }
        (void)hipGetLastError();
        grid = cus;
    }
    if (grid < 0) return;
    (void)hipMemsetAsync((char*)d_ws + WS_CTL, 0, CTL_ZERO_BYTES, stream);
    Args a{};
    for (int i = 0; i < 16; ++i) a.in[i] = (const float*)d_in[i];
    a.out = (float*)d_out; a.ws = (unsigned char*)d_ws; a.ph_lo = 0; a.ph_hi = N_PHASES;
    void* kargs[] = {&a};
    hipError_t e = hipLaunchCooperativeKernel((const void*)mega_fwd, dim3(grid), dim3(NTHREADS), kargs, LDS_BYTES, stream);
    if (e != hipSuccess) fprintf(stderr, "kernel_launch: cooperative launch failed: %s (grid %d)\n", hipGetErrorString(e), grid);
}
```

```cpp
#include <hip/hip_runtime.h>
#include <hip/hip_cooperative_groups.h>
#include <cstdio>
#include <cstdint>
#include <math.h>
namespace cg = cooperative_groups;
namespace pg8 {
#define PG8_LAS __attribute__((address_space(3)))
typedef unsigned short bf16_t;
typedef short bf16x8 __attribute__((ext_vector_type(8)));
typedef float f32x4 __attribute__((ext_vector_type(4)));
typedef unsigned u32x4 __attribute__((ext_vector_type(4)));
constexpr int BM = 256, BK = 64, HALF = 128, HTB = HALF * BK * 2  , STAGE_BYTES = 8 * HTB, NXCD = 8, WGM = 8;

__host__ __device__ __forceinline__ int lds_byte(int r, int c) { const int st = (r >> 4) * 2 + (c >> 5), rr = r & 15, cc = c & 31, ob = rr * 64 + cc * 2; return st * 1024 + (ob ^ (((ob >> 9) & 1) << 5)); }
__host__ __device__ __forceinline__ void stage_rc(int b, int& R, int& C) { const int st = b / 1024, sb = b % 1024, swz = sb ^ (((sb >> 9) & 1) << 5); R = (st >> 1) * 16 + swz / 64; C = (st & 1) * 32 + (swz % 64) / 2; }
__host__ __device__ __forceinline__ int perm32(int rho) { const int n = rho >> 4, i = rho & 15; return 8 * (i >> 2) + 4 * n + (i & 3); }

struct Unit { int pm, pn; };
struct Gemm { const bf16_t* A; const bf16_t* Bt; int M, N, K; };

struct StaticOrder {
    int nM, nN, nwg, G, c;
    __host__ __device__ void init(int M, int N, int G_, int c_) { nM = M / BM; nN = N / BM; nwg = nM * nN; G = G_; c = c_; }
    __host__ __device__ bool next(int i, Unit& u) const {
        const long L = (long)i * G + c; if (L >= nwg) return false;
        int wgid = (int)L; { const int q = nwg / NXCD, r = nwg % NXCD, xcd = wgid % NXCD, off = wgid / NXCD; wgid = (xcd < r ? xcd * (q + 1) : r * (q + 1) + (xcd - r) * q) + off; }
        const int nig = WGM * nN, gid = wgid / nig, fm = gid * WGM, gsz = (nM - fm) < WGM ? (nM - fm) : WGM;
        u.pm = fm + ((wgid % nig) % gsz); u.pn = (wgid % nig) / gsz; return true;
    }
    __device__ __forceinline__ void a_ready(const Unit&) const {}
    __device__ __forceinline__ void done(const Unit&) const {}
};

__device__ __forceinline__ unsigned cvt_pk_bf16(float lo, float hi) { unsigned r; asm volatile("v_cvt_pk_bf16_f32 %0, %1, %2" : "=v"(r) : "v"(lo), "v"(hi)); return r; }
typedef float f32x2 __attribute__((ext_vector_type(2)));
__device__ __forceinline__ f32x2 gelu_pk(f32x2 v) {
    const f32x2 av = __builtin_elementwise_abs(v), d = av * 0.2316418882f + 1.0f;
    f32x2 t; t.x = __builtin_amdgcn_rcpf(d.x); t.y = __builtin_amdgcn_rcpf(d.y);
    f32x2 q = t * 0.5307027145f + (-0.7265760135f); q = q * t + 0.7107068705f; q = q * t + (-0.142248368f); q = q * t + 0.127414796f; q = q * t;
    const f32x2 s = (v * v) * (-0.72134752044f);
    f32x2 e; e.x = __builtin_amdgcn_exp2f(s.x); e.y = __builtin_amdgcn_exp2f(s.y);
    const f32x2 m = v * (q * e), r = v - m;
    f32x2 o; o.x = v.x < 0.f ? m.x : r.x; o.y = v.y < 0.f ? m.y : r.y; return o;
}

template <int ACT  > struct EpiBf16 {
    static constexpr bool PERM = true, AFTER_DRAIN = false; static_assert(ACT == 0 || ACT == 1, "EpiBf16: ACT is 0 (none) or 1 (gelu_pk)");
    bf16_t* O; int ldc; const float* bias; int split_cols; size_t split_stride; float scale0;
    __device__ __forceinline__ void operator()(const f32x4 (&acc)[2][2][4][2], const Unit& u, int wr, int wc, int fr, int fq) const {
        const int row0 = u.pm * BM + wr * 64 + fr; int colt = u.pn * BM; bf16_t* base = O;
        float sc = 1.f; if (split_cols) { const int t = colt / split_cols; base += (size_t)t * split_stride; colt -= t * split_cols; if (t == 0) sc = scale0; }
        const int col0 = colt + wc * 32 + 8 * fq, bcol0 = u.pn * BM + wc * 32 + 8 * fq;
        f32x4 bv[2][2];
#pragma unroll
        for (int bj = 0; bj < 2; ++bj)
#pragma unroll
            for (int n = 0; n < 2; ++n) bv[bj][n] = bias ? *(const f32x4*)(bias + bcol0 + bj * HALF + 4 * n) : (f32x4){0.f, 0.f, 0.f, 0.f};
#pragma unroll
        for (int ai = 0; ai < 2; ++ai)
#pragma unroll
            for (int m = 0; m < 4; ++m) { bf16_t* rowp = base + (size_t)(row0 + ai * HALF + m * 16) * ldc + col0;
#pragma unroll
                for (int bj = 0; bj < 2; ++bj) { f32x4 v0 = acc[ai][bj][m][0] + bv[bj][0], v1 = acc[ai][bj][m][1] + bv[bj][1];
                    if (ACT == 1) { f32x2 a = gelu_pk((f32x2){v0[0], v0[1]}), b = gelu_pk((f32x2){v0[2], v0[3]}), c = gelu_pk((f32x2){v1[0], v1[1]}), d = gelu_pk((f32x2){v1[2], v1[3]});
                        v0 = (f32x4){a.x, a.y, b.x, b.y}; v1 = (f32x4){c.x, c.y, d.x, d.y}; }
                    v0 = v0 * sc; v1 = v1 * sc; u32x4 w; w.x = cvt_pk_bf16(v0[0], v0[1]); w.y = cvt_pk_bf16(v0[2], v0[3]); w.z = cvt_pk_bf16(v1[0], v1[1]); w.w = cvt_pk_bf16(v1[2], v1[3]);
                    *(u32x4*)(rowp + bj * HALF) = w; } }
    }
};
template <class Epi, class Sched, bool ALIGN_EPI = false, bool SP2 = false>
__device__ __forceinline__ void gemm_phase(PG8_LAS unsigned char* lds, const Gemm g, const Sched& S, const Epi& E, const int tid_in) {
    int tid_ = tid_in; asm volatile("" : "+v"(tid_));
    const int tid = tid_, wid = __builtin_amdgcn_readfirstlane(tid >> 6), lane = tid & 63, wr = wid >> 2, wc = wid & 3, fr = lane & 15, fq = lane >> 4;
    const int K = g.K, nt = K / BK;
    unsigned voffA[2], voffB[2];
#pragma unroll
    for (int i = 0; i < 2; ++i) { int R, C; stage_rc(tid * 16 + i * 8192, R, C); const int Rb = Epi::PERM ? ((R & ~31) + perm32(R & 31)) : R;
        voffA[i] = (unsigned)(R * K + C) * 2u; voffB[i] = (unsigned)(Rb * K + C) * 2u; }
    const size_t kstep = (size_t)(BK * 2);
    const size_t hstep = (size_t)HALF * K * 2;
    const size_t tstep = 2 * hstep;
    const unsigned ldsw = (unsigned)wid * 1024u;
    const int aoff = lds_byte(wr * 64 + fr, fq * 8), boff = lds_byte(wc * 32 + fr, fq * 8);
#define PG8_SA(b, h) (((b) * 2 + (h)) * HTB)
#define PG8_SB(b, h) ((4 + (b) * 2 + (h)) * HTB)
#define PG8_STAGE(bufoff, gbase, voff) do { _Pragma("unroll") for (int _i = 0; _i < 2; ++_i) \
        __builtin_amdgcn_global_load_lds((const unsigned*)((const char*)(gbase) + (voff)[_i]), (PG8_LAS unsigned*)(lds + (bufoff) + ldsw + _i * 8192), 16, 0, 0); } while (0)
#define PG8_LDA(dst, b, h) do { _Pragma("unroll") for (int m = 0; m < 4; ++m) _Pragma("unroll") for (int k = 0; k < 2; ++k) dst[m][k] = *(const PG8_LAS bf16x8*)(lds + PG8_SA(b, h) + aoff + m * 2048 + k * 1024); } while (0)
#define PG8_LDB(dst, b, h) do { _Pragma("unroll") for (int n = 0; n < 2; ++n) _Pragma("unroll") for (int k = 0; k < 2; ++k) dst[n][k] = *(const PG8_LAS bf16x8*)(lds + PG8_SB(b, h) + boff + n * 2048 + k * 1024); } while (0)
#define PG8_MMA(ai, bj, At, Bt) do { __builtin_amdgcn_s_setprio(1); _Pragma("unroll") for (int m = 0; m < 4; ++m) _Pragma("unroll") for (int n = 0; n < 2; ++n) _Pragma("unroll") for (int k = 0; k < 2; ++k) \
        acc[ai][bj][m][n] = __builtin_amdgcn_mfma_f32_16x16x32_bf16(Bt[n][k], At[m][k], acc[ai][bj][m][n], 0, 0, 0); __builtin_amdgcn_s_setprio(0); } while (0)
#define PG8_WAIT_V(n) asm volatile("s_waitcnt vmcnt(" #n ")" ::: "memory")
#define PG8_WAIT_L(n) asm volatile("s_waitcnt lgkmcnt(" #n ")" ::: "memory")
#define PG8_BAR __builtin_amdgcn_s_barrier()
#define PG8_SCHED __builtin_amdgcn_sched_barrier(0)
    Unit cur, nxt; int ui = 0;
    if (!S.next(0, cur)) return;
    f32x4 acc[2][2][4][2];
#pragma unroll
    for (int a = 0; a < 2; ++a)
#pragma unroll
        for (int b = 0; b < 2; ++b)
#pragma unroll
            for (int m = 0; m < 4; ++m)
#pragma unroll
                for (int n = 0; n < 2; ++n) acc[a][b][m][n] = (f32x4){0.f, 0.f, 0.f, 0.f};
    bf16x8 At[4][2], B0[2][2], B1[2][2];
    const char* cA = (const char*)g.A + (size_t)cur.pm * tstep; const char* cB = (const char*)g.Bt + (size_t)cur.pn * tstep;
    S.a_ready(cur);
    if constexpr (SP2) {
        PG8_STAGE(PG8_SB(0, 0), cB, voffB); PG8_STAGE(PG8_SB(0, 1), cB + hstep, voffB); PG8_STAGE(PG8_SA(0, 0), cA, voffA); PG8_STAGE(PG8_SA(0, 1), cA + hstep, voffA);
        if (wr == 1) PG8_BAR;
        PG8_WAIT_V(2); PG8_BAR;
        PG8_STAGE(PG8_SB(1, 0), cB + kstep, voffB); PG8_STAGE(PG8_SA(1, 0), cA + kstep, voffA); PG8_STAGE(PG8_SB(1, 1), cB + hstep + kstep, voffB);
        PG8_WAIT_V(6); PG8_BAR;
    } else {
        PG8_STAGE(PG8_SB(0, 0), cB, voffB); PG8_STAGE(PG8_SA(0, 0), cA, voffA); PG8_STAGE(PG8_SB(0, 1), cB + hstep, voffB); PG8_STAGE(PG8_SA(0, 1), cA + hstep, voffA);
        if (wr == 1) PG8_BAR;
        PG8_WAIT_V(4); PG8_BAR;
        PG8_STAGE(PG8_SB(1, 0), cB + kstep, voffB); PG8_STAGE(PG8_SA(1, 0), cA + kstep, voffA); PG8_STAGE(PG8_SB(1, 1), cB + hstep + kstep, voffB);
        PG8_WAIT_V(6); PG8_BAR;
    }
    for (;;) {
        const bool has_next = S.next(ui + 1, nxt);
        const char* nA = has_next ? (const char*)g.A + (size_t)nxt.pm * tstep : cA; const char* nB = has_next ? (const char*)g.Bt + (size_t)nxt.pn * tstep : cB;
        for (int t = 0; t < nt; t += 2) {
            const bool last = (t == nt - 2);
            const char* a1 = cA + (size_t)(t + 1) * kstep;
            const char* a2 = last ? nA : cA + (size_t)(t + 2) * kstep; const char* b2 = last ? nB : cB + (size_t)(t + 2) * kstep;
            const char* a3 = a2 + kstep; const char* b3 = b2 + kstep;
            if (last && has_next) S.a_ready(nxt);
            if constexpr (SP2) {
            PG8_LDB(B0, 0, 0); PG8_LDB(B1, 0, 1); PG8_SCHED; PG8_LDA(At, 0, 0); PG8_STAGE(PG8_SA(1, 1), a1 + hstep, voffA);
            PG8_WAIT_V(8); PG8_WAIT_L(0); PG8_BAR; PG8_MMA(0, 0, At, B0); PG8_MMA(0, 1, At, B1); PG8_BAR; PG8_SCHED;
            PG8_LDA(At, 0, 1); PG8_STAGE(PG8_SB(0, 0), b2, voffB); PG8_STAGE(PG8_SB(0, 1), b2 + hstep, voffB); PG8_STAGE(PG8_SA(0, 0), a2, voffA);
            PG8_WAIT_V(8); PG8_WAIT_L(0); PG8_BAR; PG8_MMA(1, 0, At, B0); PG8_MMA(1, 1, At, B1); PG8_BAR; PG8_SCHED;
            PG8_LDB(B0, 1, 0); PG8_LDB(B1, 1, 1); PG8_SCHED; PG8_LDA(At, 1, 0); PG8_STAGE(PG8_SA(0, 1), a2 + hstep, voffA);
            PG8_WAIT_V(8); PG8_WAIT_L(0); PG8_BAR; PG8_MMA(0, 0, At, B0); PG8_MMA(0, 1, At, B1); PG8_BAR; PG8_SCHED;
            PG8_LDA(At, 1, 1); PG8_STAGE(PG8_SB(1, 0), b3, voffB); PG8_STAGE(PG8_SB(1, 1), b3 + hstep, voffB); PG8_STAGE(PG8_SA(1, 0), a3, voffA);
            PG8_WAIT_V(8); PG8_WAIT_L(0); PG8_BAR; PG8_MMA(1, 0, At, B0); PG8_MMA(1, 1, At, B1); PG8_BAR; PG8_SCHED;
            } else {
            PG8_LDB(B0, 0, 0); PG8_SCHED; PG8_LDA(At, 0, 0); PG8_STAGE(PG8_SA(1, 1), a1 + hstep, voffA);
            PG8_WAIT_L(8); PG8_BAR; PG8_WAIT_L(0); PG8_MMA(0, 0, At, B0); PG8_BAR; PG8_SCHED;
            PG8_LDB(B1, 0, 1); PG8_STAGE(PG8_SB(0, 0), b2, voffB);
            PG8_BAR; PG8_WAIT_L(0); PG8_MMA(0, 1, At, B1); PG8_BAR;
            PG8_LDA(At, 0, 1); PG8_STAGE(PG8_SA(0, 0), a2, voffA);
            PG8_BAR; PG8_WAIT_L(0); PG8_MMA(1, 0, At, B0); PG8_BAR; PG8_SCHED;
            PG8_STAGE(PG8_SB(0, 1), b2 + hstep, voffB);
            PG8_WAIT_V(6); PG8_BAR; PG8_MMA(1, 1, At, B1); PG8_BAR;
            PG8_LDB(B0, 1, 0); PG8_SCHED; PG8_LDA(At, 1, 0); PG8_STAGE(PG8_SA(0, 1), a2 + hstep, voffA);
            PG8_WAIT_L(8); PG8_BAR; PG8_WAIT_L(0); PG8_MMA(0, 0, At, B0); PG8_BAR; PG8_SCHED;
            PG8_LDB(B1, 1, 1); PG8_STAGE(PG8_SB(1, 0), b3, voffB);
            PG8_BAR; PG8_WAIT_L(0); PG8_MMA(0, 1, At, B1); PG8_BAR;
            PG8_LDA(At, 1, 1); PG8_STAGE(PG8_SA(1, 0), a3, voffA);
            PG8_BAR; PG8_WAIT_L(0); PG8_MMA(1, 0, At, B0); PG8_BAR; PG8_SCHED;
            PG8_STAGE(PG8_SB(1, 1), b3 + hstep, voffB);
            PG8_WAIT_V(6); PG8_BAR; PG8_MMA(1, 1, At, B1); PG8_BAR;
            }
        }
        if constexpr (ALIGN_EPI) { if (wr == 0) PG8_BAR; }
        if constexpr (!Epi::AFTER_DRAIN) { E(acc, cur, wr, wc, fr, fq); S.done(cur); }
        if (!has_next) break;
#pragma unroll
        for (int a = 0; a < 2; ++a)
#pragma unroll
            for (int b = 0; b < 2; ++b)
#pragma unroll
                for (int m = 0; m < 4; ++m)
#pragma unroll
                    for (int n = 0; n < 2; ++n) acc[a][b][m][n] = (f32x4){0.f, 0.f, 0.f, 0.f};
        cur = nxt; cA = nA; cB = nB; ++ui;
        if constexpr (ALIGN_EPI) { if (wr == 1) PG8_BAR; }
    }
    PG8_WAIT_V(0);
    if constexpr (!ALIGN_EPI) { if (wr == 0) PG8_BAR; }
    PG8_BAR;
    if constexpr (Epi::AFTER_DRAIN) { E.fused(acc, cur, wr, wc, fr, fq, lds, wid, lane); S.done(cur); }
#undef PG8_SA
#undef PG8_SB
#undef PG8_STAGE
#undef PG8_LDA
#undef PG8_LDB
#undef PG8_MMA
#undef PG8_WAIT_V
#undef PG8_WAIT_L
#undef PG8_BAR
#undef PG8_SCHED
}
}
#define GAS __attribute__((address_space(1)))
#define LAS __attribute__((address_space(3)))
typedef unsigned short bf16_t;
typedef unsigned v4u __attribute__((ext_vector_type(4)));
typedef float f32x4 __attribute__((ext_vector_type(4)));
typedef short bf16x8 __attribute__((ext_vector_type(8)));
#define LDS_WAIT() asm volatile("s_waitcnt lgkmcnt(0)" ::: "memory")
#define VM_WAIT() asm volatile("s_waitcnt vmcnt(0)" ::: "memory")
__device__ __forceinline__ float bf2f(bf16_t v) { return __uint_as_float((uint32_t)v << 16); }
__device__ __forceinline__ unsigned f2bf(float f) { unsigned u = __builtin_bit_cast(unsigned, f); return (u + 0x7fffu + ((u >> 16) & 1u)) >> 16; }
__device__ __forceinline__ unsigned pk2(float lo, float hi) { return f2bf(lo) | (f2bf(hi) << 16); }
#define DPP_F(s, ctrl) __builtin_bit_cast(float, __builtin_amdgcn_update_dpp(0, __builtin_bit_cast(int, s), ctrl, 0xF, 0xF, false))
__device__ __forceinline__ float sum32(float v) {
    v += DPP_F(v, 0xB1); v += DPP_F(v, 0x4E); v += DPP_F(v, 0x141); v += DPP_F(v, 0x140);
    v += __builtin_bit_cast(float, __builtin_amdgcn_ds_swizzle(__builtin_bit_cast(int, v), 0x401F));
    return v;
}
__device__ __forceinline__ float max32(float v) {
    v = fmaxf(v, DPP_F(v, 0xB1)); v = fmaxf(v, DPP_F(v, 0x4E)); v = fmaxf(v, DPP_F(v, 0x141)); v = fmaxf(v, DPP_F(v, 0x140));
    v = fmaxf(v, __builtin_bit_cast(float, __builtin_amdgcn_ds_swizzle(__builtin_bit_cast(int, v), 0x401F)));
    return v;
}
__device__ __forceinline__ float wave_sum(float v) {
    v = sum32(v);
    return __builtin_bit_cast(float, __builtin_amdgcn_readlane(__builtin_bit_cast(int, v), 0)) + __builtin_bit_cast(float, __builtin_amdgcn_readlane(__builtin_bit_cast(int, v), 32));
}
__device__ __forceinline__ float wave_max(float v) {
    v = max32(v);
    return fmaxf(__builtin_bit_cast(float, __builtin_amdgcn_readlane(__builtin_bit_cast(int, v), 0)), __builtin_bit_cast(float, __builtin_amdgcn_readlane(__builtin_bit_cast(int, v), 32)));
}
__device__ __forceinline__ float bperm_f(int srclane, float v) { return __builtin_bit_cast(float, __builtin_amdgcn_ds_bpermute(srclane << 2, __builtin_bit_cast(int, v))); }
__device__ __forceinline__ int bperm_i(int srclane, int v) { return __builtin_amdgcn_ds_bpermute(srclane << 2, v); }
#define XB_TMO      128
#define XB_XCNT(j)  (256  + 64 * (j))
#define XB_XSUB(j)  (1280 + 64 * (j))
#define XB_XGEN(j)  (2304 + 64 * (j))
#define XB_TOP      3328
#define XB_TOPGEN   3392
#define XCD_BAR_WORDS 3456
#define XB_SPIN_CAP (1u << 24)

__device__ __forceinline__ unsigned xb_ld(unsigned* p)              { return __hip_atomic_load(p, __ATOMIC_RELAXED, __HIP_MEMORY_SCOPE_AGENT); }
__device__ __forceinline__ unsigned xb_add(unsigned* p, unsigned v) { return __hip_atomic_fetch_add(p, v, __ATOMIC_RELAXED, __HIP_MEMORY_SCOPE_AGENT); }
__device__ __forceinline__ unsigned xb_xcc_id() { return (unsigned)__builtin_amdgcn_s_getreg((3 << 11) | 20) & 0xFu; }
#define XB_SPIN(cond, bar) do { unsigned _sp = 0; while (cond) { __builtin_amdgcn_s_sleep(1); \
    if ((++_sp & 255u) == 0u) { if (xb_ld(&(bar)[XB_TMO])) break; if (_sp > XB_SPIN_CAP) { atomicAdd(&(bar)[XB_TMO], 1u); break; } } } } while (0)

struct XcdBarrier {
    unsigned* bar; unsigned x;
    volatile LAS unsigned* st;
};

__device__ __forceinline__ XcdBarrier xcd_barrier_post(unsigned* bar, volatile LAS unsigned* st, const int tid) {
    XcdBarrier b; b.bar = bar; b.x = xb_xcc_id(); b.st = st;
    if (tid == 0) (void)xb_add(&bar[XB_XCNT(b.x)], 1u);
    return b;
}
__device__ __forceinline__ void xcd_barrier_complete(unsigned* bar, unsigned x, unsigned& nloc, unsigned& nx) {
    const unsigned G = gridDim.x * gridDim.y * gridDim.z;
    unsigned sum, cnt, mine, sp = 0u;
    for (;;) {
        sum = 0u; cnt = 0u; mine = 0u;
#pragma unroll
        for (unsigned j = 0; j < 16; ++j) { const unsigned c = xb_ld(&bar[XB_XCNT(j)]); sum += c; cnt += (c > 0u) ? 1u : 0u; mine = (j == x) ? c : mine; }
        if (sum == G) break;
        __builtin_amdgcn_s_sleep(1);
        if ((++sp & 255u) == 0u) { if (xb_ld(&bar[XB_TMO])) break; if (sp > XB_SPIN_CAP) { atomicAdd(&bar[XB_TMO], 1u); break; } }
    }
    nloc = mine > 0u ? mine : 1u; nx = cnt > 0u ? cnt : 1u;
}

__device__ __forceinline__ void xcd_barrier(const XcdBarrier& b, const int tid) {
    asm volatile("s_waitcnt vmcnt(0)" ::: "memory");
    __syncthreads();
    if (tid == 0) {
        unsigned* bar = b.bar;
        __builtin_amdgcn_s_waitcnt(0);
        unsigned nloc = b.st[0], nx = b.st[1];
        if (nloc == 0u) { xcd_barrier_complete(bar, b.x, nloc, nx); b.st[0] = nloc; b.st[1] = nx; }
        const unsigned old = xb_add(&bar[XB_XSUB(b.x)], 1u);
        const unsigned gen = old / nloc;
        if (old + 1u == (gen + 1u) * nloc) {
            __builtin_amdgcn_fence(__ATOMIC_RELEASE, "agent");
            asm volatile("s_waitcnt vmcnt(0)" ::: "memory");
            const unsigned og = xb_add(&bar[XB_TOP], 1u);
            const unsigned tg = og / nx;
            if (og + 1u == (tg + 1u) * nx) xb_add(&bar[XB_TOPGEN], 1u);
            else XB_SPIN(xb_ld(&bar[XB_TOPGEN]) == tg, bar);
            __builtin_amdgcn_fence(__ATOMIC_ACQUIRE, "agent");
            xb_add(&bar[XB_XGEN(b.x)], 1u);
            asm volatile("s_waitcnt vmcnt(0)" ::: "memory");
        } else {
            XB_SPIN(xb_ld(&bar[XB_XGEN(b.x)]) == gen, bar);
            __builtin_amdgcn_fence(__ATOMIC_ACQUIRE, "agent");
            asm volatile("s_waitcnt vmcnt(0)" ::: "memory");
        }
    }
    __syncthreads();
}
constexpr int D = 1024, NB = 8, S = 2048, T = NB * S, DEPTH = 2, INW = 5128, NEXP = 16384;
constexpr int NPROJ = 5120;
constexpr float EPS = 1e-6f;
constexpr float LOG2E = 1.4426950408889634f;
constexpr float C2 = 0.125f * LOG2E;
constexpr int NWAVES = 8, NTHREADS = 512;
constexpr int LDS_BYTES = 147456;

constexpr size_t MiB = 1u << 20;
constexpr size_t WS_CTL = 0, CTL_ZERO_BYTES = 32 * 1024;
constexpr size_t WS_WIN = 1 * MiB;
constexpr size_t WS_WDO = 21 * MiB;
constexpr size_t WS_WFO = 23 * MiB;
constexpr size_t WS_WOUT = 25 * MiB;
constexpr size_t WS_WQ = 29 * MiB;
constexpr size_t WS_BT = 38 * MiB;
constexpr size_t WS_LOGF = 39 * MiB;
constexpr size_t WS_CUM = 39 * MiB + 512 * 1024;
constexpr size_t WS_EXP = 41 * MiB;
constexpr size_t WS_HN = 169 * MiB;
constexpr size_t WS_A = 201 * MiB;
constexpr size_t WS_MGT = WS_A, WS_MG = WS_A + 64 * MiB, WS_QP = WS_A;
constexpr size_t WS_SG = 297 * MiB;
constexpr size_t WS_SSP = 106 * MiB;
constexpr size_t WS_YD = 361 * MiB, WS_YF = 377 * MiB;
constexpr size_t WS_XR = 393 * MiB;
constexpr size_t WS_EXPI = 457 * MiB, WS_GATE = 465 * MiB;
constexpr size_t WS_END = 473 * MiB;
constexpr int CW_BAR = 4096;

struct Args {
    const float* in[16]; float* out; unsigned char* ws; int ph_lo, ph_hi;
};
struct Frame {
    LAS unsigned char* lds;
    int tid, lane, wave, gw, ngw, G, bid;
};
typedef __attribute__((address_space(4))) const unsigned char* kargp_t;
__device__ __forceinline__ kargp_t kargp() { kargp_t p = (kargp_t)__builtin_amdgcn_kernarg_segment_ptr(); asm volatile("" : "+s"(p)); return p; }
#define ARG_IN(i) (*(const float* const __attribute__((address_space(4)))*)(kargp() + 8 * (i)))
#define ARG_OUT   (*(float* const __attribute__((address_space(4)))*)(kargp() + 128))
#define ARG_WS    (*(unsigned char* const __attribute__((address_space(4)))*)(kargp() + 136))
#define ARG_PHLO  (*(const int __attribute__((address_space(4)))*)(kargp() + 144))
#define ARG_PHHI  (*(const int __attribute__((address_space(4)))*)(kargp() + 148))
static_assert(sizeof(Args) == 152, "kernarg layout: in[16] | out | ws | ph_lo | ph_hi");
template <class P> __device__ __forceinline__ P* opq(P* p) { asm volatile("" : "+s"(p)); return p; }

namespace pg8 {
struct EpiProj {
    static constexpr bool PERM = true, AFTER_DRAIN = false;
    bf16_t* qkv; bf16_t* sg;
    __device__ __forceinline__ void operator()(const f32x4 (&acc)[2][2][4][2], const Unit& u, int wr, int wc, int fr, int fq) const {
        const int row0 = u.pm * BM + wr * 64 + fr; const int ct = u.pn * BM;
        bf16_t* base; int ld, colt; bool sig; float sc = 1.f;
        if (ct < 3072) { const int t = ct >> 9; base = qkv + (size_t)t * T * 512; ld = 512; colt = ct & 511; sig = false; if (t == 0 || t == 3) sc = C2; }
        else { const int c2 = ct - 3072, t = c2 >> 10; base = sg + (size_t)t * T * 1024; ld = 1024; colt = c2 & 1023; sig = true; }
        const int col0 = colt + wc * 32 + 8 * fq;
#pragma unroll
        for (int ai = 0; ai < 2; ++ai)
#pragma unroll
            for (int m = 0; m < 4; ++m) { bf16_t* rowp = base + (size_t)(row0 + ai * HALF + m * 16) * ld + col0;
#pragma unroll
                for (int bj = 0; bj < 2; ++bj) { f32x4 v0 = acc[ai][bj][m][0], v1 = acc[ai][bj][m][1];
                    if (sig) {
#pragma unroll
                        for (int e = 0; e < 4; ++e) { v0[e] = __builtin_amdgcn_rcpf(1.0f + __builtin_amdgcn_exp2f(-LOG2E * v0[e])); v1[e] = __builtin_amdgcn_rcpf(1.0f + __builtin_amdgcn_exp2f(-LOG2E * v1[e])); }
                    } else { v0 = v0 * sc; v1 = v1 * sc; }
                    u32x4 w; w.x = cvt_pk_bf16(v0[0], v0[1]); w.y = cvt_pk_bf16(v0[2], v0[3]); w.z = cvt_pk_bf16(v1[0], v1[1]); w.w = cvt_pk_bf16(v1[2], v1[3]);
                    *(GAS u32x4*)(rowp + bj * HALF) = w; } }
    }
};
__device__ __forceinline__ void unpack8(const u32x4 w, float (&f)[8]) {
    f[0] = __uint_as_float(w.x << 16); f[1] = __uint_as_float(w.x & 0xffff0000u); f[2] = __uint_as_float(w.y << 16); f[3] = __uint_as_float(w.y & 0xffff0000u);
    f[4] = __uint_as_float(w.z << 16); f[5] = __uint_as_float(w.z & 0xffff0000u); f[6] = __uint_as_float(w.w << 16); f[7] = __uint_as_float(w.w & 0xffff0000u);
}
struct EpiMerge1 {
    static constexpr bool PERM = true, AFTER_DRAIN = false;
    const bf16_t* sga; bf16_t* tmp;
    __device__ __forceinline__ void operator()(const f32x4 (&acc)[2][2][4][2], const Unit& u, int wr, int wc, int fr, int fq) const {
        const int row0 = u.pm * BM + wr * 64 + fr, col0 = u.pn * BM + wc * 32 + 8 * fq;
#pragma unroll
        for (int ai = 0; ai < 2; ++ai)
#pragma unroll
            for (int m = 0; m < 4; ++m) { const size_t off = (size_t)(row0 + ai * HALF + m * 16) * 1024 + col0;
#pragma unroll
                for (int bj = 0; bj < 2; ++bj) { float g[8]; unpack8(*(const GAS u32x4*)(sga + off + bj * HALF), g);
                    const f32x4 v0 = acc[ai][bj][m][0], v1 = acc[ai][bj][m][1];
                    u32x4 w; w.x = cvt_pk_bf16(v0[0] * g[0], v0[1] * g[1]); w.y = cvt_pk_bf16(v0[2] * g[2], v0[3] * g[3]); w.z = cvt_pk_bf16(v1[0] * g[4], v1[1] * g[5]); w.w = cvt_pk_bf16(v1[2] * g[6], v1[3] * g[7]);
                    *(GAS u32x4*)(tmp + off + bj * HALF) = w; } }
    }
};
struct EpiMerge2 {
    static constexpr bool PERM = true, AFTER_DRAIN = false;
    const bf16_t* sgb; const bf16_t* tmp; bf16_t* mg;
    __device__ __forceinline__ void operator()(const f32x4 (&acc)[2][2][4][2], const Unit& u, int wr, int wc, int fr, int fq) const {
        const int row0 = u.pm * BM + wr * 64 + fr, col0 = u.pn * BM + wc * 32 + 8 * fq;
#pragma unroll
        for (int ai = 0; ai < 2; ++ai)
#pragma unroll
            for (int m = 0; m < 4; ++m) { const size_t off = (size_t)(row0 + ai * HALF + m * 16) * 1024 + col0;
#pragma unroll
                for (int bj = 0; bj < 2; ++bj) { float g[8], t[8]; unpack8(*(const GAS u32x4*)(sgb + off + bj * HALF), g); unpack8(*(const GAS u32x4*)(tmp + off + bj * HALF), t);
                    const f32x4 a0 = acc[ai][bj][m][0], a1 = acc[ai][bj][m][1];
                    u32x4 w; w.x = cvt_pk_bf16(t[0] + g[0] * a0[0], t[1] + g[1] * a0[1]); w.y = cvt_pk_bf16(t[2] + g[2] * a0[2], t[3] + g[3] * a0[3]);
                    w.z = cvt_pk_bf16(t[4] + g[4] * a1[0], t[5] + g[5] * a1[1]); w.w = cvt_pk_bf16(t[6] + g[6] * a1[2], t[7] + g[7] * a1[3]);
                    *(GAS u32x4*)(mg + off + bj * HALF) = w; } }
    }
};
struct EpiResidSS {
    static constexpr bool PERM = true, AFTER_DRAIN = false;
    const float* xin; float* xout; bf16_t* xb; float* ssp;
    __device__ __forceinline__ void operator()(const f32x4 (&acc)[2][2][4][2], const Unit& u, int wr, int wc, int fr, int fq) const {
        const int row0 = u.pm * BM + wr * 64 + fr, col0 = u.pn * BM + wc * 32 + 8 * fq;
#pragma unroll
        for (int ai = 0; ai < 2; ++ai)
#pragma unroll
            for (int m = 0; m < 4; ++m) { const int row = row0 + ai * HALF + m * 16; const size_t off = (size_t)row * 1024 + col0; float s = 0.f;
#pragma unroll
                for (int bj = 0; bj < 2; ++bj) {
                    const f32x4 v0 = *(const GAS f32x4*)(xin + off + bj * HALF) + acc[ai][bj][m][0], v1 = *(const GAS f32x4*)(xin + off + bj * HALF + 4) + acc[ai][bj][m][1];
                    *(GAS f32x4*)(xout + off + bj * HALF) = v0; *(GAS f32x4*)(xout + off + bj * HALF + 4) = v1;
                    u32x4 w; w.x = cvt_pk_bf16(v0[0], v0[1]); w.y = cvt_pk_bf16(v0[2], v0[3]); w.z = cvt_pk_bf16(v1[0], v1[1]); w.w = cvt_pk_bf16(v1[2], v1[3]);
                    *(GAS u32x4*)(xb + off + bj * HALF) = w;
                    s += ((v0[0] * v0[0] + v0[1] * v0[1]) + (v0[2] * v0[2] + v0[3] * v0[3])) + ((v1[0] * v1[0] + v1[1] * v1[1]) + (v1[2] * v1[2] + v1[3] * v1[3])); }
                s += __builtin_bit_cast(float, __builtin_amdgcn_ds_swizzle(__builtin_bit_cast(int, s), 0x401F));
                { auto rr = __builtin_amdgcn_permlane32_swap(__builtin_bit_cast(unsigned, s), __builtin_bit_cast(unsigned, s), false, false); s = __builtin_bit_cast(float, rr[0]) + __builtin_bit_cast(float, rr[1]); }
                if (fq == 0) ((GAS float*)ssp)[(size_t)row * 16 + u.pn * 4 + wc] = s; }
    }
};
struct EpiQP {
    static constexpr bool PERM = true, AFTER_DRAIN = false;
    bf16_t* qp; const PG8_LAS float* rsl; int pm0;
    __device__ __forceinline__ void operator()(const f32x4 (&acc)[2][2][4][2], const Unit& u, int wr, int wc, int fr, int fq) const {
        const int rl0 = wr * 64 + fr, col0 = u.pn * BM + wc * 32 + 8 * fq;
        const PG8_LAS float* rs_ = rsl + (u.pm == pm0 ? 0 : 256);
#pragma unroll
        for (int ai = 0; ai < 2; ++ai)
#pragma unroll
            for (int m = 0; m < 4; ++m) { const int rl = rl0 + ai * HALF + m * 16;
                const float rs = rs_[rl];
                bf16_t* rowp = qp + (size_t)(u.pm * BM + rl) * 2048 + col0;
#pragma unroll
                for (int bj = 0; bj < 2; ++bj) { const f32x4 v0 = acc[ai][bj][m][0] * rs, v1 = acc[ai][bj][m][1] * rs;
                    u32x4 w; w.x = cvt_pk_bf16(v0[0], v0[1]); w.y = cvt_pk_bf16(v0[2], v0[3]); w.z = cvt_pk_bf16(v1[0], v1[1]); w.w = cvt_pk_bf16(v1[2], v1[3]);
                    *(GAS u32x4*)(rowp + bj * HALF) = w; } }
    }
};
}

__device__ __forceinline__ void p0_transpose_item(const float* W, int ldw, int K, int Nd, int skip_from, int skip, bf16_t* WT, LAS float* scr, int item, int lane, const float* kscale = nullptr) {
    const int nblk = Nd / 32, kb = item / nblk, nb = item % nblk, k0 = 64 * kb, n0 = 32 * nb;
    const int s0 = n0 + (n0 >= skip_from ? skip : 0);
    float wv_[32];
    const GAS float* Wg = (const GAS float*)W + (size_t)(k0 + (lane >> 5)) * ldw + s0 + (lane & 31);
#pragma unroll
    for (int i = 0; i < 32; ++i) wv_[i] = Wg[(size_t)(2 * i) * ldw];
    if (kscale) {
        const GAS float* ks = (const GAS float*)kscale + k0 + (lane >> 5);
#pragma unroll
        for (int i = 0; i < 32; ++i) wv_[i] *= ks[2 * i];
    }
#pragma unroll
    for (int i = 0; i < 32; ++i) scr[(2 * i + (lane >> 5)) * 33 + (lane & 31)] = wv_[i];
    LDS_WAIT(); asm volatile("" ::: "memory");
    const int c = lane & 7;
#pragma unroll
    for (int j = 0; j < 4; ++j) { const int n = (lane >> 3) + 8 * j; const LAS float* s = scr + (8 * c) * 33 + n;
        v4u o; o.x = pk2(s[0 * 33], s[1 * 33]); o.y = pk2(s[2 * 33], s[3 * 33]); o.z = pk2(s[4 * 33], s[5 * 33]); o.w = pk2(s[6 * 33], s[7 * 33]);
        *(GAS v4u*)(WT + (size_t)(n0 + n) * K + k0 + 8 * c) = o; }
    LDS_WAIT(); asm volatile("" ::: "memory");
}
__device__ __forceinline__ void ph_prologue(Frame& F) {
    unsigned char* ws = ARG_WS;
    LAS float* scr = (LAS float*)(F.lds + F.wave * 16384);
    constexpr int I_IN = (D / 64) * (NPROJ / 32), I_DO = (512 / 64) * (D / 32), I_OUT = (D / 64) * (D / 32), I_Q = (D / 64) * (2048 / 32);
    constexpr int PER_L = I_IN + 2 * I_DO + I_OUT + I_Q;
    for (int it = F.gw; it < DEPTH * PER_L; it += F.ngw) {
        const int l = it / PER_L; int r = it % PER_L;
        if (r < I_IN) { p0_transpose_item(ARG_IN(2) + (size_t)l * D * INW, INW, D, NPROJ, 3072, 8, (bf16_t*)(ws + WS_WIN + (size_t)l * 10 * MiB), scr, r, F.lane); continue; } r -= I_IN;
        if (r < I_DO) { p0_transpose_item(ARG_IN(6) + (size_t)l * 512 * D, D, 512, D, 1 << 30, 0, (bf16_t*)(ws + WS_WDO + (size_t)l * MiB), scr, r, F.lane); continue; } r -= I_DO;
        if (r < I_DO) { p0_transpose_item(ARG_IN(7) + (size_t)l * 512 * D, D, 512, D, 1 << 30, 0, (bf16_t*)(ws + WS_WFO + (size_t)l * MiB), scr, r, F.lane); continue; } r -= I_DO;
        if (r < I_OUT) { p0_transpose_item(ARG_IN(8) + (size_t)l * D * D, D, D, D, 1 << 30, 0, (bf16_t*)(ws + WS_WOUT + (size_t)l * 2 * MiB), scr, r, F.lane); continue; } r -= I_OUT;
        p0_transpose_item(ARG_IN(10) + (size_t)l * D * 2048, 2048, D, 2048, 1 << 30, 0, (bf16_t*)(ws + WS_WQ + (size_t)l * 4 * MiB), scr, r, F.lane, ARG_IN(9) + l * D);
    }
    if (F.bid == 0) {
        float* tab = (float*)(ws + WS_BT); const float* rel_bias = ARG_IN(14);
        for (int i = F.tid; i < 4 * 129; i += NTHREADS) {
            const int h = i / 129, d = i % 129; int bucket;
            if (d < 16) bucket = d;
            else { const int large = 16 + (int)(logf((float)d / 16.0f) / 2.0794415416798357f * 16.0f); bucket = large < 31 ? large : 31; }
            tab[i] = rel_bias[bucket * 4 + h] * LOG2E;
        }
    }
}

__device__ __forceinline__ void ph_rmsnorm(Frame& F, const float* xp_, const float* gp_, bf16_t* outp_, const float* wffp_, const float* bfgp_, float* logfp_) {
    const int lane = F.lane;
    const GAS float* x = (const GAS float*)xp_; const GAS f32x4* gr = (const GAS f32x4*)gp_; GAS bf16_t* out = (GAS bf16_t*)outp_;
    const GAS float* wff = (const GAS float*)wffp_; const GAS float* bfg = (const GAS float*)bfgp_; GAS float* logf = (GAS float*)logfp_;
    LAS float* wl = (LAS float*)F.lds;
    for (int k = F.tid; k < D; k += NTHREADS) {
        const f32x4 w0 = *(const GAS f32x4*)(wff + (size_t)k * INW + 3072), w1 = *(const GAS f32x4*)(wff + (size_t)k * INW + 3076);
        wl[0 * D + k] = w0[0]; wl[1 * D + k] = w0[1]; wl[2 * D + k] = w0[2]; wl[3 * D + k] = w0[3]; wl[4 * D + k] = w1[0]; wl[5 * D + k] = w1[1]; wl[6 * D + k] = w1[2]; wl[7 * D + k] = w1[3];
    }
    __syncthreads();
    f32x4 nx[4];
    if (F.gw < T) {
#pragma unroll
        for (int j = 0; j < 4; ++j) nx[j] = ((const GAS f32x4*)(x + (size_t)F.gw * D))[j * 64 + lane];
    }
    for (int row = F.gw; row < T; row += F.ngw) {
        f32x4 v[4]; float ss = 0.f;
#pragma unroll
        for (int j = 0; j < 4; ++j) { v[j] = nx[j]; ss += (v[j][0] * v[j][0] + v[j][1] * v[j][1]) + (v[j][2] * v[j][2] + v[j][3] * v[j][3]); }
        if (row + F.ngw < T) {
#pragma unroll
            for (int j = 0; j < 4; ++j) nx[j] = ((const GAS f32x4*)(x + (size_t)(row + F.ngw) * D))[j * 64 + lane];
        }
        ss = wave_sum(ss);
        const float rs = rsqrtf(ss * (1.0f / D) + EPS);
#pragma unroll
        for (int j = 0; j < 4; ++j) v[j] = v[j] * gr[j * 64 + lane] * rs;
#pragma unroll
        for (int j = 0; j < 4; ++j) { typedef unsigned u32x2_ __attribute__((ext_vector_type(2))); u32x2_ o; o[0] = pk2(v[j][0], v[j][1]); o[1] = pk2(v[j][2], v[j][3]); *(GAS u32x2_*)(out + (size_t)row * D + (j * 64 + lane) * 4) = o; }
        float a[8];
#pragma unroll
        for (int hh = 0; hh < 8; ++hh) { float s = 0.f;
#pragma unroll
            for (int j = 0; j < 4; ++j) { const f32x4 w = *(const LAS f32x4*)(wl + hh * D + (j * 64 + lane) * 4); s += (v[j][0] * w[0] + v[j][1] * w[1]) + (v[j][2] * w[2] + v[j][3] * w[3]); }
            a[hh] = wave_sum(s); }
        if (lane < 8) {
            float f = lane == 0 ? a[0] : lane == 1 ? a[1] : lane == 2 ? a[2] : lane == 3 ? a[3] : lane == 4 ? a[4] : lane == 5 ? a[5] : lane == 6 ? a[6] : a[7];
            f += bfg[lane];
            logf[(size_t)row * 8 + lane] = fminf(f, 0.f) - log1pf(expf(-fabsf(f)));
        }
    }
    __syncthreads();
}
__device__ __forceinline__ void ph_cumsum(Frame& F, const float* logfp_, float* cump_) {
    const int lane = F.lane;
    const GAS float* logf = (const GAS float*)logfp_; GAS float* cum = (GAS float*)cump_;
    for (int task = F.gw; task < 64; task += F.ngw) {
        const int b = task >> 3, hh = task & 7;
        float v[32];
#pragma unroll
        for (int i = 0; i < 32; ++i) v[i] = logf[((size_t)(b * S + lane * 32 + i)) * 8 + hh];
#pragma unroll
        for (int i = 1; i < 32; ++i) v[i] += v[i - 1];
        float tot = v[31];
#pragma unroll
        for (int o = 1; o < 64; o <<= 1) { const float n = bperm_f(lane - o, tot); if (lane >= o) tot += n; }
        const float base = tot - v[31];
        GAS float* cp = cum + (size_t)task * S + lane * 32;
#pragma unroll
        for (int i = 0; i < 32; i += 4) { f32x4 o4 = {(v[i] + base) * LOG2E, (v[i + 1] + base) * LOG2E, (v[i + 2] + base) * LOG2E, (v[i + 3] + base) * LOG2E}; *(GAS f32x4*)(cp + i) = o4; }
    }
}
namespace att {
typedef float f32x16 __attribute__((ext_vector_type(16)));
typedef short s16x4 __attribute__((ext_vector_type(4)));
typedef short v4i16_t __attribute__((ext_vector_type(4)));
typedef unsigned u32x4 __attribute__((ext_vector_type(4)));
typedef float f32x2_t __attribute__((ext_vector_type(2))); typedef __bf16 bf16x2_t __attribute__((ext_vector_type(2)));
__device__ __forceinline__ int crow(int r, int hi) { return (r & 3) + 8 * (r >> 2) + 4 * hi; }
__device__ __forceinline__ unsigned cvtpk(float lo, float hi) { f32x2_t v = {lo, hi}; bf16x2_t b = __builtin_convertvector(v, bf16x2_t); return __builtin_bit_cast(unsigned, b); }
__device__ __forceinline__ void glds16(const void* gsrc, unsigned lds_dst) { unsigned keep;
    asm volatile("s_mov_b32 %0, m0\n\ts_mov_b32 m0, %2\n\ts_nop 0\n\tglobal_load_lds_dwordx4 %1, off\n\ts_mov_b32 m0, %0" : "=&s"(keep) : "v"(gsrc), "s"(lds_dst) : "memory"); }
__device__ __forceinline__ void glds16s(const void* gbase  , unsigned voff, unsigned lds_dst) { unsigned keep;
    asm volatile("s_mov_b32 %0, m0\n\ts_mov_b32 m0, %3\n\ts_nop 0\n\tglobal_load_lds_dwordx4 %1, %2\n\ts_mov_b32 m0, %0" : "=&s"(keep) : "v"(voff), "s"(gbase), "s"(lds_dst) : "memory"); }
#define ATT_WAIT_BAR() asm volatile("s_waitcnt vmcnt(0) lgkmcnt(0)\n\ts_barrier" ::: "memory")
#define ATT_MFMA(a, b, c) __builtin_amdgcn_mfma_f32_32x32x16_bf16(a, b, c, 0, 0, 0)
__device__ __forceinline__ s16x4 vtr(const LAS unsigned char* p) { return __builtin_bit_cast(s16x4, __builtin_amdgcn_ds_read_tr16_b64_v4i16((LAS v4i16_t*)p)); }
#define FX_SBAR() __builtin_amdgcn_sched_barrier(0)
#define FX_PIN(x) asm volatile("" : "+v"(x))
#define FX_WAIT_BAR(N) asm volatile("s_waitcnt vmcnt(" #N ") lgkmcnt(0)\n\ts_barrier" ::: "memory")
#define FX_MX3(a, b, c) __builtin_fmaxf(__builtin_fmaxf((a), (b)), (c))
__device__ __forceinline__ unsigned fx_cvtpk(float lo, float hi) { unsigned r; asm("v_cvt_pk_bf16_f32 %0, %1, %2" : "=v"(r) : "v"(lo), "v"(hi)); return r; }
__device__ __forceinline__ float fx_rowmax(const f32x16& p0, const f32x16& p1) {
    float a = FX_MX3(p0[0], p0[1], p1[0]), b = FX_MX3(p0[2], p0[3], p1[1]); a = FX_MX3(a, p1[2], p1[3]);
#pragma unroll
    for (int r = 4; r < 16; r += 4) { a = FX_MX3(a, p0[r], p0[r + 1]); b = FX_MX3(b, p0[r + 2], p0[r + 3]); a = FX_MX3(a, p1[r], p1[r + 1]); b = FX_MX3(b, p1[r + 2], p1[r + 3]); }
    float m = __builtin_fmaxf(a, b); auto rr = __builtin_amdgcn_permlane32_swap(__float_as_uint(m), __float_as_uint(m), false, false);
    return __builtin_fmaxf(__uint_as_float(rr[0]), __uint_as_float(rr[1])); }
__device__ __forceinline__ void fx_cmask(f32x16& p0, f32x16& p1, int jb, int qrel, int hi) {
    const int kb = 64 * jb + 4 * hi;
#pragma unroll
    for (int r = 0; r < 16; ++r) { const int kv = kb + (r & 3) + 8 * (r >> 2); if (kv > qrel) p0[r] = -INFINITY; if (kv + 32 > qrel) p1[r] = -INFINITY; } }

__device__ __forceinline__ void fox_unit(LAS unsigned char* lds, int tid, int b, int h, int qb, const bf16_t* Q, const bf16_t* K, const bf16_t* V, bf16_t* Y, const float* cum) {
    constexpr int QB = 256, SLOTB = 8192, LDS_K = 0, LDS_V = 3 * SLOTB, LDS_WS = 6 * SLOTB, LDS_TAB = LDS_WS + 2048, LDS_OST = LDS_TAB + 8192;
    constexpr float FTHR = 40.0f;
    int tid_ = tid; asm volatile("" : "+v"(tid_));
    const int lane = tid_ & 63, r32 = lane & 31, hi = lane >> 5, wid = __builtin_amdgcn_readfirstlane(tid_ >> 6);
    const int q0 = qb * QB, NT = (q0 + QB) / 64;
    const size_t rowbase = (size_t)b * S;
    const int hcol = h * 64;
    const bf16_t* Qw = Q + (rowbase + q0 + wid * 32) * 512 + hcol;
    const bf16_t* Kh = K + rowbase * 512 + hcol;
    const bf16_t* Vh = V + rowbase * 512 + hcol;
    const unsigned lds0 = (unsigned)(uintptr_t)lds;
    LAS float* wsf = (LAS float*)(lds + LDS_WS) + wid * 64;
    LAS float* tab = (LAS float*)(lds + LDS_TAB);
    const int qrel = wid * 32 + r32, qpos = q0 + qrel;
    const GAS float* cumg = (const GAS float*)cum;
    const bf16_t* ksrc = Kh + (size_t)(8 * wid + (lane & 7)) * 512 + (lane >> 3) * 8;
    const int vrow = lane >> 3, vslot = lane & 7;
    const int vchunk = (((vslot >> 2) ^ ((vrow >> 1) & 1)) << 2) | (vslot & 3);
    const bf16_t* vsrc = Vh + (size_t)(8 * wid + vrow) * 512 + vchunk * 8;
    const unsigned kdst = lds0 + LDS_K + wid * 1024, vdst = lds0 + LDS_V + wid * 1024;
#define FX_DMA_K(t, slot) glds16(ksrc + (size_t)(t) * 64 * 512, (unsigned)__builtin_amdgcn_readfirstlane(kdst + (slot)))
#define FX_DMA_V(t, slot) glds16(vsrc + (size_t)(t) * 64 * 512, (unsigned)__builtin_amdgcn_readfirstlane(vdst + (slot)))
    const int vq = (lane & 15) >> 2;
    const LAS unsigned char* vp0 = lds + LDS_V + ((lane >> 4) & 1) * 32 + (lane & 3) * 8 + (4 * hi + vq) * 128;
    const int vsw0 = ((vq >> 1) & 1) * 64, vsw1 = vsw0 ^ 64;
    const LAS unsigned char* kp0 = lds + LDS_K + (r32 >> 3) * 1024 + (r32 & 7) * 16 + hi * 128;
    const LAS float* cp0 = tab + 4 * hi;
    FX_DMA_K(0, 0); FX_DMA_V(0, 0); FX_DMA_K(1, SLOTB); FX_DMA_K(2, 2 * SLOTB);
    if (tid_ * 4 < q0 + QB) { const f32x4 c4 = ((const GAS f32x4*)cumg)[tid_]; ((LAS f32x4*)tab)[tid_] = (f32x4){-c4[0], -c4[1], -c4[2], -c4[3]}; }
    bf16x8 qr[4];
#pragma unroll
    for (int d0 = 0; d0 < 4; ++d0) qr[d0] = *(const GAS bf16x8*)(Qw + (size_t)r32 * 512 + d0 * 16 + hi * 8);
    float cq = cumg[qpos];
    asm volatile("" : "+v"(qr[0]), "+v"(qr[1]), "+v"(qr[2]), "+v"(qr[3]), "+v"(cq));
    float mhat = 0.f, l_reg = 0.f; f32x16 o[2]; o[0] = f32x16{}; o[1] = f32x16{};
    bool resc = false;
    f32x16 pA0, pA1, pB0, pB1; bf16x8 kf[8]; s16x4 vlo[8], vhi[8]; u32x4 pw0, pw1, pw2, pw3;
    int sl_prev = 0, sl_cur = 0, sl_next = SLOTB;
#define FX_ROT() do { sl_prev = sl_cur; sl_cur = sl_next; sl_next = (sl_next == 2 * SLOTB) ? 0 : sl_next + SLOTB; } while (0)
#define FX_EX(v) __builtin_amdgcn_exp2f((v) + nmh)
#define FX_RESC() do { if (resc) { _Pragma("unroll") for (int g_ = 0; g_ < 4; ++g_) { const f32x4 a4 = *(const LAS f32x4*)(wsf + 8 * g_ + 4 * hi); \
        _Pragma("unroll") for (int d_ = 0; d_ < 2; ++d_) { o[d_][4 * g_] *= a4[0]; o[d_][4 * g_ + 1] *= a4[1]; o[d_][4 * g_ + 2] *= a4[2]; o[d_][4 * g_ + 3] *= a4[3]; } } } } while (0)
#define FX_KLOAD2(kp, d0) do { kf[2 * (d0)] = *(const LAS bf16x8*)((kp) + (d0) * 256); kf[2 * (d0) + 1] = *(const LAS bf16x8*)((kp) + (d0) * 256 + 4096); } while (0)
#define FX_CLOAD(X0, X1, cp, g) do { const f32x4 c0_ = *(const LAS f32x4*)((cp) + 8 * (g)), c1_ = *(const LAS f32x4*)((cp) + 32 + 8 * (g)); \
        X0[4 * (g)] = c0_[0]; X0[4 * (g) + 1] = c0_[1]; X0[4 * (g) + 2] = c0_[2]; X0[4 * (g) + 3] = c0_[3]; X1[4 * (g)] = c1_[0]; X1[4 * (g) + 1] = c1_[1]; X1[4 * (g) + 2] = c1_[2]; X1[4 * (g) + 3] = c1_[3]; } while (0)
    FX_WAIT_BAR(3);
#pragma unroll
    for (int d0 = 0; d0 < 4; ++d0) FX_KLOAD2(kp0, d0);
#pragma unroll
    for (int g = 0; g < 4; ++g) FX_CLOAD(pA0, pA1, cp0, g);
    pA0 = ATT_MFMA(kf[0], qr[0], pA0); pA1 = ATT_MFMA(kf[1], qr[0], pA1); pA0 = ATT_MFMA(kf[2], qr[1], pA0); pA1 = ATT_MFMA(kf[3], qr[1], pA1);
    pA0 = ATT_MFMA(kf[4], qr[2], pA0); pA1 = ATT_MFMA(kf[5], qr[2], pA1); pA0 = ATT_MFMA(kf[6], qr[3], pA0); pA1 = ATT_MFMA(kf[7], qr[3], pA1);
    if (NT == 4) fx_cmask(pA0, pA1, 0, qrel, hi);
    { const float rm = fx_rowmax(pA0, pA1); mhat = rm + cq; const float nmh = cq - mhat;
#pragma unroll
      for (int r = 0; r < 16; ++r) { pA0[r] = FX_EX(pA0[r]); pA1[r] = FX_EX(pA1[r]); } }
    FX_WAIT_BAR(0);
    FX_DMA_K(3, 0); FX_DMA_V(1, SLOTB); FX_ROT();
#pragma unroll
    for (int d0 = 0; d0 < 4; ++d0) FX_KLOAD2(kp0 + sl_cur, d0);
#pragma unroll
    for (int g = 0; g < 4; ++g) FX_CLOAD(pB0, pB1, cp0 + 64, g);
    FX_WAIT_BAR(2);
#define FX_PKW(P, i) fx_cvtpk(P[i], P[i + 1])
#define FX_PAF(k) __builtin_bit_cast(bf16x8, pw##k)
#define FX_VFR(i) (bf16x8){vlo[i][0], vlo[i][1], vlo[i][2], vlo[i][3], vhi[i][0], vhi[i][1], vhi[i][2], vhi[i][3]}
#define FX_VRD(i) do { vlo[i] = vtr(vp_ + ((((i) >> 2) ? vsw1 : vsw0) + ((i) & 3) * 2048)); vhi[i] = vtr(vp_ + ((((i) >> 2) ? vsw1 : vsw0) + ((i) & 3) * 2048 + 1024)); } while (0)
#define FX_KRD(G, d0) do { if (G) { FX_KLOAD2(kp0 + sl_next, d0); FX_SBAR(); } } while (0)
#define FX_CRD(G, X0, X1, t, g) do { if (G) { FX_CLOAD(X0, X1, cp0 + 64 * ((t) + 1), g); FX_SBAR(); } } while (0)
#define FX_GAPA(MF, a0, a1, a2, a3, W0, W1, PW) do { MF; sacc += a0; sacc += a1; sacc += a2; sacc += a3; W0; W1; FX_PIN(PW); FX_PIN(sacc); FX_SBAR(); } while (0)
#define FX_GAPB(MF, X, i) do { MF; X[i] = FX_EX(X[i]); X[i + 1] = FX_EX(X[i + 1]); X[i + 2] = FX_EX(X[i + 2]); X[i + 3] = FX_EX(X[i + 3]); FX_PIN(X); FX_SBAR(); } while (0)
#define FX_STEP(C0, C1, P0, P1, t, MASK, GK, GV, GL) do { FX_SBAR(); \
    const LAS unsigned char* vp_ = vp0 + sl_prev; \
    FX_VRD(0); FX_SBAR(); float sacc = P0[0] + P0[1]; \
                       FX_GAPA(C0 = ATT_MFMA(kf[0], qr[0], C0), P0[2], P0[3], P0[4], P0[5],     pw0[0] = FX_PKW(P0, 0),  pw0[1] = FX_PKW(P0, 2),  pw0); \
    FX_VRD(4); FX_SBAR(); FX_GAPA(C1 = ATT_MFMA(kf[1], qr[0], C1), P0[6], P0[7], P0[8], P0[9],     pw0[2] = FX_PKW(P0, 4),  pw0[3] = FX_PKW(P0, 6),  pw0); \
    FX_VRD(1); FX_SBAR(); FX_GAPA(C0 = ATT_MFMA(kf[2], qr[1], C0),    P0[10], P0[11], P0[12], P0[13], pw1[0] = FX_PKW(P0, 8),  pw1[1] = FX_PKW(P0, 10), pw1); \
    FX_VRD(5); FX_SBAR(); FX_GAPA(C1 = ATT_MFMA(kf[3], qr[1], C1),    P0[14], P0[15], P1[0], P1[1],   pw1[2] = FX_PKW(P0, 12), pw1[3] = FX_PKW(P0, 14), pw1); \
    FX_VRD(2); FX_SBAR(); FX_GAPA(C0 = ATT_MFMA(kf[4], qr[2], C0),    P1[2], P1[3], P1[4], P1[5],     pw2[0] = FX_PKW(P1, 0),  pw2[1] = FX_PKW(P1, 2),  pw2); \
    FX_VRD(6); FX_SBAR(); FX_GAPA(C1 = ATT_MFMA(kf[5], qr[2], C1),    P1[6], P1[7], P1[8], P1[9],     pw2[2] = FX_PKW(P1, 4),  pw2[3] = FX_PKW(P1, 6),  pw2); \
    FX_VRD(3); FX_SBAR(); FX_GAPA(C0 = ATT_MFMA(kf[6], qr[3], C0),    P1[10], P1[11], P1[12], P1[13], pw3[0] = FX_PKW(P1, 8),  pw3[1] = FX_PKW(P1, 10), pw3); \
    FX_VRD(7); FX_SBAR(); FX_GAPA(C1 = ATT_MFMA(kf[7], qr[3], C1),    P1[14], P1[15], 0.f, 0.f,       pw3[2] = FX_PKW(P1, 12), pw3[3] = FX_PKW(P1, 14), pw3); \
    l_reg += sacc; \
    if (GK) FX_DMA_K((t) + 3, sl_cur); if (GV) FX_DMA_V((t) + 1, sl_next);                                \
    if (MASK) fx_cmask(C0, C1, (t) - (NT - 4), qrel, hi); \
    { const float rm = fx_rowmax(C0, C1) + (cq - mhat); resc = false;                                      \
      if (__builtin_expect(__any(rm > FTHR), 0)) { const float dl = __builtin_fmaxf(rm, 0.f); mhat += dl;     \
          const float f = __builtin_amdgcn_exp2f(-dl); l_reg *= f; if (hi == 0) wsf[r32] = f; resc = true; } } \
    const float nmh = cq - mhat; FX_SBAR(); \
    FX_CRD(GL, P0, P1, t, 0); FX_GAPB(o[0] = ATT_MFMA(FX_PAF(0), FX_VFR(0), o[0]), C0, 0);  FX_CRD(GL, P0, P1, t, 1); FX_GAPB(o[1] = ATT_MFMA(FX_PAF(0), FX_VFR(4), o[1]), C0, 4); \
    FX_KRD(GL, 0); FX_GAPB(o[0] = ATT_MFMA(FX_PAF(1), FX_VFR(1), o[0]), C0, 8);  FX_KRD(GL, 1); FX_GAPB(o[1] = ATT_MFMA(FX_PAF(1), FX_VFR(5), o[1]), C0, 12); \
    FX_KRD(GL, 2); FX_GAPB(o[0] = ATT_MFMA(FX_PAF(2), FX_VFR(2), o[0]), C1, 0);  FX_KRD(GL, 3); FX_GAPB(o[1] = ATT_MFMA(FX_PAF(2), FX_VFR(6), o[1]), C1, 4); \
    FX_CRD(GL, P0, P1, t, 2); FX_GAPB(o[0] = ATT_MFMA(FX_PAF(3), FX_VFR(3), o[0]), C1, 8);  FX_CRD(GL, P0, P1, t, 3); FX_GAPB(o[1] = ATT_MFMA(FX_PAF(3), FX_VFR(7), o[1]), C1, 12); \
    } while (0)
    int t = 1;
    for (; t + 5 < NT; t += 2) {
        FX_STEP(pB0, pB1, pA0, pA1, t, false, true, true, true);     FX_WAIT_BAR(2); FX_RESC(); FX_ROT();
        FX_STEP(pA0, pA1, pB0, pB1, t + 1, false, true, true, true); FX_WAIT_BAR(2); FX_RESC(); FX_ROT();
    }
#define FX_ENDW(tt) do { if ((tt) + 3 < NT) { FX_WAIT_BAR(2); } else if ((tt) + 2 < NT) { FX_WAIT_BAR(1); } else { FX_WAIT_BAR(0); } } while (0)
    for (; t + 1 < NT; t += 2) {
        FX_STEP(pB0, pB1, pA0, pA1, t, true, (t + 3 < NT), (t + 1 < NT), (t + 1 < NT));         FX_ENDW(t);     FX_RESC(); FX_ROT();
        FX_STEP(pA0, pA1, pB0, pB1, t + 1, true, (t + 4 < NT), (t + 2 < NT), (t + 2 < NT));     FX_ENDW(t + 1); FX_RESC(); FX_ROT();
    }
    FX_STEP(pB0, pB1, pA0, pA1, NT - 1, true, false, false, false); FX_RESC();
    { float sacc = pB0[0] + pB0[1];
#pragma unroll
      for (int r = 2; r < 16; ++r) sacc += pB0[r];
#pragma unroll
      for (int r = 0; r < 16; ++r) sacc += pB1[r];
      l_reg += sacc;
      pw0 = (u32x4){FX_PKW(pB0, 0), FX_PKW(pB0, 2), FX_PKW(pB0, 4), FX_PKW(pB0, 6)}; pw1 = (u32x4){FX_PKW(pB0, 8), FX_PKW(pB0, 10), FX_PKW(pB0, 12), FX_PKW(pB0, 14)};
      pw2 = (u32x4){FX_PKW(pB1, 0), FX_PKW(pB1, 2), FX_PKW(pB1, 4), FX_PKW(pB1, 6)}; pw3 = (u32x4){FX_PKW(pB1, 8), FX_PKW(pB1, 10), FX_PKW(pB1, 12), FX_PKW(pB1, 14)};
      const LAS unsigned char* vp_ = vp0 + sl_cur;
#pragma unroll
      for (int i = 0; i < 8; ++i) FX_VRD(i);
      o[0] = ATT_MFMA(FX_PAF(0), FX_VFR(0), o[0]); o[1] = ATT_MFMA(FX_PAF(0), FX_VFR(4), o[1]); o[0] = ATT_MFMA(FX_PAF(1), FX_VFR(1), o[0]); o[1] = ATT_MFMA(FX_PAF(1), FX_VFR(5), o[1]);
      o[0] = ATT_MFMA(FX_PAF(2), FX_VFR(2), o[0]); o[1] = ATT_MFMA(FX_PAF(2), FX_VFR(6), o[1]); o[0] = ATT_MFMA(FX_PAF(3), FX_VFR(3), o[0]); o[1] = ATT_MFMA(FX_PAF(3), FX_VFR(7), o[1]); }
    { auto rr = __builtin_amdgcn_permlane32_swap(__float_as_uint(l_reg), __float_as_uint(l_reg), false, false); l_reg = __uint_as_float(rr[0]) + __uint_as_float(rr[1]); }
    if (hi == 0) wsf[32 + r32] = 1.0f / l_reg;
    asm volatile("s_waitcnt lgkmcnt(0)" ::: "memory");
    float rli[16];
#pragma unroll
    for (int g = 0; g < 4; ++g) { const f32x4 a4 = *(const LAS f32x4*)(wsf + 32 + 8 * g + 4 * hi); rli[4 * g] = a4[0]; rli[4 * g + 1] = a4[1]; rli[4 * g + 2] = a4[2]; rli[4 * g + 3] = a4[3]; }
    LAS bf16_t* stg = (LAS bf16_t*)(lds + LDS_OST) + wid * 2048;
#pragma unroll
    for (int db = 0; db < 2; ++db)
#pragma unroll
        for (int r = 0; r < 16; ++r) stg[crow(r, hi) * 64 + db * 32 + r32] = (bf16_t)f2bf(o[db][r] * rli[r]);
    asm volatile("s_waitcnt lgkmcnt(0)" ::: "memory");
    bf16_t* Yw = Y + (rowbase + q0 + wid * 32) * 512 + hcol;
#pragma unroll
    for (int i = 0; i < 4; ++i) { const int row = i * 8 + (lane >> 3), ch = lane & 7; const u32x4 v = *(const LAS u32x4*)(stg + row * 64 + ch * 8); *(GAS u32x4*)(Yw + (size_t)row * 512 + ch * 8) = v; }
    ATT_WAIT_BAR();
#undef FX_DMA_K
#undef FX_DMA_V
#undef FX_ROT
#undef FX_EX
#undef FX_RESC
#undef FX_KLOAD2
#undef FX_CLOAD
#undef FX_PKW
#undef FX_PAF
#undef FX_VFR
#undef FX_VRD
#undef FX_KRD
#undef FX_CRD
#undef FX_ENDW
#undef FX_GAPA
#undef FX_GAPB
#undef FX_STEP
}
__device__ __forceinline__ float fx_max3(float a, float b, float c) { float r; asm("v_max3_f32 %0, %1, %2, %3" : "=v"(r) : "v"(a), "v"(b), "v"(c)); return r; }
__device__ __forceinline__ void diff_unit(LAS unsigned char* lds, int tid, int b, int h, int qb, const bf16_t* Q, const bf16_t* K, const bf16_t* V, bf16_t* Y,
                                          const float* aux  , float lam, float lnscale, const float* subg) {
    constexpr int QB = 128, SLOTB = 16384, LDS_K = 0, LDS_V = 3 * SLOTB, LDS_WS = 6 * SLOTB, LDS_TAB = LDS_WS + 2048, LDS_OST = LDS_TAB + 2048;
    constexpr float DTHR = 48.0f;
    int tid_ = tid; asm volatile("" : "+v"(tid_));
    const int lane = tid_ & 63, r32 = lane & 31, hi = lane >> 5, wid = __builtin_amdgcn_readfirstlane(tid_ >> 6);
    const int qg = wid & 3, m = wid >> 2;
    const int q0 = qb * QB, NT = (q0 + QB) / 64;
    const size_t rowbase = (size_t)b * S;
    const int hcol = h * 128;
    const bf16_t* Qw = Q + (rowbase + q0 + qg * 32) * 512 + hcol + m * 64;
    const bf16_t* Kh = K + rowbase * 512 + hcol;
    const bf16_t* Vh = V + rowbase * 512 + hcol;
    const unsigned lds0 = (unsigned)(uintptr_t)lds;
    LAS float* wsf = (LAS float*)(lds + LDS_WS) + wid * 64;
    LAS float* tab = (LAS float*)(lds + LDS_TAB);
    const int qpos = q0 + qg * 32 + r32;
    const unsigned koff = (unsigned)(((8 * wid + (lane & 7)) * 512 + (lane >> 3) * 8) * 2);
    const int vrow = lane >> 4, vslot = lane & 15;
    const int vchunk = (((vslot >> 2) ^ vrow) << 2) | (vslot & 3);
    const unsigned voff = (unsigned)(((4 * wid + vrow) * 512 + vchunk * 8) * 2);
    const unsigned kdst = lds0 + LDS_K + wid * 1024, vdst = lds0 + LDS_V + wid * 1024;
#define DF_DMA_K(t, slot) do { const bf16_t* kb_ = Kh + (size_t)(t) * 64 * 512; glds16s(kb_, koff, (unsigned)__builtin_amdgcn_readfirstlane(kdst + (slot))); glds16s(kb_ + 64, koff, (unsigned)__builtin_amdgcn_readfirstlane(kdst + (slot) + 8192u)); } while (0)
#define DF_DMA_V(t, slot) do { const bf16_t* vb_ = Vh + (size_t)(t) * 64 * 512; glds16s(vb_, voff, (unsigned)__builtin_amdgcn_readfirstlane(vdst + (slot))); glds16s(vb_ + 32 * 512, voff, (unsigned)__builtin_amdgcn_readfirstlane(vdst + (slot) + 8192u)); } while (0)
    const int vq = (lane & 15) >> 2;
    const LAS unsigned char* vp0 = lds + LDS_V + ((lane >> 4) & 1) * 32 + (lane & 3) * 8 + hi * 1024 + vq * 256;
    const LAS unsigned char* kp0 = lds + LDS_K + m * 8192 + (r32 >> 3) * 1024 + (r32 & 7) * 16 + hi * 128;
    DF_DMA_K(0, 0); DF_DMA_V(0, 0); DF_DMA_K(1, SLOTB); DF_DMA_K(2, 2 * SLOTB);
    {
        const GAS float* auxg = (const GAS float*)aux; const int i_ = tid_ - 128;
        tab[tid_] = i_ < 0 ? -INFINITY : (i_ < 128 ? auxg[i_] - auxg[128] : 0.f);
    }
    bf16x8 qr[4];
#pragma unroll
    for (int d0 = 0; d0 < 4; ++d0) qr[d0] = *(const GAS bf16x8*)(Qw + (size_t)r32 * 512 + d0 * 16 + hi * 8);
    asm volatile("" : "+v"(qr[0]), "+v"(qr[1]), "+v"(qr[2]), "+v"(qr[3]));
    float mhat = 0.f, l_reg = 0.f, fP = 1.f; f32x16 o[4];
#pragma unroll
    for (int db = 0; db < 4; ++db) o[db] = f32x16{};
    bool rescP = false, rescN = false;
    f32x16 pA0, pA1, pB0, pB1; bf16x8 kf[8]; s16x4 vlo[2][4], vhi[2][4]; u32x4 pw0, pw1, pw2, pw3;
    int sl_prev = 0, sl_cur = 0, sl_next = SLOTB;
#define DF_ROT() do { sl_prev = sl_cur; sl_cur = sl_next; sl_next = (sl_next == 2 * SLOTB) ? 0 : sl_next + SLOTB; } while (0)
#define DF_EX(v) __builtin_amdgcn_exp2f(v)
#define DF_RESC(par) do { if (rescP) { _Pragma("unroll") for (int g_ = 0; g_ < 4; ++g_) { const f32x4 a4 = *(const LAS f32x4*)(wsf + 32 * (par) + 8 * g_ + 4 * hi); \
        _Pragma("unroll") for (int d_ = 0; d_ < 4; ++d_) { o[d_][4 * g_] *= a4[0]; o[d_][4 * g_ + 1] *= a4[1]; o[d_][4 * g_ + 2] *= a4[2]; o[d_][4 * g_ + 3] *= a4[3]; } } } rescP = rescN; } while (0)
#define DF_KLOAD2(kp, d0) do { kf[2 * (d0)] = *(const LAS bf16x8*)((kp) + (d0) * 256); kf[2 * (d0) + 1] = *(const LAS bf16x8*)((kp) + (d0) * 256 + 4096); } while (0)
#define DF_CINIT(C0, C1, t) do { const LAS float* tp_ = tab + (qpos - ((t) * 64 + 4 * hi) + 128 - 59); \
        _Pragma("unroll") for (int r = 0; r < 16; ++r) { C0[r] = tp_[59 - ((r & 3) + 8 * (r >> 2))]; C1[r] = tp_[59 - 32 - ((r & 3) + 8 * (r >> 2))]; } } while (0)
#define DF_DECIDE(C0, C1, par) do { const float rm_ = fx_rowmax(C0, C1); rescN = false; float fN_ = 1.f; \
        if (__builtin_expect(__any(rm_ > DTHR), 0)) { const float dl_ = __builtin_fmaxf(rm_, 0.f); mhat += dl_; fN_ = __builtin_amdgcn_exp2f(-dl_); if (hi == 0) wsf[32 * (par) + r32] = fN_; rescN = true; } \
        fNext = fN_; } while (0)
#define DF_DECIDE2(par) do { float rm_ = mx; { auto rr_ = __builtin_amdgcn_permlane32_swap(__float_as_uint(rm_), __float_as_uint(rm_), false, false); rm_ = __builtin_fmaxf(__uint_as_float(rr_[0]), __uint_as_float(rr_[1])); } \
        rescN = false; float fN_ = 1.f; \
        if (__builtin_expect(__any(rm_ > DTHR), 0)) { const float dl_ = __builtin_fmaxf(rm_, 0.f); mhat += dl_; fN_ = __builtin_amdgcn_exp2f(-dl_); if (hi == 0) wsf[32 * (par) + r32] = fN_; rescN = true; } \
        fNext = fN_; } while (0)
    float fNext = 1.f;
    asm volatile("s_waitcnt vmcnt(6) lgkmcnt(0)\n\ts_barrier" ::: "memory");
#pragma unroll
    for (int d0 = 0; d0 < 4; ++d0) DF_KLOAD2(kp0, d0);
    if (NT <= 4) { DF_CINIT(pA0, pA1, 0); pA0 = ATT_MFMA(kf[0], qr[0], pA0); pA1 = ATT_MFMA(kf[1], qr[0], pA1); }
    else { pA0 = ATT_MFMA(kf[0], qr[0], f32x16{}); pA1 = ATT_MFMA(kf[1], qr[0], f32x16{}); }
    pA0 = ATT_MFMA(kf[2], qr[1], pA0); pA1 = ATT_MFMA(kf[3], qr[1], pA1);
    pA0 = ATT_MFMA(kf[4], qr[2], pA0); pA1 = ATT_MFMA(kf[5], qr[2], pA1); pA0 = ATT_MFMA(kf[6], qr[3], pA0); pA1 = ATT_MFMA(kf[7], qr[3], pA1);
    DF_DECIDE(pA0, pA1, 0);
#pragma unroll
    for (int r = 0; r < 16; ++r) { pA0[r] = DF_EX(pA0[r]); pA1[r] = DF_EX(pA1[r]); }
    rescP = rescN; fP = fNext;
    asm volatile("s_waitcnt vmcnt(0) lgkmcnt(0)\n\ts_barrier" ::: "memory");
    DF_DMA_K(3, 0); DF_DMA_V(1, SLOTB); DF_ROT();
#pragma unroll
    for (int d0 = 0; d0 < 4; ++d0) DF_KLOAD2(kp0 + sl_cur, d0);
    asm volatile("s_waitcnt vmcnt(4) lgkmcnt(0)\n\ts_barrier" ::: "memory");
#define DF_PKW(P, i) fx_cvtpk(P[i], P[i + 1])
#define DF_PAF(k) __builtin_bit_cast(bf16x8, pw##k)
#define DF_VFR(bf, db) (bf16x8){vlo[bf][db][0], vlo[bf][db][1], vlo[bf][db][2], vlo[bf][db][3], vhi[bf][db][0], vhi[bf][db][1], vhi[bf][db][2], vhi[bf][db][3]}
#define DF_VRD(bf, ks, i) do { if (((i) & 1) == 0) vlo[bf][(i) >> 1] = vtr(vp_ + ((((i) >> 1) ^ vq) * 64 + (ks) * 4096)); else vhi[bf][(i) >> 1] = vtr(vp_ + ((((i) >> 1) ^ vq) * 64 + (ks) * 4096 + 2048)); } while (0)
#define DF_VRD2(bf, ks, i) do { DF_VRD(bf, ks, i); DF_VRD(bf, ks, (i) + 1); FX_SBAR(); } while (0)
#define DF_KRD(G, d0) do { if (G) { DF_KLOAD2(kp0 + sl_next, d0); FX_SBAR(); } } while (0)
#define DF_GAPA(MF, a0, a1, a2, a3, W0, W1, PW) do { MF; sacc += a0; sacc += a1; sacc += a2; sacc += a3; W0; W1; FX_PIN(PW); FX_PIN(sacc); FX_SBAR(); } while (0)
#define DF_GAPB(MF, X, i) do { MF; mx = fx_max3(mx, X[i], X[i + 1]); X[i] = DF_EX(X[i]); X[i + 1] = DF_EX(X[i + 1]); FX_PIN(X); FX_PIN(mx); FX_SBAR(); } while (0)
#define DF_STEP(C0, C1, P0, P1, t, par, MASK, GK, GV, GL) do { FX_SBAR(); \
    const LAS unsigned char* vp_ = vp0 + sl_prev; \
    if (MASK) { DF_CINIT(C0, C1, t); FX_SBAR(); } \
    DF_VRD(0, 0, 0); FX_SBAR(); float sacc = P0[0] + P0[1]; float mx = -INFINITY; \
                              DF_GAPA(C0 = ATT_MFMA(kf[0], qr[0], (MASK) ? C0 : f32x16{}), P0[2], P0[3], P0[4], P0[5],     pw0[0] = DF_PKW(P0, 0),  pw0[1] = DF_PKW(P0, 2),  pw0); \
    DF_VRD(0, 0, 1); FX_SBAR(); DF_GAPA(C1 = ATT_MFMA(kf[1], qr[0], (MASK) ? C1 : f32x16{}), P0[6], P0[7], P0[8], P0[9],     pw0[2] = DF_PKW(P0, 4),  pw0[3] = DF_PKW(P0, 6),  pw0); \
    if (GK) { DF_DMA_K((t) + 3, sl_cur); FX_SBAR(); }                                                                  \
    DF_VRD(0, 0, 2); FX_SBAR(); DF_GAPA(C0 = ATT_MFMA(kf[2], qr[1], C0),    P0[10], P0[11], P0[12], P0[13], pw1[0] = DF_PKW(P0, 8),  pw1[1] = DF_PKW(P0, 10), pw1); \
    DF_VRD(0, 0, 3); FX_SBAR(); DF_GAPA(C1 = ATT_MFMA(kf[3], qr[1], C1),    P0[14], P0[15], P1[0], P1[1],   pw1[2] = DF_PKW(P0, 12), pw1[3] = DF_PKW(P0, 14), pw1); \
    if (GV) { DF_DMA_V((t) + 1, sl_next); FX_SBAR(); } \
    DF_VRD(0, 0, 4); FX_SBAR(); DF_GAPA(C0 = ATT_MFMA(kf[4], qr[2], C0),    P1[2], P1[3], P1[4], P1[5],     pw2[0] = DF_PKW(P1, 0),  pw2[1] = DF_PKW(P1, 2),  pw2); \
    DF_VRD(0, 0, 5); FX_SBAR(); DF_GAPA(C1 = ATT_MFMA(kf[5], qr[2], C1),    P1[6], P1[7], P1[8], P1[9],     pw2[2] = DF_PKW(P1, 4),  pw2[3] = DF_PKW(P1, 6),  pw2); \
    DF_VRD(0, 0, 6); FX_SBAR(); DF_GAPA(C0 = ATT_MFMA(kf[6], qr[3], C0),    P1[10], P1[11], P1[12], P1[13], pw3[0] = DF_PKW(P1, 8),  pw3[1] = DF_PKW(P1, 10), pw3); \
    DF_VRD(0, 0, 7); FX_SBAR(); DF_GAPA(C1 = ATT_MFMA(kf[7], qr[3], C1),    P1[14], P1[15], 0.f, 0.f,       pw3[2] = DF_PKW(P1, 12), pw3[3] = DF_PKW(P1, 14), pw3); \
    l_reg = (l_reg + sacc) * fP;                                                                           \
    if (__builtin_expect(!__all(mhat == 0.f), 0)) { _Pragma("unroll") for (int r = 0; r < 16; ++r) { C0[r] -= mhat; C1[r] -= mhat; } }       \
    FX_SBAR(); \
    DF_VRD2(1, 1, 0); DF_GAPB(o[0] = ATT_MFMA(DF_PAF(0), DF_VFR(0, 0), o[0]), C0, 0);   DF_VRD2(1, 1, 2); DF_GAPB(o[1] = ATT_MFMA(DF_PAF(0), DF_VFR(0, 1), o[1]), C0, 2); \
    DF_VRD2(1, 1, 4); DF_GAPB(o[2] = ATT_MFMA(DF_PAF(0), DF_VFR(0, 2), o[2]), C0, 4);   DF_VRD2(1, 1, 6); DF_GAPB(o[3] = ATT_MFMA(DF_PAF(0), DF_VFR(0, 3), o[3]), C0, 6); \
    DF_VRD2(0, 2, 0); DF_GAPB(o[0] = ATT_MFMA(DF_PAF(1), DF_VFR(1, 0), o[0]), C0, 8);   DF_VRD2(0, 2, 2); DF_GAPB(o[1] = ATT_MFMA(DF_PAF(1), DF_VFR(1, 1), o[1]), C0, 10); \
    DF_VRD2(0, 2, 4); DF_GAPB(o[2] = ATT_MFMA(DF_PAF(1), DF_VFR(1, 2), o[2]), C0, 12);  DF_VRD2(0, 2, 6); DF_GAPB(o[3] = ATT_MFMA(DF_PAF(1), DF_VFR(1, 3), o[3]), C0, 14); \
    DF_VRD2(1, 3, 0); DF_GAPB(o[0] = ATT_MFMA(DF_PAF(2), DF_VFR(0, 0), o[0]), C1, 0);   DF_VRD2(1, 3, 2); DF_GAPB(o[1] = ATT_MFMA(DF_PAF(2), DF_VFR(0, 1), o[1]), C1, 2); \
    DF_VRD2(1, 3, 4); DF_GAPB(o[2] = ATT_MFMA(DF_PAF(2), DF_VFR(0, 2), o[2]), C1, 4);   DF_VRD2(1, 3, 6); DF_GAPB(o[3] = ATT_MFMA(DF_PAF(2), DF_VFR(0, 3), o[3]), C1, 6); \
    DF_KRD(GL, 0); DF_GAPB(o[0] = ATT_MFMA(DF_PAF(3), DF_VFR(1, 0), o[0]), C1, 8);      DF_KRD(GL, 1); DF_GAPB(o[1] = ATT_MFMA(DF_PAF(3), DF_VFR(1, 1), o[1]), C1, 10); \
    DF_KRD(GL, 2); DF_GAPB(o[2] = ATT_MFMA(DF_PAF(3), DF_VFR(1, 2), o[2]), C1, 12);     DF_KRD(GL, 3); DF_GAPB(o[3] = ATT_MFMA(DF_PAF(3), DF_VFR(1, 3), o[3]), C1, 14); \
    DF_DECIDE2(par); \
    } while (0)
#define DF_WAIT_BAR(N) asm volatile("s_waitcnt vmcnt(" #N ") lgkmcnt(0)\n\ts_barrier" ::: "memory")
#define DF_AFTER(par_prev) do { DF_RESC(par_prev); fP = fNext; } while (0)
    int t = 1;
    for (; t + 5 < NT; t += 2) {
        DF_STEP(pB0, pB1, pA0, pA1, t, 1, false, true, true, true);     DF_WAIT_BAR(4); DF_AFTER(0); DF_ROT();
        DF_STEP(pA0, pA1, pB0, pB1, t + 1, 0, false, true, true, true); DF_WAIT_BAR(4); DF_AFTER(1); DF_ROT();
    }
#define DF_ENDW(tt) do { if ((tt) + 3 < NT) { DF_WAIT_BAR(4); } else if ((tt) + 2 < NT) { DF_WAIT_BAR(2); } else { DF_WAIT_BAR(0); } } while (0)
    for (; t + 1 < NT; t += 2) {
        DF_STEP(pB0, pB1, pA0, pA1, t, 1, true, (t + 3 < NT), (t + 1 < NT), (t + 1 < NT));         DF_ENDW(t);     DF_AFTER(0); DF_ROT();
        DF_STEP(pA0, pA1, pB0, pB1, t + 1, 0, true, (t + 4 < NT), (t + 2 < NT), (t + 2 < NT));     DF_ENDW(t + 1); DF_AFTER(1); DF_ROT();
    }
    if (NT == 2) DF_WAIT_BAR(0);
    DF_STEP(pB0, pB1, pA0, pA1, NT - 1, 1, true, false, false, false); DF_AFTER(0);
    { float sacc = pB0[0] + pB0[1];
#pragma unroll
      for (int r = 2; r < 16; ++r) sacc += pB0[r];
#pragma unroll
      for (int r = 0; r < 16; ++r) sacc += pB1[r];
      l_reg += sacc;
      pw0 = (u32x4){DF_PKW(pB0, 0), DF_PKW(pB0, 2), DF_PKW(pB0, 4), DF_PKW(pB0, 6)}; pw1 = (u32x4){DF_PKW(pB0, 8), DF_PKW(pB0, 10), DF_PKW(pB0, 12), DF_PKW(pB0, 14)};
      pw2 = (u32x4){DF_PKW(pB1, 0), DF_PKW(pB1, 2), DF_PKW(pB1, 4), DF_PKW(pB1, 6)}; pw3 = (u32x4){DF_PKW(pB1, 8), DF_PKW(pB1, 10), DF_PKW(pB1, 12), DF_PKW(pB1, 14)};
      const LAS unsigned char* vp_ = vp0 + sl_cur;
#pragma unroll
      for (int i = 0; i < 8; ++i) { DF_VRD(0, 0, i); DF_VRD(1, 1, i); }
      o[0] = ATT_MFMA(DF_PAF(0), DF_VFR(0, 0), o[0]); o[1] = ATT_MFMA(DF_PAF(0), DF_VFR(0, 1), o[1]); o[2] = ATT_MFMA(DF_PAF(0), DF_VFR(0, 2), o[2]); o[3] = ATT_MFMA(DF_PAF(0), DF_VFR(0, 3), o[3]);
      o[0] = ATT_MFMA(DF_PAF(1), DF_VFR(1, 0), o[0]); o[1] = ATT_MFMA(DF_PAF(1), DF_VFR(1, 1), o[1]); o[2] = ATT_MFMA(DF_PAF(1), DF_VFR(1, 2), o[2]); o[3] = ATT_MFMA(DF_PAF(1), DF_VFR(1, 3), o[3]);
      FX_SBAR();
#pragma unroll
      for (int i = 0; i < 8; ++i) { DF_VRD(0, 2, i); DF_VRD(1, 3, i); }
      o[0] = ATT_MFMA(DF_PAF(2), DF_VFR(0, 0), o[0]); o[1] = ATT_MFMA(DF_PAF(2), DF_VFR(0, 1), o[1]); o[2] = ATT_MFMA(DF_PAF(2), DF_VFR(0, 2), o[2]); o[3] = ATT_MFMA(DF_PAF(2), DF_VFR(0, 3), o[3]);
      o[0] = ATT_MFMA(DF_PAF(3), DF_VFR(1, 0), o[0]); o[1] = ATT_MFMA(DF_PAF(3), DF_VFR(1, 1), o[1]); o[2] = ATT_MFMA(DF_PAF(3), DF_VFR(1, 2), o[2]); o[3] = ATT_MFMA(DF_PAF(3), DF_VFR(1, 3), o[3]); }
    { auto rr = __builtin_amdgcn_permlane32_swap(__float_as_uint(l_reg), __float_as_uint(l_reg), false, false); l_reg = __uint_as_float(rr[0]) + __uint_as_float(rr[1]); }
    if (hi == 0) wsf[32 + r32] = (m == 1) ? lam / l_reg : 1.0f / l_reg;
    asm volatile("s_waitcnt lgkmcnt(0)" ::: "memory");
    float rli[16];
#pragma unroll
    for (int g = 0; g < 4; ++g) { const f32x4 a4 = *(const LAS f32x4*)(wsf + 32 + 8 * g + 4 * hi); rli[4 * g] = a4[0]; rli[4 * g + 1] = a4[1]; rli[4 * g + 2] = a4[2]; rli[4 * g + 3] = a4[3]; }
    ATT_WAIT_BAR();
    {
        LAS float* xch = (LAS float*)lds + qg * 4096;
        if (m == 1) {
#pragma unroll
            for (int db = 0; db < 4; ++db)
#pragma unroll
                for (int r = 0; r < 16; ++r) xch[(db * 16 + r) * 64 + lane] = o[db][r] * rli[r];
        }
        ATT_WAIT_BAR();
        if (m == 0) {
            float ss[16];
#pragma unroll
            for (int r = 0; r < 16; ++r) ss[r] = 0.f;
#pragma unroll
            for (int db = 0; db < 4; ++db)
#pragma unroll
                for (int r = 0; r < 16; ++r) { const float v = o[db][r] * rli[r] - xch[(db * 16 + r) * 64 + lane]; o[db][r] = v; ss[r] += v * v; }
#pragma unroll
            for (int r = 0; r < 16; ++r) {
                float v = ss[r];
                v = sum32(v);
                ss[r] = rsqrtf(v * (1.0f / 128.0f) + EPS) * lnscale;
            }
            LAS bf16_t* stg = (LAS bf16_t*)(lds + LDS_OST) + qg * 4096;
#pragma unroll
            for (int db = 0; db < 4; ++db) { const float gd = ((const GAS float*)subg)[db * 32 + r32];
#pragma unroll
                for (int r = 0; r < 16; ++r) stg[crow(r, hi) * 128 + db * 32 + r32] = (bf16_t)f2bf(o[db][r] * ss[r] * gd); }
            asm volatile("s_waitcnt lgkmcnt(0)" ::: "memory");
            bf16_t* Yw = Y + (rowbase + q0 + qg * 32) * 512 + hcol;
#pragma unroll
            for (int i = 0; i < 8; ++i) { const int row = i * 4 + (lane >> 4), ch = lane & 15; const u32x4 v = *(const LAS u32x4*)(stg + row * 128 + ch * 8); *(GAS u32x4*)(Yw + (size_t)row * 512 + ch * 8) = v; }
        }
    }
    ATT_WAIT_BAR();
#undef DF_DMA_K
#undef DF_DMA_V
#undef DF_ROT
#undef DF_EX
#undef DF_RESC
#undef DF_KLOAD2
#undef DF_CINIT
#undef DF_DECIDE
#undef DF_DECIDE2
#undef DF_PKW
#undef DF_PAF
#undef DF_VFR
#undef DF_VRD
#undef DF_VRD2
#undef DF_KRD
#undef DF_GAPA
#undef DF_GAPB
#undef DF_STEP
#undef DF_WAIT_BAR
#undef DF_AFTER
#undef DF_ENDW
}
}

__device__ __forceinline__ void ph_attention(Frame& F, const bf16_t* QKV, const float* BT, const float* CUM, const float* lamv, const float* subg, float lam_init, bf16_t* YD, bf16_t* YF) {
    const int vcu = (F.G % 8 == 0) ? (F.bid % 8) * (F.G / 8) + F.bid / 8 : F.bid;
    const float l01 = wave_sum(lamv[F.lane] * lamv[64 + F.lane]), l23 = wave_sum(lamv[128 + F.lane] * lamv[192 + F.lane]);
    const float lam = expf(l01) - expf(l23) + lam_init;
    for (int pi = vcu; pi < 256; pi += F.G) {
        const int bh = pi >> 3, s = pi & 7, b = bh >> 2, h = bh & 3;
        for (int k = 0; k < 2; ++k) {
            att::diff_unit(F.lds, F.tid, b, h, k == 0 ? 15 - s : s, QKV, QKV + (size_t)T * 512, QKV + (size_t)2 * T * 512, YD, BT + h * 129, lam, 1.0f - lam_init, subg);
        }
    }
    for (int pi = vcu; pi < 256; pi += F.G) {
        const int bh = pi >> 2, s = pi & 3, b = bh >> 3, h = bh & 7;
        for (int k = 0; k < 2; ++k) {
            att::fox_unit(F.lds, F.tid, b, h, k == 0 ? 7 - s : s, QKV + (size_t)3 * T * 512, QKV + (size_t)4 * T * 512, QKV + (size_t)5 * T * 512, YF, CUM + (size_t)bh * S);
        }
    }
}
namespace peer {
typedef float f32x2 __attribute__((ext_vector_type(2)));
typedef unsigned v6u __attribute__((ext_vector_type(6)));
typedef unsigned u32x2 __attribute__((ext_vector_type(2)));
typedef float v32f __attribute__((ext_vector_type(32)));
typedef float v16f __attribute__((ext_vector_type(16)));
constexpr float USCALE = 64.f, VSCALE = 23.f;
constexpr int ROWB = 768;
constexpr size_t TBL_BYTES = (size_t)NEXP * ROWB;

__device__ __forceinline__ unsigned e2m3_code(float x) {
    const float a = fminf(fabsf(x), 7.5f);
    float c = a < 2.f ? __builtin_rintf(a * 8.f) : (a < 4.f ? 16.f + __builtin_rintf((a - 2.f) * 4.f) : 24.f + __builtin_rintf((a - 4.f) * 2.f));
    return (unsigned)c | (x < 0.f ? 32u : 0u);
}
__device__ __forceinline__ void convert_chunk(const float* eu, const float* ev, unsigned char* dst, LAS unsigned char* stg, int lane, int which, size_t ch) {
    const size_t per_l = (size_t)NEXP * D / 32;
    const GAS f32x4* src = (const GAS f32x4*)(which == 0 ? eu : ev);
    const float sc = which == 0 ? USCALE : VSCALE;
    f32x4 in_[8];
#pragma unroll
    for (int k = 0; k < 8; ++k) in_[k] = src[ch * 512 + k * 64 + lane];
#pragma unroll
    for (int k = 0; k < 8; ++k) { const int pidx = k * 64 + lane; *(LAS f32x4*)(stg + pidx * 16 + (pidx >> 3) * 16) = in_[k]; }
    asm volatile("s_waitcnt lgkmcnt(0)" ::: "memory");
    const size_t i = ch * 64 + lane;
    const size_t l = i / per_l, r = i % per_l;
    v6u o;
    {
        v16f ev_, od_;
#pragma unroll
        for (int k = 0; k < 8; ++k) {
            const f32x4 v = *(const LAS f32x4*)(stg + lane * 144 + k * 16) * sc;
            ev_[2 * k] = v[0]; od_[2 * k] = v[1]; ev_[2 * k + 1] = v[2]; od_[2 * k + 1] = v[3];
        }
        o = __builtin_amdgcn_cvt_scalef32_2xpk16_fp6_f32(ev_, od_, 1.0f);
    }
    asm volatile("s_waitcnt lgkmcnt(0)" ::: "memory");
    GAS u32x2* d2 = (GAS u32x2*)(dst + (l * 2 + which) * TBL_BYTES + r * 24);
    d2[0] = (u32x2){o[0], o[1]}; d2[1] = (u32x2){o[2], o[3]}; d2[2] = (u32x2){o[4], o[5]};
}
__device__ __forceinline__ void convert_tables(Frame& F, const float* eu, const float* ev, unsigned char* dst) {
    const size_t nch = (size_t)NEXP * D / 2048;
    const size_t per_l = (size_t)NEXP * D / 32;
    const int lane = F.lane;
    LAS unsigned char* stg = F.lds + F.wave * 9216;
    for (int which = 0; which < 2; ++which) {
        const GAS f32x4* src = (const GAS f32x4*)(which == 0 ? eu : ev);
        const float sc = which == 0 ? USCALE : VSCALE;
        f32x4 in_[8], nx_[8];
        size_t ch = (size_t)F.gw;
        if (ch < nch) {
#pragma unroll
            for (int k = 0; k < 8; ++k) in_[k] = src[ch * 512 + k * 64 + lane];
        }
        for (; ch < nch; ch += (size_t)F.ngw) {
            const size_t chn = ch + (size_t)F.ngw;
            if (chn < nch) {
#pragma unroll
                for (int k = 0; k < 8; ++k) nx_[k] = src[chn * 512 + k * 64 + lane];
            }
#pragma unroll
            for (int k = 0; k < 8; ++k) { const int pidx = k * 64 + lane; *(LAS f32x4*)(stg + pidx * 16 + (pidx >> 3) * 16) = in_[k]; }
            asm volatile("s_waitcnt lgkmcnt(0)" ::: "memory");
            const size_t i = ch * 64 + lane;
            const size_t l = i / per_l, r = i % per_l;
            v6u o;
            {   v16f ev_, od_;
#pragma unroll
                for (int k = 0; k < 8; ++k) {
                    const f32x4 v = *(const LAS f32x4*)(stg + lane * 144 + k * 16) * sc;
                    ev_[2 * k] = v[0]; od_[2 * k] = v[1]; ev_[2 * k + 1] = v[2]; od_[2 * k + 1] = v[3];
                }
                o = __builtin_amdgcn_cvt_scalef32_2xpk16_fp6_f32(ev_, od_, 1.0f);
            }
            asm volatile("s_waitcnt lgkmcnt(0)" ::: "memory");
            GAS u32x2* d2 = (GAS u32x2*)(dst + (l * 2 + which) * TBL_BYTES + r * 24);
            d2[0] = (u32x2){o[0], o[1]}; d2[1] = (u32x2){o[2], o[3]}; d2[2] = (u32x2){o[4], o[5]};
#pragma unroll
            for (int k = 0; k < 8; ++k) in_[k] = nx_[k];
        }
    }
}

__device__ __forceinline__ float allreduce16(float s) {
    s += __builtin_bit_cast(float, __builtin_amdgcn_update_dpp(0, __builtin_bit_cast(int, s), 0xB1, 0xF, 0xF, false));
    s += __builtin_bit_cast(float, __builtin_amdgcn_update_dpp(0, __builtin_bit_cast(int, s), 0x4E, 0xF, 0xF, false));
    s += __builtin_bit_cast(float, __builtin_amdgcn_update_dpp(0, __builtin_bit_cast(int, s), 0x141, 0xF, 0xF, false));
    s += __builtin_bit_cast(float, __builtin_amdgcn_update_dpp(0, __builtin_bit_cast(int, s), 0x140, 0xF, 0xF, false));
    return s;
}
__device__ __forceinline__ v32f dec32(unsigned a, unsigned b, unsigned c, unsigned d, unsigned e, unsigned f) { return __builtin_amdgcn_cvt_scalef32_pk32_f32_fp6((v6u){a, b, c, d, e, f}, 1.0f); }

template <int MODE>
__device__ __forceinline__ void ph_peer_gather(Frame& F, const bf16_t* HNp, const float* g2pp, const float* SSPp, const int* EXPIp, const float* GATEp, const unsigned char* EU6p, const unsigned char* EV6p, float* XRp,
                                               const float* gnp, bf16_t* HNoutp, const float* wffp, const float* bfgp, float* logfp, float* outp) {
    const int lane0 = F.lane;
    LAS float* wl = (LAS float*)F.lds;
    if (MODE == 1) {
        const GAS float* wff = (const GAS float*)wffp;
        for (int k = F.tid; k < D; k += NTHREADS) {
            const f32x4 w0 = *(const GAS f32x4*)(wff + (size_t)k * INW + 3072), w1 = *(const GAS f32x4*)(wff + (size_t)k * INW + 3076);
            const int ln = ((k >> 5) & 31) + 32 * ((k >> 4) & 1), slot = (((k >> 2) & 3) * 64 + ln) * 4 + (k & 3);
            wl[0 * D + slot] = w0[0]; wl[1 * D + slot] = w0[1]; wl[2 * D + slot] = w0[2]; wl[3 * D + slot] = w0[3]; wl[4 * D + slot] = w1[0]; wl[5 * D + slot] = w1[1]; wl[6 * D + slot] = w1[2]; wl[7 * D + slot] = w1[3];
        }
        __syncthreads();
    }
    const unsigned char* wsb0 = (const unsigned char*)HNp - WS_HN;
    const GAS unsigned char* EU6 = (const GAS unsigned char*)EU6p; const GAS unsigned char* EV6 = (const GAS unsigned char*)EV6p;
    const GAS float* g2p = (const GAS float*)g2pp;
    int pi0 = 0, pi1 = 0; float pg0 = 0.f, pg1 = 0.f, pss = 0.f;
#define PEER_PREF(tt, ln, wb) do { const GAS int* ei_ = (const GAS int*)((wb) + WS_EXPI) + (size_t)(tt) * 128 + (ln); const GAS float* ga_ = (const GAS float*)((wb) + WS_GATE) + (size_t)(tt) * 128 + (ln); \
        pi0 = ei_[0]; pi1 = ei_[64]; pg0 = ga_[0]; pg1 = ga_[64]; pss = ((ln) < 16) ? ((const GAS float*)((wb) + WS_SSP))[(size_t)(tt) * 16 + (ln)] : 0.f; } while (0)
    if (F.gw < T) PEER_PREF(F.gw, lane0, wsb0);
    size_t cvc = (size_t)F.gw;
    for (int t = F.gw; t < T; t += F.ngw) {
        int lane = lane0; asm volatile("" : "+v"(lane));
        const unsigned char* wsb = opq(wsb0);
        const GAS bf16_t* HN = (const GAS bf16_t*)(wsb + WS_HN); GAS float* XR = (GAS float*)(wsb + WS_XR);
        const int r32 = lane & 31, hi = lane >> 5;
        int idx0 = pi0, idx1 = pi1; float gate0 = pg0, gate1 = pg1; const float ssv0 = pss;
        if (t + F.ngw < T) PEER_PREF(t + F.ngw, lane, wsb);
        {
            unsigned k0 = ((unsigned)idx0 << 7) | (unsigned)lane, k1 = ((unsigned)idx1 << 7) | (unsigned)(64 + lane);
#pragma unroll
            for (int kk = 2; kk <= 128; kk <<= 1) {
#pragma unroll
                for (int j = kk >> 1; j > 0; j >>= 1) {
                    if (j == 64) { const unsigned lo = k0 < k1 ? k0 : k1, hi2 = k0 < k1 ? k1 : k0; k0 = lo; k1 = hi2; }
                    else {
                        const unsigned p0 = (unsigned)bperm_i(lane ^ j, (int)k0), p1 = (unsigned)bperm_i(lane ^ j, (int)k1);
                        const bool lower = (lane & j) == 0;
                        const bool up0 = (lane & kk) == 0 || kk == 128, up1 = ((64 + lane) & kk) == 0 || kk == 128;
                        const bool kmin0 = (lower == up0), kmin1 = (lower == up1);
                        k0 = kmin0 ? (k0 < p0 ? k0 : p0) : (k0 > p0 ? k0 : p0);
                        k1 = kmin1 ? (k1 < p1 ? k1 : p1) : (k1 > p1 ? k1 : p1);
                    }
                }
            }
            const int s0 = (int)(k0 & 127u), s1 = (int)(k1 & 127u);
            const float ga0 = bperm_f(s0 & 63, gate0), gb0 = bperm_f(s0 & 63, gate1), ga1 = bperm_f(s1 & 63, gate0), gb1 = bperm_f(s1 & 63, gate1);
            gate0 = s0 < 64 ? ga0 : gb0; gate1 = s1 < 64 ? ga1 : gb1;
            idx0 = (int)(k0 >> 7); idx1 = (int)(k1 >> 7);
        }
        float cv0 = 0.f, cv1 = 0.f;
        {
            f32x2 tu[16];
            u32x2 ub[4][3];
#define PEER_ULOAD(s, slot) do { const int ix_ = bperm_i((lane & 32) + ((s) & 31), ((s) >> 5) ? idx1 : idx0); \
            const GAS u32x2* p_ = (const GAS u32x2*)(EU6 + (size_t)ix_ * ROWB + r32 * 24); ub[slot][0] = p_[0]; ub[slot][1] = p_[1]; ub[slot][2] = p_[2]; } while (0)
#define PEER_UCOMP(s, slot) do { f32x2 a0_ = {0.f, 0.f}, a1_ = {0.f, 0.f}; \
            { const v32f g_ = dec32(ub[slot][0][0], ub[slot][0][1], ub[slot][1][0], ub[slot][1][1], ub[slot][2][0], ub[slot][2][1]); \
              _Pragma("unroll") for (int j = 0; j < 16; j += 2) { a0_ = (f32x2){g_[2 * j], g_[2 * j + 1]} * tu[j] + a0_; a1_ = (f32x2){g_[2 * j + 2], g_[2 * j + 3]} * tu[j + 1] + a1_; } } \
            const float tot_ = sum32((a0_[0] + a0_[1]) + (a1_[0] + a1_[1])); \
            if (((s) >> 5) == 0) { if (r32 == ((s) & 31)) cv0 = tot_; } else { if (r32 == ((s) & 31)) cv1 = tot_; } } while (0)
            asm volatile("" ::: "memory");
            v4u trow[4];
#pragma unroll
            for (int q = 0; q < 4; ++q) trow[q] = ((const GAS v4u*)(HN + (size_t)t * D + r32 * 32))[q];
            PEER_ULOAD(0, 0); PEER_ULOAD(1, 1); PEER_ULOAD(2, 2);
            {
              const float ssv = sum32(ssv0);
              const float rsn = rsqrtf(__builtin_bit_cast(float, __builtin_amdgcn_readlane(__builtin_bit_cast(int, ssv), 0)) * (1.0f / D) + EPS);
              const GAS f32x4* gq = (const GAS f32x4*)(g2p + r32 * 32);
#pragma unroll
              for (int q = 0; q < 4; ++q) { const v4u a = trow[q]; const f32x4 ga = gq[2 * q] * rsn, gb = gq[2 * q + 1] * rsn;
                  tu[q * 4 + 0] = (f32x2){__uint_as_float(a[0] << 16) * ga[0], __uint_as_float(a[0] & 0xffff0000u) * ga[1]};
                  tu[q * 4 + 1] = (f32x2){__uint_as_float(a[1] << 16) * ga[2], __uint_as_float(a[1] & 0xffff0000u) * ga[3]};
                  tu[q * 4 + 2] = (f32x2){__uint_as_float(a[2] << 16) * gb[0], __uint_as_float(a[2] & 0xffff0000u) * gb[1]};
                  tu[q * 4 + 3] = (f32x2){__uint_as_float(a[3] << 16) * gb[2], __uint_as_float(a[3] & 0xffff0000u) * gb[3]}; } }
            for (int s0 = 0; s0 < 60; s0 += 4) {
                PEER_ULOAD(s0 + 3, 3); PEER_UCOMP(s0, 0);
                PEER_ULOAD(s0 + 4, 0); PEER_UCOMP(s0 + 1, 1);
                PEER_ULOAD(s0 + 5, 1); PEER_UCOMP(s0 + 2, 2);
                PEER_ULOAD(s0 + 6, 2); PEER_UCOMP(s0 + 3, 3);
            }
            PEER_ULOAD(63, 3); PEER_UCOMP(60, 0); PEER_UCOMP(61, 1); PEER_UCOMP(62, 2); PEER_UCOMP(63, 3);
#undef PEER_ULOAD
#undef PEER_UCOMP
        }
        float c0, c1;
        { const float x0 = cv0 * (1.0f / USCALE), x1 = cv1 * (1.0f / USCALE);
          c0 = gate0 * (0.5f * x0 * (1.0f + erff(x0 * 0.70710678118654752f))) * (1.0f / VSCALE);
          c1 = gate1 * (0.5f * x1 * (1.0f + erff(x1 * 0.70710678118654752f))) * (1.0f / VSCALE); }
        f32x2 acc[16];
#pragma unroll
        for (int k = 0; k < 16; ++k) acc[k] = (f32x2){0.f, 0.f};
        u32x2 vb[6][3];
#define PEER_VLOAD(s, slot) do { const int sl_ = (lane & 32) + ((s) & 31); const int ix_ = bperm_i(sl_, ((s) >> 5) ? idx1 : idx0); \
            const GAS u32x2* p_ = (const GAS u32x2*)(EV6 + (size_t)ix_ * ROWB + r32 * 24); vb[slot][0] = p_[0]; vb[slot][1] = p_[1]; vb[slot][2] = p_[2]; } while (0)
#define PEER_VCOMP(s, slot) do { const int sl_ = (lane & 32) + ((s) & 31); const float c_ = bperm_f(sl_, ((s) >> 5) ? c1 : c0); const f32x2 cc_ = {c_, c_}; \
            const v32f g_ = dec32(vb[slot][0][0], vb[slot][0][1], vb[slot][1][0], vb[slot][1][1], vb[slot][2][0], vb[slot][2][1]); \
            _Pragma("unroll") for (int j = 0; j < 16; ++j) acc[j] = (f32x2){g_[2 * j], g_[2 * j + 1]} * cc_ + acc[j]; } while (0)
#pragma unroll
        for (int k = 0; k < 5; ++k) PEER_VLOAD(k, k);
        for (int s0 = 0; s0 < 54; s0 += 6) {
#pragma unroll
            for (int k = 0; k < 6; ++k) { PEER_VLOAD(s0 + k + 5, (k + 5) % 6); PEER_VCOMP(s0 + k, k); }
        }
#pragma unroll
        for (int k = 0; k < 5; ++k) { PEER_VLOAD(59 + k, (k + 5) % 6); PEER_VCOMP(54 + k, k); }
#pragma unroll
        for (int k = 0; k < 5; ++k) PEER_VCOMP(59 + k, (k + 5) % 6);
#undef PEER_VLOAD
#undef PEER_VCOMP
        float pv[16];
#pragma unroll
        for (int j = 0; j < 8; ++j) {
            const float mx = hi ? acc[8 + j][0] : acc[j][0], my = hi ? acc[8 + j][1] : acc[j][1];
            const float ox = hi ? acc[j][0] : acc[8 + j][0], oy = hi ? acc[j][1] : acc[8 + j][1];
            pv[2 * j] = mx + bperm_f(lane ^ 32, ox); pv[2 * j + 1] = my + bperm_f(lane ^ 32, oy);
        }
        int e0 = r32 * 32 + hi * 16; asm volatile("" : "+v"(e0));
        GAS f32x4* xp = (GAS f32x4*)(XR + (size_t)t * D + e0);
        f32x4 xv[4];
#pragma unroll
        for (int j = 0; j < 4; ++j) xv[j] = xp[j];
        float ss = 0.f;
#pragma unroll
        for (int j = 0; j < 4; ++j) { xv[j][0] += pv[4 * j]; xv[j][1] += pv[4 * j + 1]; xv[j][2] += pv[4 * j + 2]; xv[j][3] += pv[4 * j + 3];
            ss += xv[j][0] * xv[j][0] + xv[j][1] * xv[j][1] + xv[j][2] * xv[j][2] + xv[j][3] * xv[j][3]; }
        if (MODE != 2) {
#pragma unroll
            for (int j = 0; j < 4; ++j) xp[j] = xv[j];
        }
        ss = wave_sum(ss);
        const float rs = rsqrtf(ss * (1.0f / D) + EPS);
        const GAS f32x4* gp = (const GAS f32x4*)(gnp + e0);
#pragma unroll
        for (int j = 0; j < 4; ++j) { const f32x4 gg = gp[j]; xv[j] = xv[j] * gg * rs; }
        if (MODE == 2) {
            GAS f32x4* op = (GAS f32x4*)(outp + (size_t)t * D + e0);
#pragma unroll
            for (int j = 0; j < 4; ++j) op[j] = xv[j];
        } else {
            v4u h0, h1;
            h0[0] = pk2(xv[0][0], xv[0][1]); h0[1] = pk2(xv[0][2], xv[0][3]); h0[2] = pk2(xv[1][0], xv[1][1]); h0[3] = pk2(xv[1][2], xv[1][3]);
            h1[0] = pk2(xv[2][0], xv[2][1]); h1[1] = pk2(xv[2][2], xv[2][3]); h1[2] = pk2(xv[3][0], xv[3][1]); h1[3] = pk2(xv[3][2], xv[3][3]);
            GAS v4u* hp = (GAS v4u*)((GAS bf16_t*)(wsb + WS_HN) + (size_t)t * D + e0); hp[0] = h0; hp[1] = h1;
            float a[8];
#pragma unroll
            for (int q = 0; q < 8; ++q) { float s = 0.f;
#pragma unroll
                for (int j = 0; j < 4; ++j) { const f32x4 w = *(const LAS f32x4*)(wl + q * D + (j * 64 + lane) * 4); s += (xv[j][0] * w[0] + xv[j][1] * w[1]) + (xv[j][2] * w[2] + xv[j][3] * w[3]); }
                a[q] = wave_sum(s); }
            if (lane < 8) {
                float f = lane == 0 ? a[0] : lane == 1 ? a[1] : lane == 2 ? a[2] : lane == 3 ? a[3] : lane == 4 ? a[4] : lane == 5 ? a[5] : lane == 6 ? a[6] : a[7];
                f += bfgp[lane];
                ((GAS float*)(wsb + WS_LOGF))[(size_t)t * 8 + lane] = fminf(f, 0.f) - log1pf(expf(-fabsf(f)));
            }
        }
        if (MODE == 1) {
            constexpr size_t NCHL = (size_t)NEXP * D / 2048;
            if (cvc < 2 * NCHL) { int lc_ = lane; asm volatile("" : "+v"(lc_));
                peer::convert_chunk(ARG_IN(12), ARG_IN(13), (unsigned char*)(opq(wsb0) + WS_EXP), F.lds + 32768 + F.wave * 9216, lc_, (int)(cvc / NCHL), NCHL + cvc % NCHL); cvc += (size_t)F.ngw; }
        }
    }
    if (MODE == 1) {
        constexpr size_t NCHL = (size_t)NEXP * D / 2048;
        for (; cvc < 2 * NCHL; cvc += (size_t)F.ngw) { int lc_ = lane0; asm volatile("" : "+v"(lc_)); peer::convert_chunk(ARG_IN(12), ARG_IN(13), (unsigned char*)(opq(wsb0) + WS_EXP), F.lds + 32768 + F.wave * 9216, lc_, (int)(cvc / NCHL), NCHL + cvc % NCHL); }
    }
}
}
namespace route {
typedef float f32x16 __attribute__((ext_vector_type(16)));
typedef unsigned u32x2 __attribute__((ext_vector_type(2)));
constexpr int KROW = 272;
constexpr int KIMG = 128 * KROW;
constexpr int OFF_SLOT = 2 * KIMG;

#define RT_CE(a, b) do { const float hi_ = fmaxf(a, b), lo_ = fminf(a, b); a = hi_; b = lo_; } while (0)
template <int BASE> __device__ __forceinline__ void sort16(float (&v)[64]) {
    constexpr int NET[60][2] = {{0, 13}, {1, 12}, {2, 15}, {3, 14}, {4, 8}, {5, 6}, {7, 11}, {9, 10},   {0, 5}, {1, 7}, {2, 9}, {3, 4}, {6, 13}, {8, 14}, {10, 15}, {11, 12},
                                {0, 1}, {2, 3}, {4, 5}, {6, 8}, {7, 9}, {10, 11}, {12, 13}, {14, 15},   {0, 2}, {1, 3}, {4, 10}, {5, 11}, {6, 7}, {8, 9}, {12, 14}, {13, 15},
                                {1, 2}, {3, 12}, {4, 6}, {5, 7}, {8, 10}, {9, 11}, {13, 14},   {1, 4}, {2, 6}, {5, 8}, {7, 10}, {9, 13}, {11, 14},   {2, 4}, {3, 6}, {9, 12}, {11, 13},
                                {3, 5}, {6, 8}, {7, 9}, {10, 12},   {3, 4}, {5, 6}, {7, 8}, {9, 10}, {11, 12},   {6, 7}, {8, 9}};
#pragma unroll
    for (int c = 0; c < 60; ++c) RT_CE(v[BASE + NET[c][0]], v[BASE + NET[c][1]]);
}
template <int A, int B> __device__ __forceinline__ void merge16(float (&v)[64]) {
#pragma unroll
    for (int i = 0; i < 16; ++i) v[A + i] = fmaxf(v[A + i], v[B + 15 - i]);
#pragma unroll
    for (int j = 8; j > 0; j >>= 1)
#pragma unroll
        for (int i = 0; i < 16; ++i) { const int l = i ^ j; if (l > i) RT_CE(v[A + i], v[A + l]); }
}
__device__ __forceinline__ void top16_of_64(float (&v)[64]) { sort16<0>(v); sort16<16>(v); sort16<32>(v); sort16<48>(v); merge16<0, 16>(v); merge16<32, 48>(v); merge16<0, 32>(v); }

__device__ __forceinline__ void ph_route(Frame& F, const pg8::StaticOrder& So, const bf16_t* QPp, const float* SKp, int* EXPIp, float* GATEp) {
    const int lane = F.lane, r32 = lane & 31, hi = lane >> 5;
    const GAS bf16_t* QP = (const GAS bf16_t*)QPp; const GAS float* SK = (const GAS float*)SKp;
    {
        f32x4 k4[16];
#pragma unroll
        for (int q = 0; q < 16; ++q) k4[q] = *(const GAS f32x4*)(SK + (size_t)(F.tid + q * NTHREADS) * 4);
#pragma unroll
        for (int q = 0; q < 16; ++q) {
            const int e = (F.tid + q * NTHREADS) * 4, p = e >> 14, n = (e >> 7) & 127, d = e & 127;
            u32x2 o; o[0] = pk2(k4[q][0], k4[q][1]); o[1] = pk2(k4[q][2], k4[q][3]);
            *(LAS u32x2*)(F.lds + p * KIMG + n * KROW + d * 2) = o;
        }
    }
    __syncthreads();
    LAS unsigned* slot = (LAS unsigned*)(F.lds + OFF_SLOT + F.wave * 8192) + lane;
    pg8::Unit u_;
    for (int ui = 0; So.next(ui, u_); ++ui) {
        const int tile = u_.pm * 8 + F.wave, h = u_.pn;
        const int tok = tile * 32 + r32;
        float s01[2][16];
#pragma unroll
        for (int p = 0; p < 2; ++p) {
            bf16x8 qf[8];
#pragma unroll
            for (int ks = 0; ks < 8; ++ks) qf[ks] = *(const GAS bf16x8*)(QP + (size_t)tok * 2048 + h * 256 + p * 128 + ks * 16 + hi * 8);
            f32x16 acc[4];
#pragma unroll
            for (int kb = 0; kb < 4; ++kb) acc[kb] = f32x16{};
            const LAS unsigned char* kbase = F.lds + p * KIMG + r32 * KROW + hi * 16;
#pragma unroll
            for (int ks = 0; ks < 8; ++ks)
#pragma unroll
                for (int kb = 0; kb < 4; ++kb) {
                    const bf16x8 a = *(const LAS bf16x8*)(kbase + kb * 32 * KROW + ks * 32);
                    acc[kb] = __builtin_amdgcn_mfma_f32_32x32x16_bf16(a, qf[ks], acc[kb], 0, 0, 0);
                }
            float v[64];
#pragma unroll
            for (int kb = 0; kb < 4; ++kb)
#pragma unroll
                for (int r = 0; r < 16; ++r) {
                    const unsigned n = (unsigned)(32 * kb + (r & 3) + 8 * (r >> 2)) + 4u * (unsigned)hi;
                    v[kb * 16 + r] = __uint_as_float((__float_as_uint(acc[kb][r]) & 0xFFFFFF80u) | n);
                }
            top16_of_64(v);
            float w[16];
#pragma unroll
            for (int i = 0; i < 16; ++i) w[i] = bperm_f(lane ^ 32, v[15 - i]);
#pragma unroll
            for (int i = 0; i < 16; ++i) v[i] = fmaxf(v[i], w[i]);
#pragma unroll
            for (int j = 8; j > 0; j >>= 1)
#pragma unroll
                for (int i = 0; i < 16; ++i) { const int l = i ^ j; if (l > i) RT_CE(v[i], v[l]); }
#pragma unroll
            for (int i = 0; i < 16; ++i) s01[p][i] = v[i];
        }
#pragma unroll
        for (int i = 0; i < 16; ++i) { slot[i * 64] = __float_as_uint(s01[0][i]) & 127u; slot[(16 + i) * 64] = __float_as_uint(s01[1][i]) & 127u; }
        float c[64];
        {
            constexpr int CNT[16] = {16, 8, 5, 4, 3, 2, 2, 2, 1, 1, 1, 1, 1, 1, 1, 1}, OFS[16] = {0, 16, 24, 29, 33, 36, 38, 40, 42, 43, 44, 45, 46, 47, 48, 49};
#pragma unroll
            for (int a = 0; a < 16; ++a)
#pragma unroll
                for (int b = 0; b < 16; ++b)
                    if (b < CNT[a]) c[OFS[a] + b] = __uint_as_float((__float_as_uint(s01[0][a] + s01[1][b]) & 0xFFFFFF00u) | (unsigned)(a * 16 + b));
#pragma unroll
            for (int i = 50; i < 64; ++i) c[i] = -INFINITY;
        }
        sort16<16>(c); sort16<32>(c); RT_CE(c[48], c[49]); merge16<0, 16>(c); merge16<32, 48>(c); merge16<0, 32>(c);
        float g[16]; int ex[16];
        asm volatile("s_waitcnt lgkmcnt(0)" ::: "memory");
        const float mx = __uint_as_float(__float_as_uint(c[0]) & 0xFFFFFF00u);
        float sum = 0.f;
#pragma unroll
        for (int i = 0; i < 16; ++i) {
            const unsigned bits = __float_as_uint(c[i]);
            const unsigned a = (bits >> 4) & 15u, b = bits & 15u;
            g[i] = __expf(__uint_as_float(bits & 0xFFFFFF00u) - mx); sum += g[i];
            ex[i] = (int)(slot[a * 64] * 128u + slot[(16 + b) * 64]);
        }
        const float inv = 1.0f / sum;
        GAS int* eo = (GAS int*)EXPIp + ((size_t)tok * 8 + h) * 16 + hi * 8;
        GAS float* go = (GAS float*)GATEp + ((size_t)tok * 8 + h) * 16 + hi * 8;
        if (hi == 0) {
            *(GAS v4u*)eo = (v4u){(unsigned)ex[0], (unsigned)ex[1], (unsigned)ex[2], (unsigned)ex[3]}; *(GAS v4u*)(eo + 4) = (v4u){(unsigned)ex[4], (unsigned)ex[5], (unsigned)ex[6], (unsigned)ex[7]};
            *(GAS f32x4*)go = (f32x4){g[0] * inv, g[1] * inv, g[2] * inv, g[3] * inv}; *(GAS f32x4*)(go + 4) = (f32x4){g[4] * inv, g[5] * inv, g[6] * inv, g[7] * inv};
        } else {
            *(GAS v4u*)eo = (v4u){(unsigned)ex[8], (unsigned)ex[9], (unsigned)ex[10], (unsigned)ex[11]}; *(GAS v4u*)(eo + 4) = (v4u){(unsigned)ex[12], (unsigned)ex[13], (unsigned)ex[14], (unsigned)ex[15]};
            *(GAS f32x4*)go = (f32x4){g[8] * inv, g[9] * inv, g[10] * inv, g[11] * inv}; *(GAS f32x4*)(go + 4) = (f32x4){g[12] * inv, g[13] * inv, g[14] * inv, g[15] * inv};
        }
        asm volatile("s_waitcnt lgkmcnt(0)" ::: "memory");
    }
}
#undef RT_CE
}
constexpr int NPL = 6;
constexpr int N_PHASES = 1 + DEPTH * NPL;
__global__ void __launch_bounds__(NTHREADS, 2) mega_fwd(Args  ) {
    extern __shared__ __attribute__((aligned(16))) unsigned char lds[];
    cg::grid_group grid = cg::this_grid();
    Frame F;
    F.lds = (LAS unsigned char*)lds;
    F.G = gridDim.x; F.ngw = F.G * NWAVES;
    volatile LAS unsigned* bst = (volatile LAS unsigned*)(F.lds + LDS_BYTES - 64);
    const int wave0 = __builtin_amdgcn_readfirstlane((int)threadIdx.x >> 6);
    if (threadIdx.x == 0) { bst[0] = 0u; bst[1] = 0u; }
    __syncthreads();
    const XcdBarrier bar = xcd_barrier_post((unsigned*)(ARG_WS + WS_CTL) + CW_BAR, bst, (int)threadIdx.x);
    for (int ph = ARG_PHLO; ph < ARG_PHHI; ++ph) {
        { int t_; asm volatile("v_mbcnt_lo_u32_b32 %0, -1, 0\n\tv_mbcnt_hi_u32_b32 %0, -1, %0" : "=v"(t_)); t_ += wave0 * 64; asm volatile("" : "+v"(t_)); int b_ = blockIdx.x; asm volatile("" : "+s"(b_));
          int l_ = t_ & 63; asm volatile("" : "+v"(l_));
          F.tid = t_; F.lane = l_; F.wave = __builtin_amdgcn_readfirstlane(t_ >> 6); F.bid = b_; F.gw = b_ * NWAVES + F.wave; }
        unsigned char* ws = ARG_WS;
        float* XR = (float*)(ws + WS_XR);
        bf16_t* HN = (bf16_t*)(ws + WS_HN);
        if (ph == 0) {
            ph_prologue(F);
            __syncthreads();
            peer::convert_tables(F, ARG_IN(12), ARG_IN(13), ws + WS_EXP);
            __syncthreads();
            ph_rmsnorm(F, ARG_IN(0), ARG_IN(1), HN, ARG_IN(2), ARG_IN(3), (float*)(ws + WS_LOGF));
        } else {
            const int l = (ph - 1) / NPL, k = (ph - 1) % NPL;
            const float* xin = (l == 0) ? ARG_IN(0) : XR;
            switch (k) {
            case 0: {
                ph_cumsum(F, (const float*)(ws + WS_LOGF), (float*)(ws + WS_CUM));
                pg8::Gemm g{HN, (const bf16_t*)(ws + WS_WIN + (size_t)l * 10 * MiB), T, NPROJ, D}; pg8::StaticOrder So; So.init(T, NPROJ, F.G, F.bid);
                pg8::EpiProj E{(bf16_t*)(ws + WS_A), (bf16_t*)(ws + WS_SG)};
                pg8::gemm_phase<pg8::EpiProj, pg8::StaticOrder, true, true>(F.lds, g, So, E, F.tid);
            } break;
            case 1: {
                const float lam_init = 0.8f - 0.6f * expf(-0.3f * (float)l);
                ph_attention(F, (const bf16_t*)(ws + WS_A), (const float*)(ws + WS_BT), (const float*)(ws + WS_CUM), ARG_IN(4) + l * 256, ARG_IN(5) + l * 128, lam_init, (bf16_t*)(ws + WS_YD), (bf16_t*)(ws + WS_YF));
            } break;
            case 2: {
                { pg8::Gemm g{(const bf16_t*)(ws + WS_YD), (const bf16_t*)(ws + WS_WDO + (size_t)l * MiB), T, D, 512}; pg8::StaticOrder So; So.init(T, D, F.G, F.bid);
                  pg8::EpiMerge1 E{(const bf16_t*)(ws + WS_SG), (bf16_t*)(ws + WS_MGT)};
                  pg8::gemm_phase<pg8::EpiMerge1, pg8::StaticOrder, true, true>(F.lds, g, So, E, F.tid); }
                ws = opq(ws);
                { pg8::Gemm g{(const bf16_t*)(ws + WS_YF), (const bf16_t*)(ws + WS_WFO + (size_t)l * MiB), T, D, 512}; pg8::StaticOrder So; So.init(T, D, F.G, F.bid);
                  pg8::EpiMerge2 E{(const bf16_t*)(ws + WS_SG) + (size_t)T * 1024, (const bf16_t*)(ws + WS_MGT), (bf16_t*)(ws + WS_MG)};
                  pg8::gemm_phase<pg8::EpiMerge2, pg8::StaticOrder, true, true>(F.lds, g, So, E, F.tid); }
            } break;
            case 3: {
                pg8::Gemm g{(const bf16_t*)(ws + WS_MG), (const bf16_t*)(ws + WS_WOUT + (size_t)l * 2 * MiB), T, D, D}; pg8::StaticOrder So; So.init(T, D, F.G, F.bid);
                pg8::EpiResidSS E{xin, XR, HN, (float*)(ws + WS_SSP)};
                pg8::gemm_phase<pg8::EpiResidSS, pg8::StaticOrder, true, true>(F.lds, g, So, E, F.tid);
            } break;
            case 4: {
                pg8::StaticOrder So; So.init(T, 2048, F.G, F.bid);
                LAS float* rsl = (LAS float*)(F.lds + 131072 + 4096);
                int pm0 = 0;
                { pg8::Unit u_; for (int ui = 0; ui < 2 && So.next(ui, u_); ++ui) { if (ui == 0) pm0 = u_.pm;
                      if (F.tid < 256) { const GAS f32x4* sp = (const GAS f32x4*)((const float*)(ws + WS_SSP) + (size_t)(u_.pm * 256 + F.tid) * 16);
                          const f32x4 s0 = sp[0], s1 = sp[1], s2 = sp[2], s3 = sp[3];
                          const float ss = ((s0[0] + s0[1]) + (s0[2] + s0[3])) + ((s1[0] + s1[1]) + (s1[2] + s1[3])) + ((s2[0] + s2[1]) + (s2[2] + s2[3])) + ((s3[0] + s3[1]) + (s3[2] + s3[3]));
                          rsl[(u_.pm == pm0 ? 0 : 256) + F.tid] = rsqrtf(ss * (1.0f / D) + EPS); } } }
                __syncthreads();
                { pg8::Gemm g{HN, (const bf16_t*)(ws + WS_WQ + (size_t)l * 4 * MiB), T, 2048, D};
                  pg8::EpiQP E{(bf16_t*)(ws + WS_QP), rsl, pm0};
                  pg8::gemm_phase<pg8::EpiQP, pg8::StaticOrder, true, true>(F.lds, g, So, E, F.tid); }
                asm volatile("s_waitcnt vmcnt(0)" ::: "memory");
                __syncthreads();
                if (F.tid == 0) { __builtin_amdgcn_fence(__ATOMIC_ACQUIRE, "agent"); asm volatile("s_waitcnt vmcnt(0)" ::: "memory"); }
                __syncthreads();
                ws = opq(ws);
                route::ph_route(F, So, (const bf16_t*)(ws + WS_QP), ARG_IN(11) + (size_t)l * 2 * 128 * 128, (int*)(ws + WS_EXPI), (float*)(ws + WS_GATE));
            } break;
            case 5: {
                const unsigned char* eu8 = ws + WS_EXP + (size_t)(l * 2) * peer::TBL_BYTES; const unsigned char* ev8 = eu8 + peer::TBL_BYTES;
                if (l + 1 < DEPTH)
                    peer::ph_peer_gather<1>(F, HN, ARG_IN(9) + l * D, (const float*)(ws + WS_SSP), (const int*)(ws + WS_EXPI), (const float*)(ws + WS_GATE), eu8, ev8, XR,
                                            ARG_IN(1) + (l + 1) * D, HN, ARG_IN(2) + (size_t)(l + 1) * D * INW, ARG_IN(3) + (l + 1) * 8, (float*)(ws + WS_LOGF), nullptr);
                else
                    peer::ph_peer_gather<2>(F, HN, ARG_IN(9) + l * D, (const float*)(ws + WS_SSP), (const int*)(ws + WS_EXPI), (const float*)(ws + WS_GATE), eu8, ev8, XR,
                                            ARG_IN(15), nullptr, nullptr, nullptr, nullptr, ARG_OUT);
            } break;
            }
        }
        if (ph + 1 < ARG_PHHI) { if (ARG_PHHI > N_PHASES) grid.sync(); else xcd_barrier(bar, F.tid); }
    }
}

extern "C" void kernel_launch(void* const* d_in, const int* in_sizes, int n_in, void* d_out, int out_size, void* d_ws, size_t ws_size, hipStream_t stream) {
    static int grid = 0;
    if (grid == 0) {
        if (n_in != 16 || ws_size < WS_END) { fprintf(stderr, "kernel_launch: unexpected inputs (n_in %d, ws %zu)\n", n_in, ws_size); grid = -1; return; }
        int dev = 0, cus = 0, per_cu = 0;
        if (hipGetDevice(&dev) != hipSuccess || hipDeviceGetAttribute(&cus, hipDeviceAttributeMultiprocessorCount, dev) != hipSuccess) { grid = -1; return; }
        if (hipFuncSetAttribute((const void*)mega_fwd, hipFuncAttributeMaxDynamicSharedMemorySize, LDS_BYTES) != hipSuccess) { fprintf(stderr, "kernel_launch: hipFuncSetAttribute failed\n"); grid = -1; return; }
        if (hipOccupancyMaxActiveBlocksPerMultiprocessor(&per_cu, (const void*)mega_fwd, NTHREADS, LDS_BYTES) != hipSuccess || per_cu < 1) { fprintf(stderr, "kernel_launch: occupancy query says %d\n", per_cu); per_cu = 1; }
        (void)hipGetLastError();
        grid = cus;
    }
    if (grid < 0) return;
    (void)hipMemsetAsync((char*)d_ws + WS_CTL, 0, CTL_ZERO_BYTES, stream);
    Args a{};
    for (int i = 0; i < 16; ++i) a.in[i] = (const float*)d_in[i];
    a.out = (float*)d_out; a.ws = (unsigned char*)d_ws; a.ph_lo = 0; a.ph_hi = N_PHASES;
    void* kargs[] = {&a};
    hipError_t e = hipLaunchCooperativeKernel((const void*)mega_fwd, dim3(grid), dim3(NTHREADS), kargs, LDS_BYTES, stream);
    if (e != hipSuccess) fprintf(stderr, "kernel_launch: cooperative launch failed: %s (grid %d)\n", hipGetErrorString(e), grid);
}
```

```cpp
#include <hip/hip_runtime.h>
#include <hip/hip_cooperative_groups.h>
#include <cstdio>
#include <cstdint>
#include <math.h>
namespace cg = cooperative_groups;
namespace pg8 {
#define PG8_LAS __attribute__((address_space(3)))
typedef unsigned short bf16_t;
typedef short bf16x8 __attribute__((ext_vector_type(8)));
typedef float f32x4 __attribute__((ext_vector_type(4)));
typedef unsigned u32x4 __attribute__((ext_vector_type(4)));
constexpr int BM = 256, BK = 64, HALF = 128, HTB = HALF * BK * 2  , STAGE_BYTES = 8 * HTB, NXCD = 8, WGM = 8;

__host__ __device__ __forceinline__ int lds_byte(int r, int c) { const int st = (r >> 4) * 2 + (c >> 5), rr = r & 15, cc = c & 31, ob = rr * 64 + cc * 2; return st * 1024 + (ob ^ (((ob >> 9) & 1) << 5)); }
__host__ __device__ __forceinline__ void stage_rc(int b, int& R, int& C) { const int st = b / 1024, sb = b % 1024, swz = sb ^ (((sb >> 9) & 1) << 5); R = (st >> 1) * 16 + swz / 64; C = (st & 1) * 32 + (swz % 64) / 2; }
__host__ __device__ __forceinline__ int perm32(int rho) { const int n = rho >> 4, i = rho & 15; return 8 * (i >> 2) + 4 * n + (i & 3); }

struct Unit { int pm, pn; };
struct Gemm { const bf16_t* A; const bf16_t* Bt; int M, N, K; const bf16_t* A2; const bf16_t* Bt2; };

struct StaticOrder {
    int nM, nN, nwg, G, c;
    __host__ __device__ void init(int M, int N, int G_, int c_) { nM = M / BM; nN = N / BM; nwg = nM * nN; G = G_; c = c_; }
    __host__ __device__ bool next(int i, Unit& u) const {
        const long L = (long)i * G + c; if (L >= nwg) return false;
        int wgid = (int)L; { const int q = nwg / NXCD, r = nwg % NXCD, xcd = wgid % NXCD, off = wgid / NXCD; wgid = (xcd < r ? xcd * (q + 1) : r * (q + 1) + (xcd - r) * q) + off; }
        const int nig = WGM * nN, gid = wgid / nig, fm = gid * WGM, gsz = (nM - fm) < WGM ? (nM - fm) : WGM;
        u.pm = fm + ((wgid % nig) % gsz); u.pn = (wgid % nig) / gsz; return true;
    }
    __device__ __forceinline__ void a_ready(const Unit&) const {}
    __device__ __forceinline__ void done(const Unit&) const {}
};

struct PairOrder {
    StaticOrder base;
    __host__ __device__ void init(int M, int N, int G_, int c_) { base.init(M, N, G_, c_); }
    __host__ __device__ bool next(int i, Unit& u) const { return base.next(i >> 1, u); }
    __device__ __forceinline__ void a_ready(const Unit&) const {}
    __device__ __forceinline__ void done(const Unit&) const {}
};

__device__ __forceinline__ unsigned cvt_pk_bf16(float lo, float hi) { unsigned r; asm volatile("v_cvt_pk_bf16_f32 %0, %1, %2" : "=v"(r) : "v"(lo), "v"(hi)); return r; }
typedef float f32x2 __attribute__((ext_vector_type(2)));
__device__ __forceinline__ f32x2 gelu_pk(f32x2 v) {
    const f32x2 av = __builtin_elementwise_abs(v), d = av * 0.2316418882f + 1.0f;
    f32x2 t; t.x = __builtin_amdgcn_rcpf(d.x); t.y = __builtin_amdgcn_rcpf(d.y);
    f32x2 q = t * 0.5307027145f + (-0.7265760135f); q = q * t + 0.7107068705f; q = q * t + (-0.142248368f); q = q * t + 0.127414796f; q = q * t;
    const f32x2 s = (v * v) * (-0.72134752044f);
    f32x2 e; e.x = __builtin_amdgcn_exp2f(s.x); e.y = __builtin_amdgcn_exp2f(s.y);
    const f32x2 m = v * (q * e), r = v - m;
    f32x2 o; o.x = v.x < 0.f ? m.x : r.x; o.y = v.y < 0.f ? m.y : r.y; return o;
}

template <int ACT  > struct EpiBf16 {
    static constexpr bool PERM = true, AFTER_DRAIN = false, CHAIN = false; static_assert(ACT == 0 || ACT == 1, "EpiBf16: ACT is 0 (none) or 1 (gelu_pk)");
    bf16_t* O; int ldc; const float* bias; int split_cols; size_t split_stride; float scale0;
    __device__ __forceinline__ void operator()(const f32x4 (&acc)[2][2][4][2], const Unit& u, int wr, int wc, int fr, int fq) const {
        const int row0 = u.pm * BM + wr * 64 + fr; int colt = u.pn * BM; bf16_t* base = O;
        float sc = 1.f; if (split_cols) { const int t = colt / split_cols; base += (size_t)t * split_stride; colt -= t * split_cols; if (t == 0) sc = scale0; }
        const int col0 = colt + wc * 32 + 8 * fq, bcol0 = u.pn * BM + wc * 32 + 8 * fq;
        f32x4 bv[2][2];
#pragma unroll
        for (int bj = 0; bj < 2; ++bj)
#pragma unroll
            for (int n = 0; n < 2; ++n) bv[bj][n] = bias ? *(const f32x4*)(bias + bcol0 + bj * HALF + 4 * n) : (f32x4){0.f, 0.f, 0.f, 0.f};
#pragma unroll
        for (int ai = 0; ai < 2; ++ai)
#pragma unroll
            for (int m = 0; m < 4; ++m) { bf16_t* rowp = base + (size_t)(row0 + ai * HALF + m * 16) * ldc + col0;
#pragma unroll
                for (int bj = 0; bj < 2; ++bj) { f32x4 v0 = acc[ai][bj][m][0] + bv[bj][0], v1 = acc[ai][bj][m][1] + bv[bj][1];
                    if (ACT == 1) { f32x2 a = gelu_pk((f32x2){v0[0], v0[1]}), b = gelu_pk((f32x2){v0[2], v0[3]}), c = gelu_pk((f32x2){v1[0], v1[1]}), d = gelu_pk((f32x2){v1[2], v1[3]});
                        v0 = (f32x4){a.x, a.y, b.x, b.y}; v1 = (f32x4){c.x, c.y, d.x, d.y}; }
                    v0 = v0 * sc; v1 = v1 * sc; u32x4 w; w.x = cvt_pk_bf16(v0[0], v0[1]); w.y = cvt_pk_bf16(v0[2], v0[3]); w.z = cvt_pk_bf16(v1[0], v1[1]); w.w = cvt_pk_bf16(v1[2], v1[3]);
                    *(u32x4*)(rowp + bj * HALF) = w; } }
    }
};
template <class Epi, class Sched, bool ALIGN_EPI = false, bool SP2 = false>
__device__ __forceinline__ void gemm_phase(PG8_LAS unsigned char* lds, const Gemm g, const Sched& S, const Epi& E, const int tid_in) {
    int tid_ = tid_in; asm volatile("" : "+v"(tid_));
    const int tid = tid_, wid = __builtin_amdgcn_readfirstlane(tid >> 6), lane = tid & 63, wr = wid >> 2, wc = wid & 3, fr = lane & 15, fq = lane >> 4;
    const int K = g.K, nt = K / BK;
    unsigned voffA[2], voffB[2];
#pragma unroll
    for (int i = 0; i < 2; ++i) { int R, C; stage_rc(tid * 16 + i * 8192, R, C); const int Rb = Epi::PERM ? ((R & ~31) + perm32(R & 31)) : R;
        voffA[i] = (unsigned)(R * K + C) * 2u; voffB[i] = (unsigned)(Rb * K + C) * 2u; }
    const size_t kstep = (size_t)(BK * 2);
    const size_t hstep = (size_t)HALF * K * 2;
    const size_t tstep = 2 * hstep;
    const unsigned ldsw = (unsigned)wid * 1024u;
    const int aoff = lds_byte(wr * 64 + fr, fq * 8), boff = lds_byte(wc * 32 + fr, fq * 8);
#define PG8_SA(b, h) (((b) * 2 + (h)) * HTB)
#define PG8_SB(b, h) ((4 + (b) * 2 + (h)) * HTB)
#define PG8_STAGE(bufoff, gbase, voff) do { _Pragma("unroll") for (int _i = 0; _i < 2; ++_i) \
        __builtin_amdgcn_global_load_lds((const unsigned*)((const char*)(gbase) + (voff)[_i]), (PG8_LAS unsigned*)(lds + (bufoff) + ldsw + _i * 8192), 16, 0, 0); } while (0)
#define PG8_LDA(dst, b, h) do { _Pragma("unroll") for (int m = 0; m < 4; ++m) _Pragma("unroll") for (int k = 0; k < 2; ++k) dst[m][k] = *(const PG8_LAS bf16x8*)(lds + PG8_SA(b, h) + aoff + m * 2048 + k * 1024); } while (0)
#define PG8_LDB(dst, b, h) do { _Pragma("unroll") for (int n = 0; n < 2; ++n) _Pragma("unroll") for (int k = 0; k < 2; ++k) dst[n][k] = *(const PG8_LAS bf16x8*)(lds + PG8_SB(b, h) + boff + n * 2048 + k * 1024); } while (0)
#define PG8_MMA(ai, bj, At, Bt) do { __builtin_amdgcn_s_setprio(1); _Pragma("unroll") for (int m = 0; m < 4; ++m) _Pragma("unroll") for (int n = 0; n < 2; ++n) _Pragma("unroll") for (int k = 0; k < 2; ++k) \
        acc[ai][bj][m][n] = __builtin_amdgcn_mfma_f32_16x16x32_bf16(Bt[n][k], At[m][k], acc[ai][bj][m][n], 0, 0, 0); __builtin_amdgcn_s_setprio(0); } while (0)
#define PG8_WAIT_V(n) asm volatile("s_waitcnt vmcnt(" #n ")" ::: "memory")
#define PG8_WAIT_L(n) asm volatile("s_waitcnt lgkmcnt(" #n ")" ::: "memory")
#define PG8_BAR __builtin_amdgcn_s_barrier()
#define PG8_SCHED __builtin_amdgcn_sched_barrier(0)
    Unit cur, nxt; int ui = 0;
    if (!S.next(0, cur)) return;
    f32x4 acc[2][2][4][2];
#pragma unroll
    for (int a = 0; a < 2; ++a)
#pragma unroll
        for (int b = 0; b < 2; ++b)
#pragma unroll
            for (int m = 0; m < 4; ++m)
#pragma unroll
                for (int n = 0; n < 2; ++n) acc[a][b][m][n] = (f32x4){0.f, 0.f, 0.f, 0.f};
    bf16x8 At[4][2], B0[2][2], B1[2][2];
    const char* cA = (const char*)g.A + (size_t)cur.pm * tstep; const char* cB = (const char*)g.Bt + (size_t)cur.pn * tstep;
    S.a_ready(cur);
    if constexpr (SP2) {
        PG8_STAGE(PG8_SB(0, 0), cB, voffB); PG8_STAGE(PG8_SB(0, 1), cB + hstep, voffB); PG8_STAGE(PG8_SA(0, 0), cA, voffA); PG8_STAGE(PG8_SA(0, 1), cA + hstep, voffA);
        if (wr == 1) PG8_BAR;
        PG8_WAIT_V(2); PG8_BAR;
        PG8_STAGE(PG8_SB(1, 0), cB + kstep, voffB); PG8_STAGE(PG8_SA(1, 0), cA + kstep, voffA); PG8_STAGE(PG8_SB(1, 1), cB + hstep + kstep, voffB);
        PG8_WAIT_V(6); PG8_BAR;
    } else {
        PG8_STAGE(PG8_SB(0, 0), cB, voffB); PG8_STAGE(PG8_SA(0, 0), cA, voffA); PG8_STAGE(PG8_SB(0, 1), cB + hstep, voffB); PG8_STAGE(PG8_SA(0, 1), cA + hstep, voffA);
        if (wr == 1) PG8_BAR;
        PG8_WAIT_V(4); PG8_BAR;
        PG8_STAGE(PG8_SB(1, 0), cB + kstep, voffB); PG8_STAGE(PG8_SA(1, 0), cA + kstep, voffA); PG8_STAGE(PG8_SB(1, 1), cB + hstep + kstep, voffB);
        PG8_WAIT_V(6); PG8_BAR;
    }
    for (;;) {
        const bool has_next = S.next(ui + 1, nxt);
        const bool nsec = Epi::CHAIN && ((ui + 1) & 1);
        const char* nA = has_next ? (const char*)(nsec ? g.A2 : g.A) + (size_t)nxt.pm * tstep : cA; const char* nB = has_next ? (const char*)(nsec ? g.Bt2 : g.Bt) + (size_t)nxt.pn * tstep : cB;
        for (int t = 0; t < nt; t += 2) {
            const bool last = (t == nt - 2);
            const char* a1 = cA + (size_t)(t + 1) * kstep;
            const char* a2 = last ? nA : cA + (size_t)(t + 2) * kstep; const char* b2 = last ? nB : cB + (size_t)(t + 2) * kstep;
            const char* a3 = a2 + kstep; const char* b3 = b2 + kstep;
            if (last && has_next) S.a_ready(nxt);
            if constexpr (SP2) {
            PG8_LDB(B0, 0, 0); PG8_LDB(B1, 0, 1); PG8_SCHED; PG8_LDA(At, 0, 0); PG8_STAGE(PG8_SA(1, 1), a1 + hstep, voffA);
            PG8_WAIT_V(8); PG8_WAIT_L(0); PG8_BAR; PG8_MMA(0, 0, At, B0); PG8_MMA(0, 1, At, B1); PG8_BAR; PG8_SCHED;
            PG8_LDA(At, 0, 1); PG8_STAGE(PG8_SB(0, 0), b2, voffB); PG8_STAGE(PG8_SB(0, 1), b2 + hstep, voffB); PG8_STAGE(PG8_SA(0, 0), a2, voffA);
            PG8_WAIT_V(8); PG8_WAIT_L(0); PG8_BAR; PG8_MMA(1, 0, At, B0); PG8_MMA(1, 1, At, B1); PG8_BAR; PG8_SCHED;
            PG8_LDB(B0, 1, 0); PG8_LDB(B1, 1, 1); PG8_SCHED; PG8_LDA(At, 1, 0); PG8_STAGE(PG8_SA(0, 1), a2 + hstep, voffA);
            PG8_WAIT_V(8); PG8_WAIT_L(0); PG8_BAR; PG8_MMA(0, 0, At, B0); PG8_MMA(0, 1, At, B1); PG8_BAR; PG8_SCHED;
            PG8_LDA(At, 1, 1); PG8_STAGE(PG8_SB(1, 0), b3, voffB); PG8_STAGE(PG8_SB(1, 1), b3 + hstep, voffB); PG8_STAGE(PG8_SA(1, 0), a3, voffA);
            PG8_WAIT_V(8); PG8_WAIT_L(0); PG8_BAR; PG8_MMA(1, 0, At, B0); PG8_MMA(1, 1, At, B1); PG8_BAR; PG8_SCHED;
            } else {
            PG8_LDB(B0, 0, 0); PG8_SCHED; PG8_LDA(At, 0, 0); PG8_STAGE(PG8_SA(1, 1), a1 + hstep, voffA);
            PG8_WAIT_L(8); PG8_BAR; PG8_WAIT_L(0); PG8_MMA(0, 0, At, B0); PG8_BAR; PG8_SCHED;
            PG8_LDB(B1, 0, 1); PG8_STAGE(PG8_SB(0, 0), b2, voffB);
            PG8_BAR; PG8_WAIT_L(0); PG8_MMA(0, 1, At, B1); PG8_BAR;
            PG8_LDA(At, 0, 1); PG8_STAGE(PG8_SA(0, 0), a2, voffA);
            PG8_BAR; PG8_WAIT_L(0); PG8_MMA(1, 0, At, B0); PG8_BAR; PG8_SCHED;
            PG8_STAGE(PG8_SB(0, 1), b2 + hstep, voffB);
            PG8_WAIT_V(6); PG8_BAR; PG8_MMA(1, 1, At, B1); PG8_BAR;
            PG8_LDB(B0, 1, 0); PG8_SCHED; PG8_LDA(At, 1, 0); PG8_STAGE(PG8_SA(0, 1), a2 + hstep, voffA);
            PG8_WAIT_L(8); PG8_BAR; PG8_WAIT_L(0); PG8_MMA(0, 0, At, B0); PG8_BAR; PG8_SCHED;
            PG8_LDB(B1, 1, 1); PG8_STAGE(PG8_SB(1, 0), b3, voffB);
            PG8_BAR; PG8_WAIT_L(0); PG8_MMA(0, 1, At, B1); PG8_BAR;
            PG8_LDA(At, 1, 1); PG8_STAGE(PG8_SA(1, 0), a3, voffA);
            PG8_BAR; PG8_WAIT_L(0); PG8_MMA(1, 0, At, B0); PG8_BAR; PG8_SCHED;
            PG8_STAGE(PG8_SB(1, 1), b3 + hstep, voffB);
            PG8_WAIT_V(6); PG8_BAR; PG8_MMA(1, 1, At, B1); PG8_BAR;
            }
        }
        if constexpr (ALIGN_EPI) { if (wr == 0) PG8_BAR; }
        if constexpr (Epi::CHAIN) { if ((ui & 1) == 0) E.mid(acc, cur, wr, wc, fr, fq); else E(acc, cur, wr, wc, fr, fq); }
        else if constexpr (!Epi::AFTER_DRAIN) { E(acc, cur, wr, wc, fr, fq); S.done(cur); }
        if (!has_next) break;
        if (!Epi::CHAIN || (ui & 1))
#pragma unroll
        for (int a = 0; a < 2; ++a)
#pragma unroll
            for (int b = 0; b < 2; ++b)
#pragma unroll
                for (int m = 0; m < 4; ++m)
#pragma unroll
                    for (int n = 0; n < 2; ++n) acc[a][b][m][n] = (f32x4){0.f, 0.f, 0.f, 0.f};
        cur = nxt; cA = nA; cB = nB; ++ui;
        if constexpr (ALIGN_EPI) { if (wr == 1) PG8_BAR; }
    }
    PG8_WAIT_V(0);
    if constexpr (!ALIGN_EPI) { if (wr == 0) PG8_BAR; }
    PG8_BAR;
    if constexpr (Epi::AFTER_DRAIN) { E.fused(acc, cur, wr, wc, fr, fq, lds, wid, lane); S.done(cur); }
#undef PG8_SA
#undef PG8_SB
#undef PG8_STAGE
#undef PG8_LDA
#undef PG8_LDB
#undef PG8_MMA
#undef PG8_WAIT_V
#undef PG8_WAIT_L
#undef PG8_BAR
#undef PG8_SCHED
}
}
#define GAS __attribute__((address_space(1)))
#define LAS __attribute__((address_space(3)))
typedef unsigned short bf16_t;
typedef unsigned v4u __attribute__((ext_vector_type(4)));
typedef float f32x4 __attribute__((ext_vector_type(4)));
typedef short bf16x8 __attribute__((ext_vector_type(8)));
#define LDS_WAIT() asm volatile("s_waitcnt lgkmcnt(0)" ::: "memory")
#define VM_WAIT() asm volatile("s_waitcnt vmcnt(0)" ::: "memory")
__device__ __forceinline__ float bf2f(bf16_t v) { return __uint_as_float((uint32_t)v << 16); }
__device__ __forceinline__ unsigned f2bf(float f) { unsigned u = __builtin_bit_cast(unsigned, f); return (u + 0x7fffu + ((u >> 16) & 1u)) >> 16; }
__device__ __forceinline__ unsigned pk2(float lo, float hi) { return f2bf(lo) | (f2bf(hi) << 16); }
#define DPP_F(s, ctrl) __builtin_bit_cast(float, __builtin_amdgcn_update_dpp(0, __builtin_bit_cast(int, s), ctrl, 0xF, 0xF, false))
__device__ __forceinline__ float sum32(float v) {
    v += DPP_F(v, 0xB1); v += DPP_F(v, 0x4E); v += DPP_F(v, 0x141); v += DPP_F(v, 0x140);
    v += __builtin_bit_cast(float, __builtin_amdgcn_ds_swizzle(__builtin_bit_cast(int, v), 0x401F));
    return v;
}
__device__ __forceinline__ float max32(float v) {
    v = fmaxf(v, DPP_F(v, 0xB1)); v = fmaxf(v, DPP_F(v, 0x4E)); v = fmaxf(v, DPP_F(v, 0x141)); v = fmaxf(v, DPP_F(v, 0x140));
    v = fmaxf(v, __builtin_bit_cast(float, __builtin_amdgcn_ds_swizzle(__builtin_bit_cast(int, v), 0x401F)));
    return v;
}
__device__ __forceinline__ float wave_sum(float v) {
    v = sum32(v);
    return __builtin_bit_cast(float, __builtin_amdgcn_readlane(__builtin_bit_cast(int, v), 0)) + __builtin_bit_cast(float, __builtin_amdgcn_readlane(__builtin_bit_cast(int, v), 32));
}
__device__ __forceinline__ float wave_max(float v) {
    v = max32(v);
    return fmaxf(__builtin_bit_cast(float, __builtin_amdgcn_readlane(__builtin_bit_cast(int, v), 0)), __builtin_bit_cast(float, __builtin_amdgcn_readlane(__builtin_bit_cast(int, v), 32)));
}
__device__ __forceinline__ float log_sigmoid(float f) {
    const float e = __builtin_amdgcn_exp2f(-fabsf(f) * 1.4426950408889634f);
    return fminf(f, 0.f) - __builtin_amdgcn_logf(1.0f + e) * 0.6931471805599453f;
}
__device__ __forceinline__ float bperm_f(int srclane, float v) { return __builtin_bit_cast(float, __builtin_amdgcn_ds_bpermute(srclane << 2, __builtin_bit_cast(int, v))); }
__device__ __forceinline__ int bperm_i(int srclane, int v) { return __builtin_amdgcn_ds_bpermute(srclane << 2, v); }
#define XB_TMO      128
#define XB_XCNT(j)  (256  + 64 * (j))
#define XB_XSUB(j)  (1280 + 64 * (j))
#define XB_XGEN(j)  (2304 + 64 * (j))
#define XB_TOP      3328
#define XB_TOPGEN   3392
#define XCD_BAR_WORDS 3456
#define XB_SPIN_CAP (1u << 24)

__device__ __forceinline__ unsigned xb_ld(unsigned* p)              { return __hip_atomic_load(p, __ATOMIC_RELAXED, __HIP_MEMORY_SCOPE_AGENT); }
__device__ __forceinline__ unsigned xb_add(unsigned* p, unsigned v) { return __hip_atomic_fetch_add(p, v, __ATOMIC_RELAXED, __HIP_MEMORY_SCOPE_AGENT); }
__device__ __forceinline__ unsigned xb_xcc_id() { return (unsigned)__builtin_amdgcn_s_getreg((3 << 11) | 20) & 0xFu; }
#define XB_SPIN(cond, bar) do { unsigned _sp = 0; while (cond) { __builtin_amdgcn_s_sleep(1); \
    if ((++_sp & 255u) == 0u) { if (xb_ld(&(bar)[XB_TMO])) break; if (_sp > XB_SPIN_CAP) { atomicAdd(&(bar)[XB_TMO], 1u); break; } } } } while (0)

struct XcdBarrier {
    unsigned* bar; unsigned x;
    volatile LAS unsigned* st;
};

__device__ __forceinline__ XcdBarrier xcd_barrier_post(unsigned* bar, volatile LAS unsigned* st, const int tid) {
    XcdBarrier b; b.bar = bar; b.x = xb_xcc_id(); b.st = st;
    if (tid == 0) (void)xb_add(&bar[XB_XCNT(b.x)], 1u);
    return b;
}
__device__ __forceinline__ void xcd_barrier_complete(unsigned* bar, unsigned x, unsigned& nloc, unsigned& nx) {
    const unsigned G = gridDim.x * gridDim.y * gridDim.z;
    unsigned sum, cnt, mine, sp = 0u;
    for (;;) {
        sum = 0u; cnt = 0u; mine = 0u;
#pragma unroll
        for (unsigned j = 0; j < 16; ++j) { const unsigned c = xb_ld(&bar[XB_XCNT(j)]); sum += c; cnt += (c > 0u) ? 1u : 0u; mine = (j == x) ? c : mine; }
        if (sum == G) break;
        __builtin_amdgcn_s_sleep(1);
        if ((++sp & 255u) == 0u) { if (xb_ld(&bar[XB_TMO])) break; if (sp > XB_SPIN_CAP) { atomicAdd(&bar[XB_TMO], 1u); break; } }
    }
    nloc = mine > 0u ? mine : 1u; nx = cnt > 0u ? cnt : 1u;
}

__device__ __forceinline__ void xcd_barrier(const XcdBarrier& b, const int tid) {
    asm volatile("s_waitcnt vmcnt(0)" ::: "memory");
    __syncthreads();
    if (tid == 0) {
        unsigned* bar = b.bar;
        __builtin_amdgcn_s_waitcnt(0);
        unsigned nloc = b.st[0], nx = b.st[1];
        if (nloc == 0u) { xcd_barrier_complete(bar, b.x, nloc, nx); b.st[0] = nloc; b.st[1] = nx; }
        const unsigned old = xb_add(&bar[XB_XSUB(b.x)], 1u);
        const unsigned gen = old / nloc;
        if (old + 1u == (gen + 1u) * nloc) {
            __builtin_amdgcn_fence(__ATOMIC_RELEASE, "agent");
            asm volatile("s_waitcnt vmcnt(0)" ::: "memory");
            const unsigned og = xb_add(&bar[XB_TOP], 1u);
            const unsigned tg = og / nx;
            __builtin_amdgcn_fence(__ATOMIC_ACQUIRE, "agent");
            if (og + 1u == (tg + 1u) * nx) xb_add(&bar[XB_TOPGEN], 1u);
            else XB_SPIN(xb_ld(&bar[XB_TOPGEN]) == tg, bar);
            xb_add(&bar[XB_XGEN(b.x)], 1u);
            asm volatile("s_waitcnt vmcnt(0)" ::: "memory");
        } else {
            __builtin_amdgcn_fence(__ATOMIC_ACQUIRE, "agent");
            XB_SPIN(xb_ld(&bar[XB_XGEN(b.x)]) == gen, bar);
            asm volatile("s_waitcnt vmcnt(0)" ::: "memory");
        }
    }
    __syncthreads();
}
constexpr int D = 1024, NB = 8, S = 2048, T = NB * S, DEPTH = 2, INW = 5128, NEXP = 16384;
constexpr int NPROJ = 5120;
constexpr float EPS = 1e-6f;
constexpr float LOG2E = 1.4426950408889634f;
constexpr float C2 = 0.125f * LOG2E;
constexpr int NWAVES = 8, NTHREADS = 512;
constexpr int LDS_BYTES = 147456;

constexpr size_t MiB = 1u << 20;
constexpr size_t WS_CTL = 0, CTL_ZERO_BYTES = 32 * 1024;
constexpr size_t WS_WIN = 1 * MiB;
constexpr size_t WS_WDO = 21 * MiB;
constexpr size_t WS_WFO = 23 * MiB;
constexpr size_t WS_WOUT = 25 * MiB;
constexpr size_t WS_WQ = 29 * MiB;
constexpr size_t WS_BT = 38 * MiB;
constexpr size_t WS_LOGF = 39 * MiB;
constexpr size_t WS_CUM = 39 * MiB + 512 * 1024;
constexpr size_t WS_EXP = 41 * MiB;
constexpr size_t WS_HN = 169 * MiB;
constexpr size_t WS_A = 201 * MiB;
constexpr size_t WS_MGT = WS_A, WS_MG = WS_A + 64 * MiB, WS_QP = WS_A;
constexpr size_t WS_SG = 297 * MiB;
constexpr size_t WS_SSP = 106 * MiB;
constexpr size_t WS_YD = 361 * MiB, WS_YF = 377 * MiB;
constexpr size_t WS_XR = 393 * MiB;
constexpr size_t WS_EXPI = 457 * MiB, WS_GATE = 465 * MiB;
constexpr size_t WS_END = 473 * MiB;
constexpr int CW_BAR = 4096;

struct Args {
    const float* in[16]; float* out; unsigned char* ws; int ph_lo, ph_hi;
};
struct Frame {
    LAS unsigned char* lds;
    int tid, lane, wave, gw, ngw, G, bid;
};
typedef __attribute__((address_space(4))) const unsigned char* kargp_t;
__device__ __forceinline__ kargp_t kargp() { kargp_t p = (kargp_t)__builtin_amdgcn_kernarg_segment_ptr(); asm volatile("" : "+s"(p)); return p; }
#define ARG_IN(i) (*(const float* const __attribute__((address_space(4)))*)(kargp() + 8 * (i)))
#define ARG_OUT   (*(float* const __attribute__((address_space(4)))*)(kargp() + 128))
#define ARG_WS    (*(unsigned char* const __attribute__((address_space(4)))*)(kargp() + 136))
#define ARG_PHLO  (*(const int __attribute__((address_space(4)))*)(kargp() + 144))
#define ARG_PHHI  (*(const int __attribute__((address_space(4)))*)(kargp() + 148))
static_assert(sizeof(Args) == 152, "kernarg layout: in[16] | out | ws | ph_lo | ph_hi");
template <class P> __device__ __forceinline__ P* opq(P* p) { asm volatile("" : "+s"(p)); return p; }

namespace pg8 {
struct EpiProj {
    static constexpr bool PERM = true, AFTER_DRAIN = false, CHAIN = false;
    bf16_t* qkv; bf16_t* sg;
    __device__ __forceinline__ void operator()(const f32x4 (&acc)[2][2][4][2], const Unit& u, int wr, int wc, int fr, int fq) const {
        const int row0 = u.pm * BM + wr * 64 + fr; const int ct = u.pn * BM;
        bf16_t* base; int ld, colt; bool sig; float sc = 1.f;
        if (ct < 3072) { const int t = ct >> 9; base = qkv + (size_t)t * T * 512; ld = 512; colt = ct & 511; sig = false; if (t == 0 || t == 3) sc = C2; }
        else { const int c2 = ct - 3072, t = c2 >> 10; base = sg + (size_t)t * T * 1024; ld = 1024; colt = c2 & 1023; sig = true; }
        const int col0 = colt + wc * 32 + 8 * fq;
#pragma unroll
        for (int ai = 0; ai < 2; ++ai)
#pragma unroll
            for (int m = 0; m < 4; ++m) { bf16_t* rowp = base + (size_t)(row0 + ai * HALF + m * 16) * ld + col0;
#pragma unroll
                for (int bj = 0; bj < 2; ++bj) { f32x4 v0 = acc[ai][bj][m][0], v1 = acc[ai][bj][m][1];
                    if (sig) {
#pragma unroll
                        for (int e = 0; e < 4; ++e) { v0[e] = __builtin_amdgcn_rcpf(1.0f + __builtin_amdgcn_exp2f(-LOG2E * v0[e])); v1[e] = __builtin_amdgcn_rcpf(1.0f + __builtin_amdgcn_exp2f(-LOG2E * v1[e])); }
                    } else { v0 = v0 * sc; v1 = v1 * sc; }
                    u32x4 w; w.x = cvt_pk_bf16(v0[0], v0[1]); w.y = cvt_pk_bf16(v0[2], v0[3]); w.z = cvt_pk_bf16(v1[0], v1[1]); w.w = cvt_pk_bf16(v1[2], v1[3]);
                    *(GAS u32x4*)(rowp + bj * HALF) = w; } }
    }
};
__device__ __forceinline__ void unpack8(const u32x4 w, float (&f)[8]) {
    f[0] = __uint_as_float(w.x << 16); f[1] = __uint_as_float(w.x & 0xffff0000u); f[2] = __uint_as_float(w.y << 16); f[3] = __uint_as_float(w.y & 0xffff0000u);
    f[4] = __uint_as_float(w.z << 16); f[5] = __uint_as_float(w.z & 0xffff0000u); f[6] = __uint_as_float(w.w << 16); f[7] = __uint_as_float(w.w & 0xffff0000u);
}
struct EpiMerge1 {
    static constexpr bool PERM = true, AFTER_DRAIN = false, CHAIN = false;
    const bf16_t* sga; bf16_t* tmp;
    __device__ __forceinline__ void operator()(const f32x4 (&acc)[2][2][4][2], const Unit& u, int wr, int wc, int fr, int fq) const {
        const int row0 = u.pm * BM + wr * 64 + fr, col0 = u.pn * BM + wc * 32 + 8 * fq;
        u32x4 gq[2][4][2];
#pragma unroll
        for (int ai = 0; ai < 2; ++ai)
#pragma unroll
            for (int m = 0; m < 4; ++m)
#pragma unroll
                for (int bj = 0; bj < 2; ++bj) gq[ai][m][bj] = *(const GAS u32x4*)(sga + (size_t)(row0 + ai * HALF + m * 16) * 1024 + col0 + bj * HALF);
#pragma unroll
        for (int ai = 0; ai < 2; ++ai)
#pragma unroll
            for (int m = 0; m < 4; ++m) { const size_t off = (size_t)(row0 + ai * HALF + m * 16) * 1024 + col0;
#pragma unroll
                for (int bj = 0; bj < 2; ++bj) { float g[8]; unpack8(gq[ai][m][bj], g);
                    const f32x4 v0 = acc[ai][bj][m][0], v1 = acc[ai][bj][m][1];
                    u32x4 w; w.x = cvt_pk_bf16(v0[0] * g[0], v0[1] * g[1]); w.y = cvt_pk_bf16(v0[2] * g[2], v0[3] * g[3]); w.z = cvt_pk_bf16(v1[0] * g[4], v1[1] * g[5]); w.w = cvt_pk_bf16(v1[2] * g[6], v1[3] * g[7]);
                    *(GAS u32x4*)(tmp + off + bj * HALF) = w; } }
    }
};
struct EpiMerge2 {
    static constexpr bool PERM = true, AFTER_DRAIN = false, CHAIN = false;
    const bf16_t* sgb; const bf16_t* tmp; bf16_t* mg;
    __device__ __forceinline__ void operator()(const f32x4 (&acc)[2][2][4][2], const Unit& u, int wr, int wc, int fr, int fq) const {
        const int row0 = u.pm * BM + wr * 64 + fr, col0 = u.pn * BM + wc * 32 + 8 * fq;
#pragma unroll
        for (int ai = 0; ai < 2; ++ai) {
            u32x4 gq[4][2], tq[4][2];
#pragma unroll
            for (int m = 0; m < 4; ++m)
#pragma unroll
                for (int bj = 0; bj < 2; ++bj) { const size_t o_ = (size_t)(row0 + ai * HALF + m * 16) * 1024 + col0 + bj * HALF; gq[m][bj] = *(const GAS u32x4*)(sgb + o_); tq[m][bj] = *(const GAS u32x4*)(tmp + o_); }
#pragma unroll
            for (int m = 0; m < 4; ++m) { const size_t off = (size_t)(row0 + ai * HALF + m * 16) * 1024 + col0;
#pragma unroll
                for (int bj = 0; bj < 2; ++bj) { float g[8], t[8]; unpack8(gq[m][bj], g); unpack8(tq[m][bj], t);
                    const f32x4 a0 = acc[ai][bj][m][0], a1 = acc[ai][bj][m][1];
                    u32x4 w; w.x = cvt_pk_bf16(t[0] + g[0] * a0[0], t[1] + g[1] * a0[1]); w.y = cvt_pk_bf16(t[2] + g[2] * a0[2], t[3] + g[3] * a0[3]);
                    w.z = cvt_pk_bf16(t[4] + g[4] * a1[0], t[5] + g[5] * a1[1]); w.w = cvt_pk_bf16(t[6] + g[6] * a1[2], t[7] + g[7] * a1[3]);
                    *(GAS u32x4*)(mg + off + bj * HALF) = w; } } }
    }
};
struct EpiMergeC {
    static constexpr bool PERM = true, AFTER_DRAIN = false, CHAIN = true;
    const bf16_t* sga; const bf16_t* sgb; bf16_t* mg;
    __device__ __forceinline__ void mid(f32x4 (&acc)[2][2][4][2], const Unit& u, int wr, int wc, int fr, int fq) const {
        const int row0 = u.pm * BM + wr * 64 + fr, col0 = u.pn * BM + wc * 32 + 8 * fq;
#pragma unroll
        for (int ai = 0; ai < 2; ++ai) {
            u32x4 gq[4][2], hq[4][2];
#pragma unroll
            for (int m = 0; m < 4; ++m)
#pragma unroll
                for (int bj = 0; bj < 2; ++bj) { const size_t o_ = (size_t)(row0 + ai * HALF + m * 16) * 1024 + col0 + bj * HALF; gq[m][bj] = *(const GAS u32x4*)(sga + o_); hq[m][bj] = *(const GAS u32x4*)(sgb + o_); }
#pragma unroll
            for (int m = 0; m < 4; ++m)
#pragma unroll
                for (int bj = 0; bj < 2; ++bj) { float g[8], h[8]; unpack8(gq[m][bj], g); unpack8(hq[m][bj], h);
#pragma unroll
                    for (int i = 0; i < 8; ++i) g[i] *= __builtin_amdgcn_rcpf(fmaxf(h[i], 7.8886090522101181e-31f));
                    acc[ai][bj][m][0] = acc[ai][bj][m][0] * (f32x4){g[0], g[1], g[2], g[3]}; acc[ai][bj][m][1] = acc[ai][bj][m][1] * (f32x4){g[4], g[5], g[6], g[7]}; }
        }
    }
    __device__ __forceinline__ void operator()(const f32x4 (&acc)[2][2][4][2], const Unit& u, int wr, int wc, int fr, int fq) const {
        const int row0 = u.pm * BM + wr * 64 + fr, col0 = u.pn * BM + wc * 32 + 8 * fq;
        u32x4 hq[2][4][2];
#pragma unroll
        for (int ai = 0; ai < 2; ++ai)
#pragma unroll
            for (int m = 0; m < 4; ++m)
#pragma unroll
                for (int bj = 0; bj < 2; ++bj) hq[ai][m][bj] = *(const GAS u32x4*)(sgb + (size_t)(row0 + ai * HALF + m * 16) * 1024 + col0 + bj * HALF);
#pragma unroll
        for (int ai = 0; ai < 2; ++ai)
#pragma unroll
            for (int m = 0; m < 4; ++m) { const size_t off = (size_t)(row0 + ai * HALF + m * 16) * 1024 + col0;
#pragma unroll
                for (int bj = 0; bj < 2; ++bj) { float h[8]; unpack8(hq[ai][m][bj], h);
#pragma unroll
                    for (int i = 0; i < 8; ++i) h[i] = fmaxf(h[i], 7.8886090522101181e-31f);
                    const f32x4 v0 = acc[ai][bj][m][0], v1 = acc[ai][bj][m][1];
                    u32x4 w; w.x = cvt_pk_bf16(v0[0] * h[0], v0[1] * h[1]); w.y = cvt_pk_bf16(v0[2] * h[2], v0[3] * h[3]); w.z = cvt_pk_bf16(v1[0] * h[4], v1[1] * h[5]); w.w = cvt_pk_bf16(v1[2] * h[6], v1[3] * h[7]);
                    *(GAS u32x4*)(mg + off + bj * HALF) = w; } }
    }
};
template <bool XBF>
struct EpiResidSS {
    static constexpr bool PERM = true, AFTER_DRAIN = false, CHAIN = false;
    const void* xin; bf16_t* xb; float* ssp;
    __device__ __forceinline__ void operator()(const f32x4 (&acc)[2][2][4][2], const Unit& u, int wr, int wc, int fr, int fq) const {
        const int row0 = u.pm * BM + wr * 64 + fr, col0 = u.pn * BM + wc * 32 + 8 * fq;
#pragma unroll
        for (int ai = 0; ai < 2; ++ai) {
            f32x4 xq[4][2][2];
#pragma unroll
            for (int m = 0; m < 4; ++m)
#pragma unroll
                for (int bj = 0; bj < 2; ++bj) { const size_t o_ = (size_t)(row0 + ai * HALF + m * 16) * 1024 + col0 + bj * HALF;
                    if constexpr (XBF) { const u32x4 w_ = *(const GAS u32x4*)((const bf16_t*)xin + o_);
                        xq[m][bj][0][0] = __builtin_bit_cast(float, w_.x << 16); xq[m][bj][0][1] = __builtin_bit_cast(float, w_.x & 0xffff0000u);
                        xq[m][bj][0][2] = __builtin_bit_cast(float, w_.y << 16); xq[m][bj][0][3] = __builtin_bit_cast(float, w_.y & 0xffff0000u);
                        xq[m][bj][1][0] = __builtin_bit_cast(float, w_.z << 16); xq[m][bj][1][1] = __builtin_bit_cast(float, w_.z & 0xffff0000u);
                        xq[m][bj][1][2] = __builtin_bit_cast(float, w_.w << 16); xq[m][bj][1][3] = __builtin_bit_cast(float, w_.w & 0xffff0000u); }
                    else { const GAS f32x4* xp_ = (const GAS f32x4*)((const float*)xin + o_); xq[m][bj][0] = xp_[0]; xq[m][bj][1] = xp_[1]; } }
#pragma unroll
            for (int m = 0; m < 4; ++m) { const int row = row0 + ai * HALF + m * 16; const size_t off = (size_t)row * 1024 + col0; float s = 0.f;
#pragma unroll
                for (int bj = 0; bj < 2; ++bj) {
                    const f32x4 v0 = xq[m][bj][0] + acc[ai][bj][m][0], v1 = xq[m][bj][1] + acc[ai][bj][m][1];
                    u32x4 w; w.x = cvt_pk_bf16(v0[0], v0[1]); w.y = cvt_pk_bf16(v0[2], v0[3]); w.z = cvt_pk_bf16(v1[0], v1[1]); w.w = cvt_pk_bf16(v1[2], v1[3]);
                    *(GAS u32x4*)(xb + off + bj * HALF) = w;
                    s += ((v0[0] * v0[0] + v0[1] * v0[1]) + (v0[2] * v0[2] + v0[3] * v0[3])) + ((v1[0] * v1[0] + v1[1] * v1[1]) + (v1[2] * v1[2] + v1[3] * v1[3])); }
                s += __builtin_bit_cast(float, __builtin_amdgcn_ds_swizzle(__builtin_bit_cast(int, s), 0x401F));
                { auto rr = __builtin_amdgcn_permlane32_swap(__builtin_bit_cast(unsigned, s), __builtin_bit_cast(unsigned, s), false, false); s = __builtin_bit_cast(float, rr[0]) + __builtin_bit_cast(float, rr[1]); }
                if (fq == 0) ((GAS float*)ssp)[(size_t)row * 16 + u.pn * 4 + wc] = s; } }
    }
};
struct EpiQP {
    static constexpr bool PERM = true, AFTER_DRAIN = false, CHAIN = false;
    bf16_t* qp; const PG8_LAS float* rsl; int pm0;
    __device__ __forceinline__ void operator()(const f32x4 (&acc)[2][2][4][2], const Unit& u, int wr, int wc, int fr, int fq) const {
        const int rl0 = wr * 64 + fr, col0 = u.pn * BM + wc * 32 + 8 * fq;
        const PG8_LAS float* rs_ = rsl + (u.pm == pm0 ? 0 : 256);
#pragma unroll
        for (int ai = 0; ai < 2; ++ai)
#pragma unroll
            for (int m = 0; m < 4; ++m) { const int rl = rl0 + ai * HALF + m * 16;
                const float rs = rs_[rl];
                bf16_t* rowp = qp + (size_t)(u.pm * BM + rl) * 2048 + col0;
#pragma unroll
                for (int bj = 0; bj < 2; ++bj) { const f32x4 v0 = acc[ai][bj][m][0] * rs, v1 = acc[ai][bj][m][1] * rs;
                    u32x4 w; w.x = cvt_pk_bf16(v0[0], v0[1]); w.y = cvt_pk_bf16(v0[2], v0[3]); w.z = cvt_pk_bf16(v1[0], v1[1]); w.w = cvt_pk_bf16(v1[2], v1[3]);
                    *(GAS u32x4*)(rowp + bj * HALF) = w; } }
    }
};
}

__device__ __forceinline__ void p0_transpose_item(const float* W, int ldw, int K, int Nd, int skip_from, int skip, bf16_t* WT, LAS float* scr, int item, int lane, const float* kscale = nullptr) {
    const int nblk = Nd / 32, kb = item / nblk, nb = item % nblk, k0 = 64 * kb, n0 = 32 * nb;
    const int s0 = n0 + (n0 >= skip_from ? skip : 0);
    float wv_[32];
    const GAS float* Wg = (const GAS float*)W + (size_t)(k0 + (lane >> 5)) * ldw + s0 + (lane & 31);
#pragma unroll
    for (int i = 0; i < 32; ++i) wv_[i] = Wg[(size_t)(2 * i) * ldw];
    if (kscale) {
        const GAS float* ks = (const GAS float*)kscale + k0 + (lane >> 5);
#pragma unroll
        for (int i = 0; i < 32; ++i) wv_[i] *= ks[2 * i];
    }
#pragma unroll
    for (int i = 0; i < 32; ++i) scr[(2 * i + (lane >> 5)) * 33 + (lane & 31)] = wv_[i];
    LDS_WAIT(); asm volatile("" ::: "memory");
    const int c = lane & 7;
#pragma unroll
    for (int j = 0; j < 4; ++j) { const int n = (lane >> 3) + 8 * j; const LAS float* s = scr + (8 * c) * 33 + n;
        v4u o; o.x = pk2(s[0 * 33], s[1 * 33]); o.y = pk2(s[2 * 33], s[3 * 33]); o.z = pk2(s[4 * 33], s[5 * 33]); o.w = pk2(s[6 * 33], s[7 * 33]);
        *(GAS v4u*)(WT + (size_t)(n0 + n) * K + k0 + 8 * c) = o; }
    LDS_WAIT(); asm volatile("" ::: "memory");
}
__device__ __forceinline__ void ph_prologue(Frame& F) {
    unsigned char* ws = ARG_WS;
    LAS float* scr = (LAS float*)(F.lds + F.wave * 16384);
    constexpr int I_IN = (D / 64) * (NPROJ / 32), I_DO = (512 / 64) * (D / 32), I_OUT = (D / 64) * (D / 32), I_Q = (D / 64) * (2048 / 32);
    constexpr int PER_L = I_IN + 2 * I_DO + I_OUT + I_Q;
    for (int it = F.gw; it < DEPTH * PER_L; it += F.ngw) {
        const int l = it / PER_L; int r = it % PER_L;
        if (r < I_IN) { p0_transpose_item(ARG_IN(2) + (size_t)l * D * INW, INW, D, NPROJ, 3072, 8, (bf16_t*)(ws + WS_WIN + (size_t)l * 10 * MiB), scr, r, F.lane); continue; } r -= I_IN;
        if (r < I_DO) { p0_transpose_item(ARG_IN(6) + (size_t)l * 512 * D, D, 512, D, 1 << 30, 0, (bf16_t*)(ws + WS_WDO + (size_t)l * MiB), scr, r, F.lane); continue; } r -= I_DO;
        if (r < I_DO) { p0_transpose_item(ARG_IN(7) + (size_t)l * 512 * D, D, 512, D, 1 << 30, 0, (bf16_t*)(ws + WS_WFO + (size_t)l * MiB), scr, r, F.lane); continue; } r -= I_DO;
        if (r < I_OUT) { p0_transpose_item(ARG_IN(8) + (size_t)l * D * D, D, D, D, 1 << 30, 0, (bf16_t*)(ws + WS_WOUT + (size_t)l * 2 * MiB), scr, r, F.lane); continue; } r -= I_OUT;
        p0_transpose_item(ARG_IN(10) + (size_t)l * D * 2048, 2048, D, 2048, 1 << 30, 0, (bf16_t*)(ws + WS_WQ + (size_t)l * 4 * MiB), scr, r, F.lane, ARG_IN(9) + l * D);
    }
    if (F.bid == 0) {
        float* tab = (float*)(ws + WS_BT); const float* rel_bias = ARG_IN(14);
        for (int i = F.tid; i < 4 * 129; i += NTHREADS) {
            const int h = i / 129, d = i % 129; int bucket;
            if (d < 16) bucket = d;
            else { const int large = 16 + (int)(logf((float)d / 16.0f) / 2.0794415416798357f * 16.0f); bucket = large < 31 ? large : 31; }
            tab[i] = rel_bias[bucket * 4 + h] * LOG2E;
        }
    }
}

__device__ __forceinline__ void ph_rmsnorm(Frame& F, const float* xp_, const float* gp_, bf16_t* outp_, const float* wffp_, const float* bfgp_, float* logfp_) {
    const int lane = F.lane;
    const GAS float* x = (const GAS float*)xp_; const GAS f32x4* gr = (const GAS f32x4*)gp_; GAS bf16_t* out = (GAS bf16_t*)outp_;
    const GAS float* wff = (const GAS float*)wffp_; const GAS float* bfg = (const GAS float*)bfgp_; GAS float* logf = (GAS float*)logfp_;
    LAS float* wl = (LAS float*)F.lds;
    for (int k = F.tid; k < D; k += NTHREADS) {
        const f32x4 w0 = *(const GAS f32x4*)(wff + (size_t)k * INW + 3072), w1 = *(const GAS f32x4*)(wff + (size_t)k * INW + 3076);
        wl[0 * D + k] = w0[0]; wl[1 * D + k] = w0[1]; wl[2 * D + k] = w0[2]; wl[3 * D + k] = w0[3]; wl[4 * D + k] = w1[0]; wl[5 * D + k] = w1[1]; wl[6 * D + k] = w1[2]; wl[7 * D + k] = w1[3];
    }
    __syncthreads();
    f32x4 nx[4];
    if (F.gw < T) {
#pragma unroll
        for (int j = 0; j < 4; ++j) nx[j] = ((const GAS f32x4*)(x + (size_t)F.gw * D))[j * 64 + lane];
    }
    for (int row = F.gw; row < T; row += F.ngw) {
        f32x4 v[4]; float ss = 0.f;
#pragma unroll
        for (int j = 0; j < 4; ++j) { v[j] = nx[j]; ss += (v[j][0] * v[j][0] + v[j][1] * v[j][1]) + (v[j][2] * v[j][2] + v[j][3] * v[j][3]); }
        if (row + F.ngw < T) {
#pragma unroll
            for (int j = 0; j < 4; ++j) nx[j] = ((const GAS f32x4*)(x + (size_t)(row + F.ngw) * D))[j * 64 + lane];
        }
        ss = wave_sum(ss);
        const float rs = rsqrtf(ss * (1.0f / D) + EPS);
#pragma unroll
        for (int j = 0; j < 4; ++j) v[j] = v[j] * gr[j * 64 + lane] * rs;
#pragma unroll
        for (int j = 0; j < 4; ++j) { typedef unsigned u32x2_ __attribute__((ext_vector_type(2))); u32x2_ o; o[0] = pk2(v[j][0], v[j][1]); o[1] = pk2(v[j][2], v[j][3]); *(GAS u32x2_*)(out + (size_t)row * D + (j * 64 + lane) * 4) = o; }
        float a[8];
#pragma unroll
        for (int hh = 0; hh < 8; ++hh) { float s = 0.f;
#pragma unroll
            for (int j = 0; j < 4; ++j) { const f32x4 w = *(const LAS f32x4*)(wl + hh * D + (j * 64 + lane) * 4); s += (v[j][0] * w[0] + v[j][1] * w[1]) + (v[j][2] * w[2] + v[j][3] * w[3]); }
            a[hh] = wave_sum(s); }
        if (lane < 8) {
            float f = lane == 0 ? a[0] : lane == 1 ? a[1] : lane == 2 ? a[2] : lane == 3 ? a[3] : lane == 4 ? a[4] : lane == 5 ? a[5] : lane == 6 ? a[6] : a[7];
            f += bfg[lane];
            logf[(size_t)row * 8 + lane] = log_sigmoid(f);
        }
    }
    __syncthreads();
}
__device__ __forceinline__ void ph_cumsum(Frame& F, const float* logfp_, float* cump_) {
    const int lane = F.lane, w = F.wave;
    const GAS float* logf = (const GAS float*)logfp_; GAS float* cum = (GAS float*)cump_;
    LAS float* tot = (LAS float*)F.lds;
    for (int b = F.bid; b < NB; b += F.G) {
        const int t0 = w * 256 + lane * 4;
        f32x4 x[4][2];
#pragma unroll
        for (int i = 0; i < 4; ++i) { const GAS f32x4* p_ = (const GAS f32x4*)(logf + ((size_t)(b * S + t0 + i)) * 8); x[i][0] = p_[0]; x[i][1] = p_[1]; }
        float v[8][4], inc[8];
#pragma unroll
        for (int hh = 0; hh < 8; ++hh) {
            v[hh][0] = x[0][hh >> 2][hh & 3];
#pragma unroll
            for (int i = 1; i < 4; ++i) v[hh][i] = v[hh][i - 1] + x[i][hh >> 2][hh & 3];
            float t = v[hh][3];
#pragma unroll
            for (int o = 1; o < 64; o <<= 1) { const float n = bperm_f(lane - o, t); if (lane >= o) t += n; }
            inc[hh] = t;
        }
        if (lane == 63) {
#pragma unroll
            for (int hh = 0; hh < 8; ++hh) tot[w * 8 + hh] = inc[hh];
        }
        __syncthreads();
#pragma unroll
        for (int hh = 0; hh < 8; ++hh) {
            float base = inc[hh] - v[hh][3];
#pragma unroll
            for (int ww = 0; ww < 7; ++ww) base += (ww < w) ? tot[ww * 8 + hh] : 0.f;
            const f32x4 o4 = {(v[hh][0] + base) * LOG2E, (v[hh][1] + base) * LOG2E, (v[hh][2] + base) * LOG2E, (v[hh][3] + base) * LOG2E};
            *(GAS f32x4*)(cum + ((size_t)(b * 8 + hh)) * S + t0) = o4;
        }
        __syncthreads();
    }
}
namespace att {
typedef float f32x16 __attribute__((ext_vector_type(16)));
typedef short s16x4 __attribute__((ext_vector_type(4)));
typedef short v4i16_t __attribute__((ext_vector_type(4)));
typedef unsigned u32x4 __attribute__((ext_vector_type(4)));
typedef float f32x2_t __attribute__((ext_vector_type(2))); typedef __bf16 bf16x2_t __attribute__((ext_vector_type(2)));
__device__ __forceinline__ int crow(int r, int hi) { return (r & 3) + 8 * (r >> 2) + 4 * hi; }
__device__ __forceinline__ unsigned cvtpk(float lo, float hi) { f32x2_t v = {lo, hi}; bf16x2_t b = __builtin_convertvector(v, bf16x2_t); return __builtin_bit_cast(unsigned, b); }
__device__ __forceinline__ void glds16(const void* gsrc, unsigned lds_dst) { unsigned keep;
    asm volatile("s_mov_b32 %0, m0\n\ts_mov_b32 m0, %2\n\ts_nop 0\n\tglobal_load_lds_dwordx4 %1, off\n\ts_mov_b32 m0, %0" : "=&s"(keep) : "v"(gsrc), "s"(lds_dst) : "memory"); }
__device__ __forceinline__ void glds16s(const void* gbase  , unsigned voff, unsigned lds_dst) { unsigned keep;
    asm volatile("s_mov_b32 %0, m0\n\ts_mov_b32 m0, %3\n\ts_nop 0\n\tglobal_load_lds_dwordx4 %1, %2\n\ts_mov_b32 m0, %0" : "=&s"(keep) : "v"(voff), "s"(gbase), "s"(lds_dst) : "memory"); }
#define ATT_WAIT_BAR() asm volatile("s_waitcnt vmcnt(0) lgkmcnt(0)\n\ts_barrier" ::: "memory")
#define ATT_MFMA(a, b, c) __builtin_amdgcn_mfma_f32_32x32x16_bf16(a, b, c, 0, 0, 0)
__device__ __forceinline__ s16x4 vtr(const LAS unsigned char* p) { return __builtin_bit_cast(s16x4, __builtin_amdgcn_ds_read_tr16_b64_v4i16((LAS v4i16_t*)p)); }
#define FX_SBAR() __builtin_amdgcn_sched_barrier(0)
#define FX_PIN(x) asm volatile("" : "+v"(x))
#define FX_WAIT_BAR(N) asm volatile("s_waitcnt vmcnt(" #N ") lgkmcnt(0)\n\ts_barrier" ::: "memory")
#define FX_MX3(a, b, c) __builtin_fmaxf(__builtin_fmaxf((a), (b)), (c))
__device__ __forceinline__ unsigned fx_cvtpk(float lo, float hi) { unsigned r; asm("v_cvt_pk_bf16_f32 %0, %1, %2" : "=v"(r) : "v"(lo), "v"(hi)); return r; }
__device__ __forceinline__ float fx_rowmax(const f32x16& p0, const f32x16& p1) {
    float a = FX_MX3(p0[0], p0[1], p1[0]), b = FX_MX3(p0[2], p0[3], p1[1]); a = FX_MX3(a, p1[2], p1[3]);
#pragma unroll
    for (int r = 4; r < 16; r += 4) { a = FX_MX3(a, p0[r], p0[r + 1]); b = FX_MX3(b, p0[r + 2], p0[r + 3]); a = FX_MX3(a, p1[r], p1[r + 1]); b = FX_MX3(b, p1[r + 2], p1[r + 3]); }
    float m = __builtin_fmaxf(a, b); auto rr = __builtin_amdgcn_permlane32_swap(__float_as_uint(m), __float_as_uint(m), false, false);
    return __builtin_fmaxf(__uint_as_float(rr[0]), __uint_as_float(rr[1])); }
__device__ __forceinline__ void fx_cmask(f32x16& p0, f32x16& p1, int jb, int qrel, int hi) {
    const int kb = 64 * jb + 4 * hi;
#pragma unroll
    for (int r = 0; r < 16; ++r) { const int kv = kb + (r & 3) + 8 * (r >> 2); if (kv > qrel) p0[r] = -INFINITY; if (kv + 32 > qrel) p1[r] = -INFINITY; } }

__device__ __forceinline__ void fox_unit(LAS unsigned char* lds, int tid, int b, int h, int qb, const bf16_t* Q, const bf16_t* K, const bf16_t* V, bf16_t* Y, const float* cum) {
    constexpr int QB = 256, SLOTB = 8192, LDS_K = 0, LDS_V = 3 * SLOTB, LDS_WS = 6 * SLOTB, LDS_TAB = LDS_WS + 2048, LDS_OST = LDS_TAB + 8192;
    constexpr float FTHR = 40.0f;
    int tid_ = tid; asm volatile("" : "+v"(tid_));
    const int lane = tid_ & 63, r32 = lane & 31, hi = lane >> 5, wid = __builtin_amdgcn_readfirstlane(tid_ >> 6);
    const int q0 = qb * QB, NT = (q0 + QB) / 64;
    const size_t rowbase = (size_t)b * S;
    const int hcol = h * 64;
    const bf16_t* Qw = Q + (rowbase + q0 + wid * 32) * 512 + hcol;
    const bf16_t* Kh = K + rowbase * 512 + hcol;
    const bf16_t* Vh = V + rowbase * 512 + hcol;
    const unsigned lds0 = (unsigned)(uintptr_t)lds;
    LAS float* wsf = (LAS float*)(lds + LDS_WS) + wid * 64;
    LAS float* tab = (LAS float*)(lds + LDS_TAB);
    const int qrel = wid * 32 + r32, qpos = q0 + qrel;
    const GAS float* cumg = (const GAS float*)cum;
    const unsigned koff = (unsigned)(((8 * wid + (lane & 7)) * 512 + (lane >> 3) * 8) * 2);
    const int vrow = lane >> 3, vslot = lane & 7;
    const int vchunk = (((vslot >> 2) ^ ((vrow >> 1) & 1)) << 2) | (vslot & 3);
    const unsigned voff = (unsigned)(((8 * wid + vrow) * 512 + vchunk * 8) * 2);
    const unsigned kdst = lds0 + LDS_K + wid * 1024, vdst = lds0 + LDS_V + wid * 1024;
#define FX_DMA_K(t, slot) glds16s(Kh + (size_t)(t) * 64 * 512, koff, (unsigned)__builtin_amdgcn_readfirstlane(kdst + (slot)))
#define FX_DMA_V(t, slot) glds16s(Vh + (size_t)(t) * 64 * 512, voff, (unsigned)__builtin_amdgcn_readfirstlane(vdst + (slot)))
    const int vq = (lane & 15) >> 2;
    const LAS unsigned char* vp0 = lds + LDS_V + ((lane >> 4) & 1) * 32 + (lane & 3) * 8 + (4 * hi + vq) * 128;
    const int vsw0 = ((vq >> 1) & 1) * 64, vsw1 = vsw0 ^ 64;
    const LAS unsigned char* kp0 = lds + LDS_K + (r32 >> 3) * 1024 + (r32 & 7) * 16 + hi * 128;
    const LAS float* cp0 = tab + 4 * hi;
    FX_DMA_K(0, 0); FX_DMA_V(0, 0); FX_DMA_K(1, SLOTB); FX_DMA_K(2, 2 * SLOTB);
    if (tid_ * 4 < q0 + QB) { const f32x4 c4 = ((const GAS f32x4*)cumg)[tid_]; ((LAS f32x4*)tab)[tid_] = (f32x4){-c4[0], -c4[1], -c4[2], -c4[3]}; }
    bf16x8 qr[4];
#pragma unroll
    for (int d0 = 0; d0 < 4; ++d0) qr[d0] = *(const GAS bf16x8*)(Qw + (size_t)r32 * 512 + d0 * 16 + hi * 8);
    float cq = cumg[qpos];
    asm volatile("" : "+v"(qr[0]), "+v"(qr[1]), "+v"(qr[2]), "+v"(qr[3]), "+v"(cq));
    float mhat = 0.f; f32x16 o[2]; o[0] = f32x16{}; o[1] = f32x16{};
    f32x16 osum = f32x16{};
    const u32x4 onesw = {0x3F803F80u, 0x3F803F80u, 0x3F803F80u, 0x3F803F80u};
    const bf16x8 ones = __builtin_bit_cast(bf16x8, onesw);
    bool resc = false;
    f32x16 pA0, pA1, pB0, pB1; bf16x8 kf[8]; s16x4 vlo[8], vhi[8]; u32x4 pw0, pw1, pw2, pw3;
    int sl_prev = 0, sl_cur = 0, sl_next = SLOTB;
#define FX_ROT() do { sl_prev = sl_cur; sl_cur = sl_next; sl_next = (sl_next == 2 * SLOTB) ? 0 : sl_next + SLOTB; } while (0)
#define FX_EX(v) __builtin_amdgcn_exp2f((v) + nmh)
#define FX_RESC() do { if (resc) { _Pragma("unroll") for (int g_ = 0; g_ < 4; ++g_) { const f32x4 a4 = *(const LAS f32x4*)(wsf + 8 * g_ + 4 * hi); \
        _Pragma("unroll") for (int d_ = 0; d_ < 2; ++d_) { o[d_][4 * g_] *= a4[0]; o[d_][4 * g_ + 1] *= a4[1]; o[d_][4 * g_ + 2] *= a4[2]; o[d_][4 * g_ + 3] *= a4[3]; } \
        osum[4 * g_] *= a4[0]; osum[4 * g_ + 1] *= a4[1]; osum[4 * g_ + 2] *= a4[2]; osum[4 * g_ + 3] *= a4[3]; } } } while (0)
#define FX_KLOAD2(kp, d0) do { kf[2 * (d0)] = *(const LAS bf16x8*)((kp) + (d0) * 256); kf[2 * (d0) + 1] = *(const LAS bf16x8*)((kp) + (d0) * 256 + 4096); } while (0)
#define FX_CLOAD(X0, X1, cp, g) do { const f32x4 c0_ = *(const LAS f32x4*)((cp) + 8 * (g)), c1_ = *(const LAS f32x4*)((cp) + 32 + 8 * (g)); \
        X0[4 * (g)] = c0_[0]; X0[4 * (g) + 1] = c0_[1]; X0[4 * (g) + 2] = c0_[2]; X0[4 * (g) + 3] = c0_[3]; X1[4 * (g)] = c1_[0]; X1[4 * (g) + 1] = c1_[1]; X1[4 * (g) + 2] = c1_[2]; X1[4 * (g) + 3] = c1_[3]; } while (0)
    FX_WAIT_BAR(3);
#pragma unroll
    for (int d0 = 0; d0 < 4; ++d0) FX_KLOAD2(kp0, d0);
#pragma unroll
    for (int g = 0; g < 4; ++g) FX_CLOAD(pA0, pA1, cp0, g);
    pA0 = ATT_MFMA(kf[0], qr[0], pA0); pA1 = ATT_MFMA(kf[1], qr[0], pA1); pA0 = ATT_MFMA(kf[2], qr[1], pA0); pA1 = ATT_MFMA(kf[3], qr[1], pA1);
    pA0 = ATT_MFMA(kf[4], qr[2], pA0); pA1 = ATT_MFMA(kf[5], qr[2], pA1); pA0 = ATT_MFMA(kf[6], qr[3], pA0); pA1 = ATT_MFMA(kf[7], qr[3], pA1);
    if (NT == 4) fx_cmask(pA0, pA1, 0, qrel, hi);
    { const float rm = fx_rowmax(pA0, pA1); mhat = rm + cq; const float nmh = cq - mhat;
#pragma unroll
      for (int r = 0; r < 16; ++r) { pA0[r] = FX_EX(pA0[r]); pA1[r] = FX_EX(pA1[r]); } }
    FX_WAIT_BAR(0);
    FX_DMA_K(3, 0); FX_DMA_V(1, SLOTB); FX_ROT();
#pragma unroll
    for (int d0 = 0; d0 < 4; ++d0) FX_KLOAD2(kp0 + sl_cur, d0);
#pragma unroll
    for (int g = 0; g < 4; ++g) FX_CLOAD(pB0, pB1, cp0 + 64, g);
    FX_WAIT_BAR(2);
#define FX_PKW(P, i) fx_cvtpk(P[i], P[i + 1])
#define FX_PAF(k) __builtin_bit_cast(bf16x8, pw##k)
#define FX_VFR(i) (bf16x8){vlo[i][0], vlo[i][1], vlo[i][2], vlo[i][3], vhi[i][0], vhi[i][1], vhi[i][2], vhi[i][3]}
#define FX_VRD(i) do { vlo[i] = vtr(vp_ + ((((i) >> 2) ? vsw1 : vsw0) + ((i) & 3) * 2048)); vhi[i] = vtr(vp_ + ((((i) >> 2) ? vsw1 : vsw0) + ((i) & 3) * 2048 + 1024)); } while (0)
#define FX_KRD(G, d0) do { if (G) { FX_KLOAD2(kp0 + sl_next, d0); FX_SBAR(); } } while (0)
#define FX_CRD(G, X0, X1, t, g) do { if (G) { FX_CLOAD(X0, X1, cp0 + 64 * ((t) + 1), g); FX_SBAR(); } } while (0)
#define FX_GAPA(MF, a0, a1, a2, a3, W0, W1, PW) do { MF; W0; W1; FX_PIN(PW); FX_SBAR(); } while (0)
#define FX_GAPB(MF, X, i) do { MF; X[i] = FX_EX(X[i]); X[i + 1] = FX_EX(X[i + 1]); X[i + 2] = FX_EX(X[i + 2]); X[i + 3] = FX_EX(X[i + 3]); FX_PIN(X); FX_SBAR(); } while (0)
#define FX_STEP(C0, C1, P0, P1, t, MASK, GK, GV, GL) do { FX_SBAR(); \
    const LAS unsigned char* vp_ = vp0 + sl_prev; \
    FX_VRD(0); FX_SBAR(); \
                       FX_GAPA(C0 = ATT_MFMA(kf[0], qr[0], C0), P0[2], P0[3], P0[4], P0[5],     pw0[0] = FX_PKW(P0, 0),  pw0[1] = FX_PKW(P0, 2),  pw0); \
    FX_VRD(4); FX_SBAR(); FX_GAPA(C1 = ATT_MFMA(kf[1], qr[0], C1), P0[6], P0[7], P0[8], P0[9],     pw0[2] = FX_PKW(P0, 4),  pw0[3] = FX_PKW(P0, 6),  pw0); \
    FX_VRD(1); FX_SBAR(); FX_GAPA(C0 = ATT_MFMA(kf[2], qr[1], C0),    P0[10], P0[11], P0[12], P0[13], pw1[0] = FX_PKW(P0, 8),  pw1[1] = FX_PKW(P0, 10), pw1); \
    FX_VRD(5); FX_SBAR(); FX_GAPA(C1 = ATT_MFMA(kf[3], qr[1], C1),    P0[14], P0[15], P1[0], P1[1],   pw1[2] = FX_PKW(P0, 12), pw1[3] = FX_PKW(P0, 14), pw1); \
    FX_VRD(2); FX_SBAR(); FX_GAPA(C0 = ATT_MFMA(kf[4], qr[2], C0),    P1[2], P1[3], P1[4], P1[5],     pw2[0] = FX_PKW(P1, 0),  pw2[1] = FX_PKW(P1, 2),  pw2); \
    FX_VRD(6); FX_SBAR(); FX_GAPA(C1 = ATT_MFMA(kf[5], qr[2], C1),    P1[6], P1[7], P1[8], P1[9],     pw2[2] = FX_PKW(P1, 4),  pw2[3] = FX_PKW(P1, 6),  pw2); \
    FX_VRD(3); FX_SBAR(); FX_GAPA(C0 = ATT_MFMA(kf[6], qr[3], C0),    P1[10], P1[11], P1[12], P1[13], pw3[0] = FX_PKW(P1, 8),  pw3[1] = FX_PKW(P1, 10), pw3); \
    FX_VRD(7); FX_SBAR(); FX_GAPA(C1 = ATT_MFMA(kf[7], qr[3], C1),    P1[14], P1[15], 0.f, 0.f,       pw3[2] = FX_PKW(P1, 12), pw3[3] = FX_PKW(P1, 14), pw3); \
    if (GK) FX_DMA_K((t) + 3, sl_cur); if (GV) FX_DMA_V((t) + 1, sl_next);                                \
    if (MASK) fx_cmask(C0, C1, (t) - (NT - 4), qrel, hi); \
    { const float rm = fx_rowmax(C0, C1) + (cq - mhat); resc = false;                                      \
      if (__builtin_expect(__any(rm > FTHR), 0)) { const float dl = __builtin_fmaxf(rm, 0.f); mhat += dl;     \
          const float f = __builtin_amdgcn_exp2f(-dl); if (hi == 0) wsf[r32] = f; resc = true; } } \
    const float nmh = cq - mhat; FX_SBAR(); \
    FX_CRD(GL, P0, P1, t, 0); FX_GAPB(o[0] = ATT_MFMA(FX_PAF(0), FX_VFR(0), o[0]), C0, 0);  FX_CRD(GL, P0, P1, t, 1); FX_GAPB(o[1] = ATT_MFMA(FX_PAF(0), FX_VFR(4), o[1]); osum = ATT_MFMA(FX_PAF(0), ones, osum), C0, 4); \
    FX_KRD(GL, 0); FX_GAPB(o[0] = ATT_MFMA(FX_PAF(1), FX_VFR(1), o[0]), C0, 8);  FX_KRD(GL, 1); FX_GAPB(o[1] = ATT_MFMA(FX_PAF(1), FX_VFR(5), o[1]); osum = ATT_MFMA(FX_PAF(1), ones, osum), C0, 12); \
    FX_KRD(GL, 2); FX_GAPB(o[0] = ATT_MFMA(FX_PAF(2), FX_VFR(2), o[0]), C1, 0);  FX_KRD(GL, 3); FX_GAPB(o[1] = ATT_MFMA(FX_PAF(2), FX_VFR(6), o[1]); osum = ATT_MFMA(FX_PAF(2), ones, osum), C1, 4); \
    FX_CRD(GL, P0, P1, t, 2); FX_GAPB(o[0] = ATT_MFMA(FX_PAF(3), FX_VFR(3), o[0]), C1, 8);  FX_CRD(GL, P0, P1, t, 3); FX_GAPB(o[1] = ATT_MFMA(FX_PAF(3), FX_VFR(7), o[1]); osum = ATT_MFMA(FX_PAF(3), ones, osum), C1, 12); \
    } while (0)
    int t = 1;
    for (; t + 5 < NT; t += 2) {
        FX_STEP(pB0, pB1, pA0, pA1, t, false, true, true, true);     FX_WAIT_BAR(2); FX_RESC(); FX_ROT();
        FX_STEP(pA0, pA1, pB0, pB1, t + 1, false, true, true, true); FX_WAIT_BAR(2); FX_RESC(); FX_ROT();
    }
#define FX_ENDW(tt) do { if ((tt) + 3 < NT) { FX_WAIT_BAR(2); } else if ((tt) + 2 < NT) { FX_WAIT_BAR(1); } else { FX_WAIT_BAR(0); } } while (0)
    for (; t + 1 < NT; t += 2) {
        FX_STEP(pB0, pB1, pA0, pA1, t, true, (t + 3 < NT), (t + 1 < NT), (t + 1 < NT));         FX_ENDW(t);     FX_RESC(); FX_ROT();
        FX_STEP(pA0, pA1, pB0, pB1, t + 1, true, (t + 4 < NT), (t + 2 < NT), (t + 2 < NT));     FX_ENDW(t + 1); FX_RESC(); FX_ROT();
    }
    FX_STEP(pB0, pB1, pA0, pA1, NT - 1, true, false, false, false); FX_RESC();
    {
      pw0 = (u32x4){FX_PKW(pB0, 0), FX_PKW(pB0, 2), FX_PKW(pB0, 4), FX_PKW(pB0, 6)}; pw1 = (u32x4){FX_PKW(pB0, 8), FX_PKW(pB0, 10), FX_PKW(pB0, 12), FX_PKW(pB0, 14)};
      pw2 = (u32x4){FX_PKW(pB1, 0), FX_PKW(pB1, 2), FX_PKW(pB1, 4), FX_PKW(pB1, 6)}; pw3 = (u32x4){FX_PKW(pB1, 8), FX_PKW(pB1, 10), FX_PKW(pB1, 12), FX_PKW(pB1, 14)};
      const LAS unsigned char* vp_ = vp0 + sl_cur;
#pragma unroll
      for (int i = 0; i < 8; ++i) FX_VRD(i);
      o[0] = ATT_MFMA(FX_PAF(0), FX_VFR(0), o[0]); o[1] = ATT_MFMA(FX_PAF(0), FX_VFR(4), o[1]); o[0] = ATT_MFMA(FX_PAF(1), FX_VFR(1), o[0]); o[1] = ATT_MFMA(FX_PAF(1), FX_VFR(5), o[1]);
      o[0] = ATT_MFMA(FX_PAF(2), FX_VFR(2), o[0]); o[1] = ATT_MFMA(FX_PAF(2), FX_VFR(6), o[1]); o[0] = ATT_MFMA(FX_PAF(3), FX_VFR(3), o[0]); o[1] = ATT_MFMA(FX_PAF(3), FX_VFR(7), o[1]);
      osum = ATT_MFMA(FX_PAF(0), ones, osum); osum = ATT_MFMA(FX_PAF(1), ones, osum); osum = ATT_MFMA(FX_PAF(2), ones, osum); osum = ATT_MFMA(FX_PAF(3), ones, osum); }
    float rli[16];
#pragma unroll
    for (int r = 0; r < 16; ++r) rli[r] = 1.0f / osum[r];
    LAS bf16_t* stg = (LAS bf16_t*)(lds + LDS_OST) + wid * 2048;
#pragma unroll
    for (int db = 0; db < 2; ++db)
#pragma unroll
        for (int r = 0; r < 16; ++r) stg[crow(r, hi) * 64 + db * 32 + r32] = (bf16_t)f2bf(o[db][r] * rli[r]);
    asm volatile("s_waitcnt lgkmcnt(0)" ::: "memory");
    bf16_t* Yw = Y + (rowbase + q0 + wid * 32) * 512 + hcol;
#pragma unroll
    for (int i = 0; i < 4; ++i) { const int row = i * 8 + (lane >> 3), ch = lane & 7; const u32x4 v = *(const LAS u32x4*)(stg + row * 64 + ch * 8); *(GAS u32x4*)(Yw + (size_t)row * 512 + ch * 8) = v; }
    ATT_WAIT_BAR();
#undef FX_DMA_K
#undef FX_DMA_V
#undef FX_ROT
#undef FX_EX
#undef FX_RESC
#undef FX_KLOAD2
#undef FX_CLOAD
#undef FX_PKW
#undef FX_PAF
#undef FX_VFR
#undef FX_VRD
#undef FX_KRD
#undef FX_CRD
#undef FX_ENDW
#undef FX_GAPA
#undef FX_GAPB
#undef FX_STEP
}
__device__ __forceinline__ float fx_max3(float a, float b, float c) { float r; asm("v_max3_f32 %0, %1, %2, %3" : "=v"(r) : "v"(a), "v"(b), "v"(c)); return r; }
__device__ __forceinline__ void diff_unit(LAS unsigned char* lds, int tid, int b, int h, int qb, const bf16_t* Q, const bf16_t* K, const bf16_t* V, bf16_t* Y,
                                          const float* aux  , float lam, float lnscale, const float* subg) {
    constexpr int QB = 128, SLOTB = 16384, LDS_K = 0, LDS_V = 3 * SLOTB, LDS_WS = 6 * SLOTB, LDS_TAB = LDS_WS + 2048, LDS_OST = LDS_TAB + 2048;
    constexpr float DTHR = 48.0f;
    int tid_ = tid; asm volatile("" : "+v"(tid_));
    const int lane = tid_ & 63, r32 = lane & 31, hi = lane >> 5, wid = __builtin_amdgcn_readfirstlane(tid_ >> 6);
    const int qg = wid & 3, m = wid >> 2;
    const int q0 = qb * QB, NT = (q0 + QB) / 64;
    const size_t rowbase = (size_t)b * S;
    const int hcol = h * 128;
    const bf16_t* Qw = Q + (rowbase + q0 + qg * 32) * 512 + hcol + m * 64;
    const bf16_t* Kh = K + rowbase * 512 + hcol;
    const bf16_t* Vh = V + rowbase * 512 + hcol;
    const unsigned lds0 = (unsigned)(uintptr_t)lds;
    LAS float* wsf = (LAS float*)(lds + LDS_WS) + wid * 64;
    LAS float* tab = (LAS float*)(lds + LDS_TAB);
    const int qpos = q0 + qg * 32 + r32;
    const unsigned koff = (unsigned)(((8 * wid + (lane & 7)) * 512 + (lane >> 3) * 8) * 2);
    const int vrow = lane >> 4, vslot = lane & 15;
    const int vchunk = (((vslot >> 2) ^ vrow) << 2) | (vslot & 3);
    const unsigned voff = (unsigned)(((4 * wid + vrow) * 512 + vchunk * 8) * 2);
    const unsigned kdst = lds0 + LDS_K + wid * 1024, vdst = lds0 + LDS_V + wid * 1024;
#define DF_DMA_K(t, slot) do { const bf16_t* kb_ = Kh + (size_t)(t) * 64 * 512; glds16s(kb_, koff, (unsigned)__builtin_amdgcn_readfirstlane(kdst + (slot))); glds16s(kb_ + 64, koff, (unsigned)__builtin_amdgcn_readfirstlane(kdst + (slot) + 8192u)); } while (0)
#define DF_DMA_V(t, slot) do { const bf16_t* vb_ = Vh + (size_t)(t) * 64 * 512; glds16s(vb_, voff, (unsigned)__builtin_amdgcn_readfirstlane(vdst + (slot))); glds16s(vb_ + 32 * 512, voff, (unsigned)__builtin_amdgcn_readfirstlane(vdst + (slot) + 8192u)); } while (0)
    const int vq = (lane & 15) >> 2;
    const LAS unsigned char* vp0 = lds + LDS_V + ((lane >> 4) & 1) * 32 + (lane & 3) * 8 + hi * 1024 + vq * 256;
    const LAS unsigned char* kp0 = lds + LDS_K + m * 8192 + (r32 >> 3) * 1024 + (r32 & 7) * 16 + hi * 128;
    DF_DMA_K(0, 0); DF_DMA_V(0, 0); DF_DMA_K(1, SLOTB); DF_DMA_K(2, 2 * SLOTB);
    {
        const GAS float* auxg = (const GAS float*)aux; const int i_ = tid_ - 128;
        tab[tid_] = i_ < 0 ? -INFINITY : (i_ < 128 ? auxg[i_] - auxg[128] : 0.f);
    }
    bf16x8 qr[4];
#pragma unroll
    for (int d0 = 0; d0 < 4; ++d0) qr[d0] = *(const GAS bf16x8*)(Qw + (size_t)r32 * 512 + d0 * 16 + hi * 8);
    asm volatile("" : "+v"(qr[0]), "+v"(qr[1]), "+v"(qr[2]), "+v"(qr[3]));
    float mhat = 0.f, l_reg = 0.f, fP = 1.f; f32x16 o[4];
#pragma unroll
    for (int db = 0; db < 4; ++db) o[db] = f32x16{};
    bool rescP = false, rescN = false;
    f32x16 pA0, pA1, pB0, pB1; bf16x8 kf[8]; s16x4 vlo[2][4], vhi[2][4]; u32x4 pw0, pw1, pw2, pw3;
    int sl_prev = 0, sl_cur = 0, sl_next = SLOTB;
#define DF_ROT() do { sl_prev = sl_cur; sl_cur = sl_next; sl_next = (sl_next == 2 * SLOTB) ? 0 : sl_next + SLOTB; } while (0)
#define DF_EX(v) __builtin_amdgcn_exp2f(v)
#define DF_RESC(par) do { if (rescP) { _Pragma("unroll") for (int g_ = 0; g_ < 4; ++g_) { const f32x4 a4 = *(const LAS f32x4*)(wsf + 32 * (par) + 8 * g_ + 4 * hi); \
        _Pragma("unroll") for (int d_ = 0; d_ < 4; ++d_) { o[d_][4 * g_] *= a4[0]; o[d_][4 * g_ + 1] *= a4[1]; o[d_][4 * g_ + 2] *= a4[2]; o[d_][4 * g_ + 3] *= a4[3]; } } } rescP = rescN; } while (0)
#define DF_KLOAD2(kp, d0) do { kf[2 * (d0)] = *(const LAS bf16x8*)((kp) + (d0) * 256); kf[2 * (d0) + 1] = *(const LAS bf16x8*)((kp) + (d0) * 256 + 4096); } while (0)
#define DF_CINIT(C0, C1, t) do { const LAS float* tp_ = tab + (qpos - ((t) * 64 + 4 * hi) + 128 - 59); \
        _Pragma("unroll") for (int r = 0; r < 16; ++r) { C0[r] = tp_[59 - ((r & 3) + 8 * (r >> 2))]; C1[r] = tp_[59 - 32 - ((r & 3) + 8 * (r >> 2))]; } } while (0)
#define DF_DECIDE(C0, C1, par) do { const float rm_ = fx_rowmax(C0, C1); rescN = false; float fN_ = 1.f; \
        if (__builtin_expect(__any(rm_ > DTHR), 0)) { const float dl_ = __builtin_fmaxf(rm_, 0.f); mhat += dl_; fN_ = __builtin_amdgcn_exp2f(-dl_); if (hi == 0) wsf[32 * (par) + r32] = fN_; rescN = true; } \
        fNext = fN_; } while (0)
#define DF_DECIDE2(par) do { float rm_ = mx; { auto rr_ = __builtin_amdgcn_permlane32_swap(__float_as_uint(rm_), __float_as_uint(rm_), false, false); rm_ = __builtin_fmaxf(__uint_as_float(rr_[0]), __uint_as_float(rr_[1])); } \
        rescN = false; float fN_ = 1.f; \
        if (__builtin_expect(__any(rm_ > DTHR), 0)) { const float dl_ = __builtin_fmaxf(rm_, 0.f); mhat += dl_; fN_ = __builtin_amdgcn_exp2f(-dl_); if (hi == 0) wsf[32 * (par) + r32] = fN_; rescN = true; } \
        fNext = fN_; } while (0)
    float fNext = 1.f;
    asm volatile("s_waitcnt vmcnt(6) lgkmcnt(0)\n\ts_barrier" ::: "memory");
#pragma unroll
    for (int d0 = 0; d0 < 4; ++d0) DF_KLOAD2(kp0, d0);
    if (NT <= 4) { DF_CINIT(pA0, pA1, 0); pA0 = ATT_MFMA(kf[0], qr[0], pA0); pA1 = ATT_MFMA(kf[1], qr[0], pA1); }
    else { pA0 = ATT_MFMA(kf[0], qr[0], f32x16{}); pA1 = ATT_MFMA(kf[1], qr[0], f32x16{}); }
    pA0 = ATT_MFMA(kf[2], qr[1], pA0); pA1 = ATT_MFMA(kf[3], qr[1], pA1);
    pA0 = ATT_MFMA(kf[4], qr[2], pA0); pA1 = ATT_MFMA(kf[5], qr[2], pA1); pA0 = ATT_MFMA(kf[6], qr[3], pA0); pA1 = ATT_MFMA(kf[7], qr[3], pA1);
    DF_DECIDE(pA0, pA1, 0);
#pragma unroll
    for (int r = 0; r < 16; ++r) { pA0[r] = DF_EX(pA0[r]); pA1[r] = DF_EX(pA1[r]); }
    rescP = rescN; fP = fNext;
    asm volatile("s_waitcnt vmcnt(0) lgkmcnt(0)\n\ts_barrier" ::: "memory");
    DF_DMA_K(3, 0); DF_DMA_V(1, SLOTB); DF_ROT();
#pragma unroll
    for (int d0 = 0; d0 < 4; ++d0) DF_KLOAD2(kp0 + sl_cur, d0);
    asm volatile("s_waitcnt vmcnt(4) lgkmcnt(0)\n\ts_barrier" ::: "memory");
#define DF_PKW(P, i) fx_cvtpk(P[i], P[i + 1])
#define DF_PAF(k) __builtin_bit_cast(bf16x8, pw##k)
#define DF_VFR(bf, db) (bf16x8){vlo[bf][db][0], vlo[bf][db][1], vlo[bf][db][2], vlo[bf][db][3], vhi[bf][db][0], vhi[bf][db][1], vhi[bf][db][2], vhi[bf][db][3]}
#define DF_VRD(bf, ks, i) do { if (((i) & 1) == 0) vlo[bf][(i) >> 1] = vtr(vp_ + ((((i) >> 1) ^ vq) * 64 + (ks) * 4096)); else vhi[bf][(i) >> 1] = vtr(vp_ + ((((i) >> 1) ^ vq) * 64 + (ks) * 4096 + 2048)); } while (0)
#define DF_VRD2(bf, ks, i) do { DF_VRD(bf, ks, i); DF_VRD(bf, ks, (i) + 1); FX_SBAR(); } while (0)
#define DF_KRD(G, d0) do { if (G) { DF_KLOAD2(kp0 + sl_next, d0); FX_SBAR(); } } while (0)
#define DF_GAPA(MF, a0, a1, a2, a3, W0, W1, PW) do { MF; sacc += a0; sacc += a1; sacc += a2; sacc += a3; W0; W1; FX_PIN(PW); FX_PIN(sacc); FX_SBAR(); } while (0)
#define DF_GAPB(MF, X, i) do { MF; mx = fx_max3(mx, X[i], X[i + 1]); X[i] = DF_EX(X[i]); X[i + 1] = DF_EX(X[i + 1]); FX_PIN(X); FX_PIN(mx); FX_SBAR(); } while (0)
#define DF_STEP(C0, C1, P0, P1, t, par, MASK, GK, GV, GL) do { FX_SBAR(); \
    const LAS unsigned char* vp_ = vp0 + sl_prev; \
    if (MASK) { DF_CINIT(C0, C1, t); FX_SBAR(); } \
    DF_VRD(0, 0, 0); FX_SBAR(); float sacc = P0[0] + P0[1]; float mx = -INFINITY; \
                              DF_GAPA(C0 = ATT_MFMA(kf[0], qr[0], (MASK) ? C0 : f32x16{}), P0[2], P0[3], P0[4], P0[5],     pw0[0] = DF_PKW(P0, 0),  pw0[1] = DF_PKW(P0, 2),  pw0); \
    DF_VRD(0, 0, 1); FX_SBAR(); DF_GAPA(C1 = ATT_MFMA(kf[1], qr[0], (MASK) ? C1 : f32x16{}), P0[6], P0[7], P0[8], P0[9],     pw0[2] = DF_PKW(P0, 4),  pw0[3] = DF_PKW(P0, 6),  pw0); \
    if (GK) { DF_DMA_K((t) + 3, sl_cur); FX_SBAR(); }                                                                  \
    DF_VRD(0, 0, 2); FX_SBAR(); DF_GAPA(C0 = ATT_MFMA(kf[2], qr[1], C0),    P0[10], P0[11], P0[12], P0[13], pw1[0] = DF_PKW(P0, 8),  pw1[1] = DF_PKW(P0, 10), pw1); \
    DF_VRD(0, 0, 3); FX_SBAR(); DF_GAPA(C1 = ATT_MFMA(kf[3], qr[1], C1),    P0[14], P0[15], P1[0], P1[1],   pw1[2] = DF_PKW(P0, 12), pw1[3] = DF_PKW(P0, 14), pw1); \
    if (GV) { DF_DMA_V((t) + 1, sl_next); FX_SBAR(); } \
    DF_VRD(0, 0, 4); FX_SBAR(); DF_GAPA(C0 = ATT_MFMA(kf[4], qr[2], C0),    P1[2], P1[3], P1[4], P1[5],     pw2[0] = DF_PKW(P1, 0),  pw2[1] = DF_PKW(P1, 2),  pw2); \
    DF_VRD(0, 0, 5); FX_SBAR(); DF_GAPA(C1 = ATT_MFMA(kf[5], qr[2], C1),    P1[6], P1[7], P1[8], P1[9],     pw2[2] = DF_PKW(P1, 4),  pw2[3] = DF_PKW(P1, 6),  pw2); \
    DF_VRD(0, 0, 6); FX_SBAR(); DF_GAPA(C0 = ATT_MFMA(kf[6], qr[3], C0),    P1[10], P1[11], P1[12], P1[13], pw3[0] = DF_PKW(P1, 8),  pw3[1] = DF_PKW(P1, 10), pw3); \
    DF_VRD(0, 0, 7); FX_SBAR(); DF_GAPA(C1 = ATT_MFMA(kf[7], qr[3], C1),    P1[14], P1[15], 0.f, 0.f,       pw3[2] = DF_PKW(P1, 12), pw3[3] = DF_PKW(P1, 14), pw3); \
    l_reg = (l_reg + sacc) * fP;                                                                           \
    if (__builtin_expect(!__all(mhat == 0.f), 0)) { _Pragma("unroll") for (int r = 0; r < 16; ++r) { C0[r] -= mhat; C1[r] -= mhat; } }       \
    FX_SBAR(); \
    DF_VRD2(1, 1, 0); DF_GAPB(o[0] = ATT_MFMA(DF_PAF(0), DF_VFR(0, 0), o[0]), C0, 0);   DF_VRD2(1, 1, 2); DF_GAPB(o[1] = ATT_MFMA(DF_PAF(0), DF_VFR(0, 1), o[1]), C0, 2); \
    DF_VRD2(1, 1, 4); DF_GAPB(o[2] = ATT_MFMA(DF_PAF(0), DF_VFR(0, 2), o[2]), C0, 4);   DF_VRD2(1, 1, 6); DF_GAPB(o[3] = ATT_MFMA(DF_PAF(0), DF_VFR(0, 3), o[3]), C0, 6); \
    DF_VRD2(0, 2, 0); DF_GAPB(o[0] = ATT_MFMA(DF_PAF(1), DF_VFR(1, 0), o[0]), C0, 8);   DF_VRD2(0, 2, 2); DF_GAPB(o[1] = ATT_MFMA(DF_PAF(1), DF_VFR(1, 1), o[1]), C0, 10); \
    DF_VRD2(0, 2, 4); DF_GAPB(o[2] = ATT_MFMA(DF_PAF(1), DF_VFR(1, 2), o[2]), C0, 12);  DF_VRD2(0, 2, 6); DF_GAPB(o[3] = ATT_MFMA(DF_PAF(1), DF_VFR(1, 3), o[3]), C0, 14); \
    DF_VRD2(1, 3, 0); DF_GAPB(o[0] = ATT_MFMA(DF_PAF(2), DF_VFR(0, 0), o[0]), C1, 0);   DF_VRD2(1, 3, 2); DF_GAPB(o[1] = ATT_MFMA(DF_PAF(2), DF_VFR(0, 1), o[1]), C1, 2); \
    DF_VRD2(1, 3, 4); DF_GAPB(o[2] = ATT_MFMA(DF_PAF(2), DF_VFR(0, 2), o[2]), C1, 4);   DF_VRD2(1, 3, 6); DF_GAPB(o[3] = ATT_MFMA(DF_PAF(2), DF_VFR(0, 3), o[3]), C1, 6); \
    DF_KRD(GL, 0); DF_GAPB(o[0] = ATT_MFMA(DF_PAF(3), DF_VFR(1, 0), o[0]), C1, 8);      DF_KRD(GL, 1); DF_GAPB(o[1] = ATT_MFMA(DF_PAF(3), DF_VFR(1, 1), o[1]), C1, 10); \
    DF_KRD(GL, 2); DF_GAPB(o[2] = ATT_MFMA(DF_PAF(3), DF_VFR(1, 2), o[2]), C1, 12);     DF_KRD(GL, 3); DF_GAPB(o[3] = ATT_MFMA(DF_PAF(3), DF_VFR(1, 3), o[3]), C1, 14); \
    DF_DECIDE2(par); \
    } while (0)
#define DF_WAIT_BAR(N) asm volatile("s_waitcnt vmcnt(" #N ") lgkmcnt(0)\n\ts_barrier" ::: "memory")
#define DF_AFTER(par_prev) do { DF_RESC(par_prev); fP = fNext; } while (0)
    int t = 1;
    for (; t + 5 < NT; t += 2) {
        DF_STEP(pB0, pB1, pA0, pA1, t, 1, false, true, true, true);     DF_WAIT_BAR(4); DF_AFTER(0); DF_ROT();
        DF_STEP(pA0, pA1, pB0, pB1, t + 1, 0, false, true, true, true); DF_WAIT_BAR(4); DF_AFTER(1); DF_ROT();
    }
#define DF_ENDW(tt) do { if ((tt) + 3 < NT) { DF_WAIT_BAR(4); } else if ((tt) + 2 < NT) { DF_WAIT_BAR(2); } else { DF_WAIT_BAR(0); } } while (0)
    for (; t + 1 < NT; t += 2) {
        DF_STEP(pB0, pB1, pA0, pA1, t, 1, true, (t + 3 < NT), (t + 1 < NT), (t + 1 < NT));         DF_ENDW(t);     DF_AFTER(0); DF_ROT();
        DF_STEP(pA0, pA1, pB0, pB1, t + 1, 0, true, (t + 4 < NT), (t + 2 < NT), (t + 2 < NT));     DF_ENDW(t + 1); DF_AFTER(1); DF_ROT();
    }
    if (NT == 2) DF_WAIT_BAR(0);
    DF_STEP(pB0, pB1, pA0, pA1, NT - 1, 1, true, false, false, false); DF_AFTER(0);
    { float sacc = pB0[0] + pB0[1];
#pragma unroll
      for (int r = 2; r < 16; ++r) sacc += pB0[r];
#pragma unroll
      for (int r = 0; r < 16; ++r) sacc += pB1[r];
      l_reg += sacc;
      pw0 = (u32x4){DF_PKW(pB0, 0), DF_PKW(pB0, 2), DF_PKW(pB0, 4), DF_PKW(pB0, 6)}; pw1 = (u32x4){DF_PKW(pB0, 8), DF_PKW(pB0, 10), DF_PKW(pB0, 12), DF_PKW(pB0, 14)};
      pw2 = (u32x4){DF_PKW(pB1, 0), DF_PKW(pB1, 2), DF_PKW(pB1, 4), DF_PKW(pB1, 6)}; pw3 = (u32x4){DF_PKW(pB1, 8), DF_PKW(pB1, 10), DF_PKW(pB1, 12), DF_PKW(pB1, 14)};
      const LAS unsigned char* vp_ = vp0 + sl_cur;
#pragma unroll
      for (int i = 0; i < 8; ++i) { DF_VRD(0, 0, i); DF_VRD(1, 1, i); }
      o[0] = ATT_MFMA(DF_PAF(0), DF_VFR(0, 0), o[0]); o[1] = ATT_MFMA(DF_PAF(0), DF_VFR(0, 1), o[1]); o[2] = ATT_MFMA(DF_PAF(0), DF_VFR(0, 2), o[2]); o[3] = ATT_MFMA(DF_PAF(0), DF_VFR(0, 3), o[3]);
      o[0] = ATT_MFMA(DF_PAF(1), DF_VFR(1, 0), o[0]); o[1] = ATT_MFMA(DF_PAF(1), DF_VFR(1, 1), o[1]); o[2] = ATT_MFMA(DF_PAF(1), DF_VFR(1, 2), o[2]); o[3] = ATT_MFMA(DF_PAF(1), DF_VFR(1, 3), o[3]);
      FX_SBAR();
#pragma unroll
      for (int i = 0; i < 8; ++i) { DF_VRD(0, 2, i); DF_VRD(1, 3, i); }
      o[0] = ATT_MFMA(DF_PAF(2), DF_VFR(0, 0), o[0]); o[1] = ATT_MFMA(DF_PAF(2), DF_VFR(0, 1), o[1]); o[2] = ATT_MFMA(DF_PAF(2), DF_VFR(0, 2), o[2]); o[3] = ATT_MFMA(DF_PAF(2), DF_VFR(0, 3), o[3]);
      o[0] = ATT_MFMA(DF_PAF(3), DF_VFR(1, 0), o[0]); o[1] = ATT_MFMA(DF_PAF(3), DF_VFR(1, 1), o[1]); o[2] = ATT_MFMA(DF_PAF(3), DF_VFR(1, 2), o[2]); o[3] = ATT_MFMA(DF_PAF(3), DF_VFR(1, 3), o[3]); }
    { auto rr = __builtin_amdgcn_permlane32_swap(__float_as_uint(l_reg), __float_as_uint(l_reg), false, false); l_reg = __uint_as_float(rr[0]) + __uint_as_float(rr[1]); }
    if (hi == 0) wsf[32 + r32] = (m == 1) ? lam / l_reg : 1.0f / l_reg;
    asm volatile("s_waitcnt lgkmcnt(0)" ::: "memory");
    float rli[16];
#pragma unroll
    for (int g = 0; g < 4; ++g) { const f32x4 a4 = *(const LAS f32x4*)(wsf + 32 + 8 * g + 4 * hi); rli[4 * g] = a4[0]; rli[4 * g + 1] = a4[1]; rli[4 * g + 2] = a4[2]; rli[4 * g + 3] = a4[3]; }
    ATT_WAIT_BAR();
    {
        LAS float* xch = (LAS float*)lds + qg * 4096;
        if (m == 1) {
#pragma unroll
            for (int db = 0; db < 4; ++db)
#pragma unroll
                for (int r = 0; r < 16; ++r) xch[(db * 16 + r) * 64 + lane] = o[db][r] * rli[r];
        }
        ATT_WAIT_BAR();
        if (m == 0) {
            float ss[16];
#pragma unroll
            for (int r = 0; r < 16; ++r) ss[r] = 0.f;
#pragma unroll
            for (int db = 0; db < 4; ++db)
#pragma unroll
                for (int r = 0; r < 16; ++r) { const float v = o[db][r] * rli[r] - xch[(db * 16 + r) * 64 + lane]; o[db][r] = v; ss[r] += v * v; }
#pragma unroll
            for (int r = 0; r < 16; ++r) {
                float v = ss[r];
                v = sum32(v);
                ss[r] = rsqrtf(v * (1.0f / 128.0f) + EPS) * lnscale;
            }
            LAS bf16_t* stg = (LAS bf16_t*)(lds + LDS_OST) + qg * 4096;
#pragma unroll
            for (int db = 0; db < 4; ++db) { const float gd = ((const GAS float*)subg)[db * 32 + r32];
#pragma unroll
                for (int r = 0; r < 16; ++r) stg[crow(r, hi) * 128 + db * 32 + r32] = (bf16_t)f2bf(o[db][r] * ss[r] * gd); }
            asm volatile("s_waitcnt lgkmcnt(0)" ::: "memory");
            bf16_t* Yw = Y + (rowbase + q0 + qg * 32) * 512 + hcol;
#pragma unroll
            for (int i = 0; i < 8; ++i) { const int row = i * 4 + (lane >> 4), ch = lane & 15; const u32x4 v = *(const LAS u32x4*)(stg + row * 128 + ch * 8); *(GAS u32x4*)(Yw + (size_t)row * 512 + ch * 8) = v; }
        }
    }
    ATT_WAIT_BAR();
#undef DF_DMA_K
#undef DF_DMA_V
#undef DF_ROT
#undef DF_EX
#undef DF_RESC
#undef DF_KLOAD2
#undef DF_CINIT
#undef DF_DECIDE
#undef DF_DECIDE2
#undef DF_PKW
#undef DF_PAF
#undef DF_VFR
#undef DF_VRD
#undef DF_VRD2
#undef DF_KRD
#undef DF_GAPA
#undef DF_GAPB
#undef DF_STEP
#undef DF_WAIT_BAR
#undef DF_AFTER
#undef DF_ENDW
}
}

template <class Hook>
__device__ __forceinline__ void ph_attention(Frame& F, const bf16_t* QKV, const float* BT, const float* CUM, const float* lamv, const float* subg, float lam_init, bf16_t* YD, bf16_t* YF, Hook after_unit) {
    int unit_no = 0;
    const int vcu = (F.G % 8 == 0) ? (F.bid % 8) * (F.G / 8) + F.bid / 8 : F.bid;
    const float l01 = wave_sum(lamv[F.lane] * lamv[64 + F.lane]), l23 = wave_sum(lamv[128 + F.lane] * lamv[192 + F.lane]);
    const float lam = expf(l01) - expf(l23) + lam_init;
    for (int pi = vcu; pi < 256; pi += F.G) {
        const int bh = pi >> 3, s = pi & 7, b = bh >> 2, h = bh & 3;
        for (int k = 0; k < 2; ++k) {
            att::diff_unit(F.lds, F.tid, b, h, k == 0 ? 15 - s : s, QKV, QKV + (size_t)T * 512, QKV + (size_t)2 * T * 512, YD, BT + h * 129, lam, 1.0f - lam_init, subg);
            after_unit(unit_no++);
        }
    }
    for (int pi = vcu; pi < 256; pi += F.G) {
        const int bh = pi >> 2, s = pi & 3, b = bh >> 3, h = bh & 7;
        for (int k = 0; k < 2; ++k) {
            att::fox_unit(F.lds, F.tid, b, h, k == 0 ? 7 - s : s, QKV + (size_t)3 * T * 512, QKV + (size_t)4 * T * 512, QKV + (size_t)5 * T * 512, YF, CUM + (size_t)bh * S);
            after_unit(unit_no++);
        }
    }
}
namespace peer {
typedef float f32x2 __attribute__((ext_vector_type(2)));
typedef unsigned v6u __attribute__((ext_vector_type(6)));
typedef unsigned u32x2 __attribute__((ext_vector_type(2)));
typedef float v32f __attribute__((ext_vector_type(32)));
typedef float v16f __attribute__((ext_vector_type(16)));
constexpr float USCALE = 64.f, VSCALE = 23.f;
constexpr int ROWB = 768;
constexpr size_t TBL_BYTES = (size_t)NEXP * ROWB;

__device__ __forceinline__ void convert_stage(LAS unsigned char* stg, int lane, const f32x4 (&in_)[8]) {
#pragma unroll
    for (int k = 0; k < 8; ++k) { const int pidx = k * 64 + lane; *(LAS f32x4*)(stg + pidx * 16 + (pidx >> 3) * 16) = in_[k]; }
}
__device__ __forceinline__ void convert_encode(unsigned char* dst, LAS unsigned char* stg, int lane, int which, size_t ch) {
    const size_t per_l = (size_t)NEXP * D / 32;
    const float sc = which == 0 ? USCALE : VSCALE;
    asm volatile("s_waitcnt lgkmcnt(0)" ::: "memory");
    const size_t i = ch * 64 + lane;
    const size_t l = i / per_l, r = i % per_l;
    v6u o;
    {
        v16f ev_, od_;
#pragma unroll
        for (int k = 0; k < 8; ++k) {
            const f32x4 v = *(const LAS f32x4*)(stg + lane * 144 + k * 16) * sc;
            ev_[2 * k] = v[0]; od_[2 * k] = v[1]; ev_[2 * k + 1] = v[2]; od_[2 * k + 1] = v[3];
        }
        o = __builtin_amdgcn_cvt_scalef32_2xpk16_fp6_f32(ev_, od_, 1.0f);
    }
    asm volatile("s_waitcnt lgkmcnt(0)" ::: "memory");
    GAS u32x2* d2 = (GAS u32x2*)(dst + (l * 2 + which) * TBL_BYTES + r * 24);
    d2[0] = (u32x2){o[0], o[1]}; d2[1] = (u32x2){o[2], o[3]}; d2[2] = (u32x2){o[4], o[5]};
}
__device__ __forceinline__ void convert_chunk(const float* eu, const float* ev, unsigned char* dst, LAS unsigned char* stg, int lane, int which, size_t ch) {
    const GAS f32x4* src = (const GAS f32x4*)(which == 0 ? eu : ev);
    f32x4 in_[8];
#pragma unroll
    for (int k = 0; k < 8; ++k) in_[k] = src[ch * 512 + k * 64 + lane];
    convert_stage(stg, lane, in_);
    convert_encode(dst, stg, lane, which, ch);
}

__device__ __forceinline__ float allreduce16(float s) {
    s += __builtin_bit_cast(float, __builtin_amdgcn_update_dpp(0, __builtin_bit_cast(int, s), 0xB1, 0xF, 0xF, false));
    s += __builtin_bit_cast(float, __builtin_amdgcn_update_dpp(0, __builtin_bit_cast(int, s), 0x4E, 0xF, 0xF, false));
    s += __builtin_bit_cast(float, __builtin_amdgcn_update_dpp(0, __builtin_bit_cast(int, s), 0x141, 0xF, 0xF, false));
    s += __builtin_bit_cast(float, __builtin_amdgcn_update_dpp(0, __builtin_bit_cast(int, s), 0x140, 0xF, 0xF, false));
    return s;
}
__device__ __forceinline__ v32f dec32(unsigned a, unsigned b, unsigned c, unsigned d, unsigned e, unsigned f) { return __builtin_amdgcn_cvt_scalef32_pk32_f32_fp6((v6u){a, b, c, d, e, f}, 1.0f); }

template <int MODE>
__device__ __forceinline__ void ph_peer_gather(Frame& F, const bf16_t* HNp, const float* g2pp, const float* SSPp, const int* EXPIp, const float* GATEp, const unsigned char* EU6p, const unsigned char* EV6p, bf16_t* XRp,
                                               const float* gnp, bf16_t* HNoutp, const float* wffp, const float* bfgp, float* logfp, float* outp) {
    const int lane0 = F.lane;
    LAS float* wl = (LAS float*)F.lds;
    if (MODE == 1) {
        const GAS float* wff = (const GAS float*)wffp;
        for (int k = F.tid; k < D; k += NTHREADS) {
            const f32x4 w0 = *(const GAS f32x4*)(wff + (size_t)k * INW + 3072), w1 = *(const GAS f32x4*)(wff + (size_t)k * INW + 3076);
            const int ln = ((k >> 5) & 31) + 32 * ((k >> 4) & 1), slot = (((k >> 2) & 3) * 64 + ln) * 4 + (k & 3);
            wl[0 * D + slot] = w0[0]; wl[1 * D + slot] = w0[1]; wl[2 * D + slot] = w0[2]; wl[3 * D + slot] = w0[3]; wl[4 * D + slot] = w1[0]; wl[5 * D + slot] = w1[1]; wl[6 * D + slot] = w1[2]; wl[7 * D + slot] = w1[3];
        }
        __syncthreads();
    }
    const unsigned char* wsb0 = (const unsigned char*)HNp - WS_HN;
    const GAS unsigned char* EU6 = (const GAS unsigned char*)EU6p; const GAS unsigned char* EV6 = (const GAS unsigned char*)EV6p;
    const GAS float* g2p = (const GAS float*)g2pp;
    int pi0 = 0, pi1 = 0; float pg0 = 0.f, pg1 = 0.f, pss = 0.f;
#define PEER_PREF(tt, ln, wb) do { const GAS int* ei_ = (const GAS int*)((wb) + WS_EXPI) + (size_t)(tt) * 128 + (ln); const GAS float* ga_ = (const GAS float*)((wb) + WS_GATE) + (size_t)(tt) * 128 + (ln); \
        pi0 = ei_[0]; pi1 = ei_[64]; pg0 = ga_[0]; pg1 = ga_[64]; pss = ((ln) < 16) ? ((const GAS float*)((wb) + WS_SSP))[(size_t)(tt) * 16 + (ln)] : 0.f; } while (0)
    if (F.gw < T) PEER_PREF(F.gw, lane0, wsb0);
    size_t cvc = (size_t)F.gw;
    for (int t = F.gw; t < T; t += F.ngw) {
        int lane = lane0; asm volatile("" : "+v"(lane));
        const unsigned char* wsb = opq(wsb0);
        const GAS bf16_t* HN = (const GAS bf16_t*)(wsb + WS_HN); GAS bf16_t* XRB = (GAS bf16_t*)(wsb + WS_XR);
        const int r32 = lane & 31, hi = lane >> 5;
        int idx0 = pi0, idx1 = pi1; float gate0 = pg0, gate1 = pg1; const float ssv0 = pss;
        if (t + F.ngw < T) PEER_PREF(t + F.ngw, lane, wsb);
        {
            unsigned k0 = ((unsigned)idx0 << 7) | (unsigned)lane, k1 = ((unsigned)idx1 << 7) | (unsigned)(64 + lane);
#pragma unroll
            for (int kk = 2; kk <= 128; kk <<= 1) {
#pragma unroll
                for (int j = kk >> 1; j > 0; j >>= 1) {
                    if (j == 64) { const unsigned lo = k0 < k1 ? k0 : k1, hi2 = k0 < k1 ? k1 : k0; k0 = lo; k1 = hi2; }
                    else {
                        const unsigned p0 = (unsigned)bperm_i(lane ^ j, (int)k0), p1 = (unsigned)bperm_i(lane ^ j, (int)k1);
                        const bool lower = (lane & j) == 0;
                        const bool up0 = (lane & kk) == 0 || kk == 128, up1 = ((64 + lane) & kk) == 0 || kk == 128;
                        const bool kmin0 = (lower == up0), kmin1 = (lower == up1);
                        k0 = kmin0 ? (k0 < p0 ? k0 : p0) : (k0 > p0 ? k0 : p0);
                        k1 = kmin1 ? (k1 < p1 ? k1 : p1) : (k1 > p1 ? k1 : p1);
                    }
                }
            }
            const int s0 = (int)(k0 & 127u), s1 = (int)(k1 & 127u);
            const float ga0 = bperm_f(s0 & 63, gate0), gb0 = bperm_f(s0 & 63, gate1), ga1 = bperm_f(s1 & 63, gate0), gb1 = bperm_f(s1 & 63, gate1);
            gate0 = s0 < 64 ? ga0 : gb0; gate1 = s1 < 64 ? ga1 : gb1;
            idx0 = (int)(k0 >> 7); idx1 = (int)(k1 >> 7);
        }
        float cv0 = 0.f, cv1 = 0.f;
        {
            f32x2 tu[16];
            u32x2 ub[4][3];
#define PEER_ULOAD(s, slot) do { const int ix_ = bperm_i((lane & 32) + ((s) & 31), ((s) >> 5) ? idx1 : idx0); \
            const GAS u32x2* p_ = (const GAS u32x2*)(EU6 + (size_t)ix_ * ROWB + r32 * 24); ub[slot][0] = p_[0]; ub[slot][1] = p_[1]; ub[slot][2] = p_[2]; } while (0)
#define PEER_UCOMP(s, slot) do { f32x2 a0_ = {0.f, 0.f}, a1_ = {0.f, 0.f}; \
            { const v32f g_ = dec32(ub[slot][0][0], ub[slot][0][1], ub[slot][1][0], ub[slot][1][1], ub[slot][2][0], ub[slot][2][1]); \
              _Pragma("unroll") for (int j = 0; j < 16; j += 2) { a0_ = (f32x2){g_[2 * j], g_[2 * j + 1]} * tu[j] + a0_; a1_ = (f32x2){g_[2 * j + 2], g_[2 * j + 3]} * tu[j + 1] + a1_; } } \
            const float tot_ = sum32((a0_[0] + a0_[1]) + (a1_[0] + a1_[1])); \
            if (((s) >> 5) == 0) { if (r32 == ((s) & 31)) cv0 = tot_; } else { if (r32 == ((s) & 31)) cv1 = tot_; } } while (0)
            asm volatile("" ::: "memory");
            v4u trow[4];
#pragma unroll
            for (int q = 0; q < 4; ++q) trow[q] = ((const GAS v4u*)(HN + (size_t)t * D + r32 * 32))[q];
            PEER_ULOAD(0, 0); PEER_ULOAD(1, 1); PEER_ULOAD(2, 2);
            {
              const float ssv = sum32(ssv0);
              const float rsn = rsqrtf(__builtin_bit_cast(float, __builtin_amdgcn_readlane(__builtin_bit_cast(int, ssv), 0)) * (1.0f / D) + EPS);
              const GAS f32x4* gq = (const GAS f32x4*)(g2p + r32 * 32);
#pragma unroll
              for (int q = 0; q < 4; ++q) { const v4u a = trow[q]; const f32x4 ga = gq[2 * q] * rsn, gb = gq[2 * q + 1] * rsn;
                  tu[q * 4 + 0] = (f32x2){__uint_as_float(a[0] << 16) * ga[0], __uint_as_float(a[0] & 0xffff0000u) * ga[1]};
                  tu[q * 4 + 1] = (f32x2){__uint_as_float(a[1] << 16) * ga[2], __uint_as_float(a[1] & 0xffff0000u) * ga[3]};
                  tu[q * 4 + 2] = (f32x2){__uint_as_float(a[2] << 16) * gb[0], __uint_as_float(a[2] & 0xffff0000u) * gb[1]};
                  tu[q * 4 + 3] = (f32x2){__uint_as_float(a[3] << 16) * gb[2], __uint_as_float(a[3] & 0xffff0000u) * gb[3]}; } }
            for (int s0 = 0; s0 < 60; s0 += 4) {
                PEER_ULOAD(s0 + 3, 3); PEER_UCOMP(s0, 0);
                PEER_ULOAD(s0 + 4, 0); PEER_UCOMP(s0 + 1, 1);
                PEER_ULOAD(s0 + 5, 1); PEER_UCOMP(s0 + 2, 2);
                PEER_ULOAD(s0 + 6, 2); PEER_UCOMP(s0 + 3, 3);
            }
            PEER_ULOAD(63, 3); PEER_UCOMP(60, 0); PEER_UCOMP(61, 1); PEER_UCOMP(62, 2); PEER_UCOMP(63, 3);
#undef PEER_ULOAD
#undef PEER_UCOMP
        }
        float c0, c1;
        { const float x0 = cv0 * (1.0f / USCALE), x1 = cv1 * (1.0f / USCALE);
          c0 = gate0 * (0.5f * x0 * (1.0f + erff(x0 * 0.70710678118654752f))) * (1.0f / VSCALE);
          c1 = gate1 * (0.5f * x1 * (1.0f + erff(x1 * 0.70710678118654752f))) * (1.0f / VSCALE); }
        f32x2 acc[16];
#pragma unroll
        for (int k = 0; k < 16; ++k) acc[k] = (f32x2){0.f, 0.f};
        u32x2 vb[6][3];
#define PEER_VLOAD(s, slot) do { const int sl_ = (lane & 32) + ((s) & 31); const int ix_ = bperm_i(sl_, ((s) >> 5) ? idx1 : idx0); \
            const GAS u32x2* p_ = (const GAS u32x2*)(EV6 + (size_t)ix_ * ROWB + r32 * 24); vb[slot][0] = p_[0]; vb[slot][1] = p_[1]; vb[slot][2] = p_[2]; } while (0)
#define PEER_VCOMP(s, slot) do { const int sl_ = (lane & 32) + ((s) & 31); const float c_ = bperm_f(sl_, ((s) >> 5) ? c1 : c0); const f32x2 cc_ = {c_, c_}; \
            const v32f g_ = dec32(vb[slot][0][0], vb[slot][0][1], vb[slot][1][0], vb[slot][1][1], vb[slot][2][0], vb[slot][2][1]); \
            _Pragma("unroll") for (int j = 0; j < 16; ++j) acc[j] = (f32x2){g_[2 * j], g_[2 * j + 1]} * cc_ + acc[j]; } while (0)
#pragma unroll
        for (int k = 0; k < 5; ++k) PEER_VLOAD(k, k);
        for (int s0 = 0; s0 < 54; s0 += 6) {
#pragma unroll
            for (int k = 0; k < 6; ++k) { PEER_VLOAD(s0 + k + 5, (k + 5) % 6); PEER_VCOMP(s0 + k, k); }
        }
#pragma unroll
        for (int k = 0; k < 5; ++k) { PEER_VLOAD(59 + k, (k + 5) % 6); PEER_VCOMP(54 + k, k); }
        PEER_VCOMP(59, 5); PEER_VCOMP(60, 0);
        int e0 = r32 * 32 + hi * 16; asm volatile("" : "+v"(e0));
        v4u xa, xc;
        { const GAS v4u* xp = (const GAS v4u*)(HN + (size_t)t * D + e0); xa = xp[0]; xc = xp[1]; }
        PEER_VCOMP(61, 1); PEER_VCOMP(62, 2); PEER_VCOMP(63, 3);
#undef PEER_VLOAD
#undef PEER_VCOMP
        float pv[16];
#pragma unroll
        for (int j = 0; j < 8; ++j) {
            const float mx = hi ? acc[8 + j][0] : acc[j][0], my = hi ? acc[8 + j][1] : acc[j][1];
            const float ox = hi ? acc[j][0] : acc[8 + j][0], oy = hi ? acc[j][1] : acc[8 + j][1];
            pv[2 * j] = mx + bperm_f(lane ^ 32, ox); pv[2 * j + 1] = my + bperm_f(lane ^ 32, oy);
        }
        f32x4 xv[4];
        {
#pragma unroll
          for (int j = 0; j < 2; ++j) {
              xv[j][0]     = __builtin_bit_cast(float, xa[2 * j] << 16); xv[j][1]     = __builtin_bit_cast(float, xa[2 * j] & 0xffff0000u); xv[j][2]     = __builtin_bit_cast(float, xa[2 * j + 1] << 16); xv[j][3]     = __builtin_bit_cast(float, xa[2 * j + 1] & 0xffff0000u);
              xv[2 + j][0] = __builtin_bit_cast(float, xc[2 * j] << 16); xv[2 + j][1] = __builtin_bit_cast(float, xc[2 * j] & 0xffff0000u); xv[2 + j][2] = __builtin_bit_cast(float, xc[2 * j + 1] << 16); xv[2 + j][3] = __builtin_bit_cast(float, xc[2 * j + 1] & 0xffff0000u); } }
        float ss = 0.f;
#pragma unroll
        for (int j = 0; j < 4; ++j) { xv[j][0] += pv[4 * j]; xv[j][1] += pv[4 * j + 1]; xv[j][2] += pv[4 * j + 2]; xv[j][3] += pv[4 * j + 3];
            ss += xv[j][0] * xv[j][0] + xv[j][1] * xv[j][1] + xv[j][2] * xv[j][2] + xv[j][3] * xv[j][3]; }
        if (MODE != 2) {
            v4u r0, r1;
            r0[0] = pk2(xv[0][0], xv[0][1]); r0[1] = pk2(xv[0][2], xv[0][3]); r0[2] = pk2(xv[1][0], xv[1][1]); r0[3] = pk2(xv[1][2], xv[1][3]);
            r1[0] = pk2(xv[2][0], xv[2][1]); r1[1] = pk2(xv[2][2], xv[2][3]); r1[2] = pk2(xv[3][0], xv[3][1]); r1[3] = pk2(xv[3][2], xv[3][3]);
            GAS v4u* rp = (GAS v4u*)(XRB + (size_t)t * D + e0); rp[0] = r0; rp[1] = r1;
        }
        ss = wave_sum(ss);
        const float rs = rsqrtf(ss * (1.0f / D) + EPS);
        const GAS f32x4* gp = (const GAS f32x4*)(gnp + e0);
#pragma unroll
        for (int j = 0; j < 4; ++j) { const f32x4 gg = gp[j]; xv[j] = xv[j] * gg * rs; }
        if (MODE == 2) {
            GAS f32x4* op = (GAS f32x4*)(outp + (size_t)t * D + e0);
#pragma unroll
            for (int j = 0; j < 4; ++j) op[j] = xv[j];
        } else {
            v4u h0, h1;
            h0[0] = pk2(xv[0][0], xv[0][1]); h0[1] = pk2(xv[0][2], xv[0][3]); h0[2] = pk2(xv[1][0], xv[1][1]); h0[3] = pk2(xv[1][2], xv[1][3]);
            h1[0] = pk2(xv[2][0], xv[2][1]); h1[1] = pk2(xv[2][2], xv[2][3]); h1[2] = pk2(xv[3][0], xv[3][1]); h1[3] = pk2(xv[3][2], xv[3][3]);
            GAS v4u* hp = (GAS v4u*)((GAS bf16_t*)(wsb + WS_HN) + (size_t)t * D + e0); hp[0] = h0; hp[1] = h1;
            float a[8];
#pragma unroll
            for (int q = 0; q < 8; ++q) { float s = 0.f;
#pragma unroll
                for (int j = 0; j < 4; ++j) { const f32x4 w = *(const LAS f32x4*)(wl + q * D + (j * 64 + lane) * 4); s += (xv[j][0] * w[0] + xv[j][1] * w[1]) + (xv[j][2] * w[2] + xv[j][3] * w[3]); }
                a[q] = wave_sum(s); }
            if (lane < 8) {
                float f = lane == 0 ? a[0] : lane == 1 ? a[1] : lane == 2 ? a[2] : lane == 3 ? a[3] : lane == 4 ? a[4] : lane == 5 ? a[5] : lane == 6 ? a[6] : a[7];
                f += bfgp[lane];
                ((GAS float*)(wsb + WS_LOGF))[(size_t)t * 8 + lane] = log_sigmoid(f);
            }
        }
        if (MODE == 1) {
            constexpr size_t NCHL = (size_t)NEXP * D / 2048;
            if (cvc < 2 * NCHL) { int lc_ = lane; asm volatile("" : "+v"(lc_));
                peer::convert_chunk(ARG_IN(12), ARG_IN(13), (unsigned char*)(opq(wsb0) + WS_EXP), F.lds + 32768 + F.wave * 9216, lc_, (int)(cvc / NCHL), NCHL + cvc % NCHL); cvc += (size_t)F.ngw; }
        }
    }
    if (MODE == 1) {
        constexpr size_t NCHL = (size_t)NEXP * D / 2048;
        for (; cvc < 2 * NCHL; cvc += (size_t)F.ngw) { int lc_ = lane0; asm volatile("" : "+v"(lc_)); peer::convert_chunk(ARG_IN(12), ARG_IN(13), (unsigned char*)(opq(wsb0) + WS_EXP), F.lds + 32768 + F.wave * 9216, lc_, (int)(cvc / NCHL), NCHL + cvc % NCHL); }
    }
}
}
namespace route {
typedef float f32x16 __attribute__((ext_vector_type(16)));
typedef unsigned u32x2 __attribute__((ext_vector_type(2)));
constexpr int KROW = 272;
constexpr int KIMG = 128 * KROW;
constexpr int OFF_SLOT = 2 * KIMG;

#define RT_CE(a, b) do { const float hi_ = fmaxf(a, b), lo_ = fminf(a, b); a = hi_; b = lo_; } while (0)
template <int BASE> __device__ __forceinline__ void sort16(float (&v)[64]) {
    constexpr int NET[60][2] = {{0, 13}, {1, 12}, {2, 15}, {3, 14}, {4, 8}, {5, 6}, {7, 11}, {9, 10},   {0, 5}, {1, 7}, {2, 9}, {3, 4}, {6, 13}, {8, 14}, {10, 15}, {11, 12},
                                {0, 1}, {2, 3}, {4, 5}, {6, 8}, {7, 9}, {10, 11}, {12, 13}, {14, 15},   {0, 2}, {1, 3}, {4, 10}, {5, 11}, {6, 7}, {8, 9}, {12, 14}, {13, 15},
                                {1, 2}, {3, 12}, {4, 6}, {5, 7}, {8, 10}, {9, 11}, {13, 14},   {1, 4}, {2, 6}, {5, 8}, {7, 10}, {9, 13}, {11, 14},   {2, 4}, {3, 6}, {9, 12}, {11, 13},
                                {3, 5}, {6, 8}, {7, 9}, {10, 12},   {3, 4}, {5, 6}, {7, 8}, {9, 10}, {11, 12},   {6, 7}, {8, 9}};
#pragma unroll
    for (int c = 0; c < 60; ++c) RT_CE(v[BASE + NET[c][0]], v[BASE + NET[c][1]]);
}
template <int A, int B> __device__ __forceinline__ void merge16(float (&v)[64]) {
#pragma unroll
    for (int i = 0; i < 16; ++i) v[A + i] = fmaxf(v[A + i], v[B + 15 - i]);
#pragma unroll
    for (int j = 8; j > 0; j >>= 1)
#pragma unroll
        for (int i = 0; i < 16; ++i) { const int l = i ^ j; if (l > i) RT_CE(v[A + i], v[A + l]); }
}
__device__ __forceinline__ void top16_of_64(float (&v)[64]) { sort16<0>(v); sort16<16>(v); sort16<32>(v); sort16<48>(v); merge16<0, 16>(v); merge16<32, 48>(v); merge16<0, 32>(v); }

__device__ __forceinline__ void ph_route(Frame& F, const pg8::StaticOrder& So, const bf16_t* QPp, const float* SKp, int* EXPIp, float* GATEp) {
    const int lane = F.lane, r32 = lane & 31, hi = lane >> 5;
    const GAS bf16_t* QP = (const GAS bf16_t*)QPp; const GAS float* SK = (const GAS float*)SKp;
    {
        f32x4 k4[16];
#pragma unroll
        for (int q = 0; q < 16; ++q) k4[q] = *(const GAS f32x4*)(SK + (size_t)(F.tid + q * NTHREADS) * 4);
#pragma unroll
        for (int q = 0; q < 16; ++q) {
            const int e = (F.tid + q * NTHREADS) * 4, p = e >> 14, n = (e >> 7) & 127, d = e & 127;
            u32x2 o; o[0] = pk2(k4[q][0], k4[q][1]); o[1] = pk2(k4[q][2], k4[q][3]);
            *(LAS u32x2*)(F.lds + p * KIMG + n * KROW + d * 2) = o;
        }
    }
    __syncthreads();
    LAS unsigned* slot = (LAS unsigned*)(F.lds + OFF_SLOT + F.wave * 8192) + lane;
    pg8::Unit u_;
    for (int ui = 0; So.next(ui, u_); ++ui) {
        const int tile = u_.pm * 8 + F.wave, h = u_.pn;
        const int tok = tile * 32 + r32;
        float s01[2][16];
#pragma unroll
        for (int p = 0; p < 2; ++p) {
            bf16x8 qf[8];
#pragma unroll
            for (int ks = 0; ks < 8; ++ks) qf[ks] = *(const GAS bf16x8*)(QP + (size_t)tok * 2048 + h * 256 + p * 128 + ks * 16 + hi * 8);
            f32x16 acc[4];
#pragma unroll
            for (int kb = 0; kb < 4; ++kb) acc[kb] = f32x16{};
            const LAS unsigned char* kbase = F.lds + p * KIMG + r32 * KROW + hi * 16;
#pragma unroll
            for (int ks = 0; ks < 8; ++ks)
#pragma unroll
                for (int kb = 0; kb < 4; ++kb) {
                    const bf16x8 a = *(const LAS bf16x8*)(kbase + kb * 32 * KROW + ks * 32);
                    acc[kb] = __builtin_amdgcn_mfma_f32_32x32x16_bf16(a, qf[ks], acc[kb], 0, 0, 0);
                }
            float v[64];
#pragma unroll
            for (int kb = 0; kb < 4; ++kb)
#pragma unroll
                for (int r = 0; r < 16; ++r) {
                    const unsigned n = (unsigned)(32 * kb + (r & 3) + 8 * (r >> 2)) + 4u * (unsigned)hi;
                    v[kb * 16 + r] = __uint_as_float((__float_as_uint(acc[kb][r]) & 0xFFFFFF80u) | n);
                }
            top16_of_64(v);
            float w[16];
#pragma unroll
            for (int i = 0; i < 16; ++i) w[i] = bperm_f(lane ^ 32, v[15 - i]);
#pragma unroll
            for (int i = 0; i < 16; ++i) v[i] = fmaxf(v[i], w[i]);
#pragma unroll
            for (int j = 8; j > 0; j >>= 1)
#pragma unroll
                for (int i = 0; i < 16; ++i) { const int l = i ^ j; if (l > i) RT_CE(v[i], v[l]); }
#pragma unroll
            for (int i = 0; i < 16; ++i) s01[p][i] = v[i];
        }
#pragma unroll
        for (int i = 0; i < 16; ++i) { slot[i * 64] = __float_as_uint(s01[0][i]) & 127u; slot[(16 + i) * 64] = __float_as_uint(s01[1][i]) & 127u; }
        float c[64];
        {
            constexpr int CNT[16] = {16, 8, 5, 4, 3, 2, 2, 2, 1, 1, 1, 1, 1, 1, 1, 1}, OFS[16] = {0, 16, 24, 29, 33, 36, 38, 40, 42, 43, 44, 45, 46, 47, 48, 49};
#pragma unroll
            for (int a = 0; a < 16; ++a)
#pragma unroll
                for (int b = 0; b < 16; ++b)
                    if (b < CNT[a]) c[OFS[a] + b] = __uint_as_float((__float_as_uint(s01[0][a] + s01[1][b]) & 0xFFFFFF00u) | (unsigned)(a * 16 + b));
#pragma unroll
            for (int i = 50; i < 64; ++i) c[i] = -INFINITY;
        }
        sort16<16>(c); sort16<32>(c); RT_CE(c[48], c[49]); merge16<0, 16>(c); merge16<32, 48>(c); merge16<0, 32>(c);
        float g[16]; int ex[16];
        asm volatile("s_waitcnt lgkmcnt(0)" ::: "memory");
        const float mx = __uint_as_float(__float_as_uint(c[0]) & 0xFFFFFF00u);
        float sum = 0.f;
#pragma unroll
        for (int i = 0; i < 16; ++i) {
            const unsigned bits = __float_as_uint(c[i]);
            const unsigned a = (bits >> 4) & 15u, b = bits & 15u;
            g[i] = __expf(__uint_as_float(bits & 0xFFFFFF00u) - mx); sum += g[i];
            ex[i] = (int)(slot[a * 64] * 128u + slot[(16 + b) * 64]);
        }
        const float inv = 1.0f / sum;
        GAS int* eo = (GAS int*)EXPIp + ((size_t)tok * 8 + h) * 16 + hi * 8;
        GAS float* go = (GAS float*)GATEp + ((size_t)tok * 8 + h) * 16 + hi * 8;
        if (hi == 0) {
            *(GAS v4u*)eo = (v4u){(unsigned)ex[0], (unsigned)ex[1], (unsigned)ex[2], (unsigned)ex[3]}; *(GAS v4u*)(eo + 4) = (v4u){(unsigned)ex[4], (unsigned)ex[5], (unsigned)ex[6], (unsigned)ex[7]};
            *(GAS f32x4*)go = (f32x4){g[0] * inv, g[1] * inv, g[2] * inv, g[3] * inv}; *(GAS f32x4*)(go + 4) = (f32x4){g[4] * inv, g[5] * inv, g[6] * inv, g[7] * inv};
        } else {
            *(GAS v4u*)eo = (v4u){(unsigned)ex[8], (unsigned)ex[9], (unsigned)ex[10], (unsigned)ex[11]}; *(GAS v4u*)(eo + 4) = (v4u){(unsigned)ex[12], (unsigned)ex[13], (unsigned)ex[14], (unsigned)ex[15]};
            *(GAS f32x4*)go = (f32x4){g[8] * inv, g[9] * inv, g[10] * inv, g[11] * inv}; *(GAS f32x4*)(go + 4) = (f32x4){g[12] * inv, g[13] * inv, g[14] * inv, g[15] * inv};
        }
        asm volatile("s_waitcnt lgkmcnt(0)" ::: "memory");
    }
}
#undef RT_CE
}
constexpr int NPL = 6;
constexpr int N_PHASES = 1 + DEPTH * NPL;
__global__ void __launch_bounds__(NTHREADS, 2) mega_fwd(Args  ) {
    extern __shared__ __attribute__((aligned(16))) unsigned char lds[];
    cg::grid_group grid = cg::this_grid();
    Frame F;
    F.lds = (LAS unsigned char*)lds;
    F.G = gridDim.x; F.ngw = F.G * NWAVES;
    volatile LAS unsigned* bst = (volatile LAS unsigned*)(F.lds + LDS_BYTES - 64);
    const int wave0 = __builtin_amdgcn_readfirstlane((int)threadIdx.x >> 6);
    if (threadIdx.x == 0) { bst[0] = 0u; bst[1] = 0u; }
    __syncthreads();
    const XcdBarrier bar = xcd_barrier_post((unsigned*)(ARG_WS + WS_CTL) + CW_BAR, bst, (int)threadIdx.x);
    for (int ph = ARG_PHLO; ph < ARG_PHHI; ++ph) {
        { int t_; asm volatile("v_mbcnt_lo_u32_b32 %0, -1, 0\n\tv_mbcnt_hi_u32_b32 %0, -1, %0" : "=v"(t_)); t_ += wave0 * 64; asm volatile("" : "+v"(t_)); int b_ = blockIdx.x; asm volatile("" : "+s"(b_));
          int l_ = t_ & 63; asm volatile("" : "+v"(l_));
          F.tid = t_; F.lane = l_; F.wave = __builtin_amdgcn_readfirstlane(t_ >> 6); F.bid = b_; F.gw = b_ * NWAVES + F.wave; }
        unsigned char* ws = ARG_WS;
        bf16_t* XRB = (bf16_t*)(ws + WS_XR);
        bf16_t* HN = (bf16_t*)(ws + WS_HN);
        if (ph == 0) {
            ph_prologue(F);
            __syncthreads();
            ph_rmsnorm(F, ARG_IN(0), ARG_IN(1), HN, ARG_IN(2), ARG_IN(3), (float*)(ws + WS_LOGF));
        } else {
            const int l = (ph - 1) / NPL, k = (ph - 1) % NPL;
            switch (k) {
            case 0: {
                ph_cumsum(F, (const float*)(ws + WS_LOGF), (float*)(ws + WS_CUM));
                pg8::Gemm g{HN, (const bf16_t*)(ws + WS_WIN + (size_t)l * 10 * MiB), T, NPROJ, D}; pg8::StaticOrder So; So.init(T, NPROJ, F.G, F.bid);
                pg8::EpiProj E{(bf16_t*)(ws + WS_A), (bf16_t*)(ws + WS_SG)};
                pg8::gemm_phase<pg8::EpiProj, pg8::StaticOrder, true, true>(F.lds, g, So, E, F.tid);
            } break;
            case 1: {
                const float lam_init = 0.8f - 0.6f * expf(-0.3f * (float)l);
                if (l == 0) {
                    constexpr size_t NCHL = (size_t)NEXP * D / 2048, PERSLOT = 2;
                    size_t cvc = (size_t)F.gw;
                    auto conv = [&](int) {
                        if (cvc + (size_t)F.ngw < 2 * NCHL) {
                            int lc_ = F.lane; asm volatile("" : "+v"(lc_));
                            const size_t c0_ = cvc, c1_ = cvc + (size_t)F.ngw;
                            const GAS f32x4* s0_ = (const GAS f32x4*)(c0_ < NCHL ? ARG_IN(12) : ARG_IN(13)) + (c0_ % NCHL) * 512 + lc_;
                            const GAS f32x4* s1_ = (const GAS f32x4*)(c1_ < NCHL ? ARG_IN(12) : ARG_IN(13)) + (c1_ % NCHL) * 512 + lc_;
                            f32x4 a_[8], b_[8];
#pragma unroll
                            for (int k = 0; k < 8; ++k) { a_[k] = s0_[k * 64]; b_[k] = s1_[k * 64]; }
                            LAS unsigned char* stg_ = F.lds + F.wave * 9216;
                            peer::convert_stage(stg_, lc_, a_); peer::convert_encode(ARG_WS + WS_EXP, stg_, lc_, (int)(c0_ / NCHL), c0_ % NCHL);
                            peer::convert_stage(stg_, lc_, b_); peer::convert_encode(ARG_WS + WS_EXP, stg_, lc_, (int)(c1_ / NCHL), c1_ % NCHL);
                            cvc += 2 * (size_t)F.ngw;
                        }
                        __syncthreads();
                    };
                ph_attention(F, (const bf16_t*)(ws + WS_A), (const float*)(ws + WS_BT), (const float*)(ws + WS_CUM), ARG_IN(4) + l * 256, ARG_IN(5) + l * 128, lam_init, (bf16_t*)(ws + WS_YD), (bf16_t*)(ws + WS_YF), conv);
                    for (; cvc < 2 * NCHL; cvc += (size_t)F.ngw) { int lc_ = F.lane; asm volatile("" : "+v"(lc_)); peer::convert_chunk(ARG_IN(12), ARG_IN(13), ARG_WS + WS_EXP, F.lds + F.wave * 9216, lc_, (int)(cvc / NCHL), cvc % NCHL); }
                } else {
                ph_attention(F, (const bf16_t*)(ws + WS_A), (const float*)(ws + WS_BT), (const float*)(ws + WS_CUM), ARG_IN(4) + l * 256, ARG_IN(5) + l * 128, lam_init, (bf16_t*)(ws + WS_YD), (bf16_t*)(ws + WS_YF), [](int) {});
                }
            } break;
            case 2: {
                pg8::Gemm g{(const bf16_t*)(ws + WS_YD), (const bf16_t*)(ws + WS_WDO + (size_t)l * MiB), T, D, 512, (const bf16_t*)(ws + WS_YF), (const bf16_t*)(ws + WS_WFO + (size_t)l * MiB)};
                pg8::PairOrder So; So.init(T, D, F.G, F.bid);
                pg8::EpiMergeC E{(const bf16_t*)(ws + WS_SG), (const bf16_t*)(ws + WS_SG) + (size_t)T * 1024, (bf16_t*)(ws + WS_MG)};
                pg8::gemm_phase<pg8::EpiMergeC, pg8::PairOrder, true, true>(F.lds, g, So, E, F.tid);
            } break;
            case 3: {
                pg8::Gemm g{(const bf16_t*)(ws + WS_MG), (const bf16_t*)(ws + WS_WOUT + (size_t)l * 2 * MiB), T, D, D}; pg8::StaticOrder So; So.init(T, D, F.G, F.bid);
                if (l == 0) { pg8::EpiResidSS<false> E{ARG_IN(0), HN, (float*)(ws + WS_SSP)}; pg8::gemm_phase<pg8::EpiResidSS<false>, pg8::StaticOrder, true, true>(F.lds, g, So, E, F.tid); }
                else        { pg8::EpiResidSS<true>  E{XRB,       HN, (float*)(ws + WS_SSP)}; pg8::gemm_phase<pg8::EpiResidSS<true>,  pg8::StaticOrder, true, true>(F.lds, g, So, E, F.tid); }
            } break;
            case 4: {
                pg8::StaticOrder So; So.init(T, 2048, F.G, F.bid);
                LAS float* rsl = (LAS float*)(F.lds + 131072 + 4096);
                int pm0 = 0;
                { pg8::Unit u_; for (int ui = 0; ui < 2 && So.next(ui, u_); ++ui) { if (ui == 0) pm0 = u_.pm;
                      if (F.tid < 256) { const GAS f32x4* sp = (const GAS f32x4*)((const float*)(ws + WS_SSP) + (size_t)(u_.pm * 256 + F.tid) * 16);
                          const f32x4 s0 = sp[0], s1 = sp[1], s2 = sp[2], s3 = sp[3];
                          const float ss = ((s0[0] + s0[1]) + (s0[2] + s0[3])) + ((s1[0] + s1[1]) + (s1[2] + s1[3])) + ((s2[0] + s2[1]) + (s2[2] + s2[3])) + ((s3[0] + s3[1]) + (s3[2] + s3[3]));
                          rsl[(u_.pm == pm0 ? 0 : 256) + F.tid] = rsqrtf(ss * (1.0f / D) + EPS); } } }
                __syncthreads();
                { pg8::Gemm g{HN, (const bf16_t*)(ws + WS_WQ + (size_t)l * 4 * MiB), T, 2048, D};
                  pg8::EpiQP E{(bf16_t*)(ws + WS_QP), rsl, pm0};
                  pg8::gemm_phase<pg8::EpiQP, pg8::StaticOrder, true, true>(F.lds, g, So, E, F.tid); }
                asm volatile("s_waitcnt vmcnt(0)" ::: "memory");
                __syncthreads();
                if (F.tid == 0) { __builtin_amdgcn_fence(__ATOMIC_ACQUIRE, "agent"); asm volatile("s_waitcnt vmcnt(0)" ::: "memory"); }
                __syncthreads();
                ws = opq(ws);
                route::ph_route(F, So, (const bf16_t*)(ws + WS_QP), ARG_IN(11) + (size_t)l * 2 * 128 * 128, (int*)(ws + WS_EXPI), (float*)(ws + WS_GATE));
            } break;
            case 5: {
                const unsigned char* eu8 = ws + WS_EXP + (size_t)(l * 2) * peer::TBL_BYTES; const unsigned char* ev8 = eu8 + peer::TBL_BYTES;
                if (l + 1 < DEPTH)
                    peer::ph_peer_gather<1>(F, HN, ARG_IN(9) + l * D, (const float*)(ws + WS_SSP), (const int*)(ws + WS_EXPI), (const float*)(ws + WS_GATE), eu8, ev8, XRB,
                                            ARG_IN(1) + (l + 1) * D, HN, ARG_IN(2) + (size_t)(l + 1) * D * INW, ARG_IN(3) + (l + 1) * 8, (float*)(ws + WS_LOGF), nullptr);
                else
                    peer::ph_peer_gather<2>(F, HN, ARG_IN(9) + l * D, (const float*)(ws + WS_SSP), (const int*)(ws + WS_EXPI), (const float*)(ws + WS_GATE), eu8, ev8, XRB,
                                            ARG_IN(15), nullptr, nullptr, nullptr, nullptr, ARG_OUT);
            } break;
            }
        }
        if (ph + 1 < ARG_PHHI) { if (ARG_PHHI > N_PHASES) grid.sync(); else xcd_barrier(bar, F.tid); }
    }
}

extern "C" void kernel_launch(void* const* d_in, const int* in_sizes, int n_in, void* d_out, int out_size, void* d_ws, size_t ws_size, hipStream_t stream) {
    static int grid = 0;
    if (grid == 0) {
        if (n_in != 16 || ws_size < WS_END) { fprintf(stderr, "kernel_launch: unexpected inputs (n_in %d, ws %zu)\n", n_in, ws_size); grid = -1; return; }
        int dev = 0, cus = 0, per_cu = 0;
        if (hipGetDevice(&dev) != hipSuccess || hipDeviceGetAttribute(&cus, hipDeviceAttributeMultiprocessorCount, dev) != hipSuccess) { grid = -1; return; }
        if (hipFuncSetAttribute((const void*)mega_fwd, hipFuncAttributeMaxDynamicSharedMemorySize, LDS_BYTES) != hipSuccess) { fprintf(stderr, "kernel_launch: hipFuncSetAttribute failed\n"); grid = -1; return; }
        if (hipOccupancyMaxActiveBlocksPerMultiprocessor(&per_cu, (const void*)mega_fwd, NTHREADS, LDS_BYTES) != hipSuccess || per_cu < 1) { fprintf(stderr, "kernel_launch: occupancy query says %d\n", per_cu); per_cu = 1; }
        (void)hipGetLastError();
        grid = cus;
    }
    if (grid < 0) return;
    (void)hipMemsetAsync((char*)d_ws + WS_CTL, 0, CTL_ZERO_BYTES, stream);
    Args a{};
    for (int i = 0; i < 16; ++i) a.in[i] = (const float*)d_in[i];
    a.out = (float*)d_out; a.ws = (unsigned char*)d_ws; a.ph_lo = 0; a.ph_hi = N_PHASES;
    void* kargs[] = {&a};
    hipError_t e = hipLaunchCooperativeKernel((const void*)mega_fwd, dim3(grid), dim3(NTHREADS), kargs, LDS_BYTES, stream);
    if (e != hipSuccess) fprintf(stderr, "kernel_launch: cooperative launch failed: %s (grid %d)\n", hipGetErrorString(e), grid);
}
```
